# Optimizing an MI355X kernel written in HIP

```python
import jax, jax.numpy as jnp
from jax import lax
import numpy as np

D_MODEL = 4096
BATCH = 2
SEQ = 8192
DEPTH = 4

HG_HEADS = 8
HG_DK = 128
HG_DV = 128
HG_CHUNK = 64
FOX_HEADS = 8
FOX_DIM = 128
FOX_F_BIAS_MEAN = 2.0
MLA_HEADS = 16
MLA_Q_LORA = 768
MLA_KV_LORA = 512
MLA_NOPE = 128
MLA_ROPE = 64
MLA_V = 128
ROPE_THETA = 10000.0
MIX_WIDTH = HG_HEADS * HG_DV + FOX_HEADS * FOX_DIM + MLA_HEADS * MLA_V
MEM_TOKENS = 256
MEM_HEADS = 4
MEM_DIM = 128
D_FF = 4 * D_MODEL
Q_BLOCK = 128
EPS = 1e-6
MASK_VALUE = -1e30
LB_FLOOR = 1e-30
IN_SIZES = (HG_HEADS * HG_DK, HG_HEADS * HG_DK, HG_HEADS * HG_DV, HG_HEADS * HG_DV,
            FOX_HEADS * FOX_DIM, FOX_HEADS * FOX_DIM, FOX_HEADS * FOX_DIM, FOX_HEADS,
            MLA_Q_LORA, MLA_KV_LORA, MLA_ROPE)
IN_COLS = 4 * 1024 + 3 * 1024 + 8 + 768 + 512 + 64

kernel_name = "hybrid_hgrn2_fox_mla_trunk"


def rms_norm(x, g):
    xf = x.astype(jnp.float32)
    y = xf * lax.rsqrt(jnp.mean(xf * xf, axis=-1, keepdims=True) + EPS)
    return (y * g.astype(jnp.float32)).astype(x.dtype)


def head_rms_norm(o, g):
    return rms_norm(o, g.reshape(o.shape[-2], o.shape[-1]))


def rope(x, positions):
    half = x.shape[-1] // 2
    inv = ROPE_THETA ** (-jnp.arange(half, dtype=jnp.float32) / half)
    ang = positions.astype(jnp.float32)[..., None] * inv
    cos = jnp.cos(ang)[:, :, None, :]
    sin = jnp.sin(ang)[:, :, None, :]
    xf = x.astype(jnp.float32)
    x1, x2 = xf[..., :half], xf[..., half:]
    return jnp.concatenate([x1 * cos - x2 * sin, x1 * sin + x2 * cos], axis=-1).astype(x.dtype)


def hgrn2_chunked(q, k, v, log_f):
    b_, s_, h_, dk = q.shape
    dv = v.shape[-1]
    n = s_ // HG_CHUNK

    def chunks(t):
        return t.astype(jnp.float32).reshape(b_, n, HG_CHUNK, h_, t.shape[-1]).transpose(1, 0, 3, 2, 4)

    qc, kc, vc = chunks(q), chunks(k), chunks(v)
    bc = jnp.cumsum(chunks(log_f), axis=3)
    tri = jnp.tril(jnp.ones((HG_CHUNK, HG_CHUNK), dtype=bool))[:, :, None]

    def step(state, xs):
        qi, ki, vi, bi = xs
        rel = bi[:, :, :, None, :] - bi[:, :, None, :, :]
        decay = jnp.where(tri, jnp.exp(jnp.minimum(rel, 0.0)), 0.0)
        scores = jnp.einsum('bhtk,bhsk,bhtsk->bhts', qi, ki, decay)
        o = (jnp.einsum('bhts,bhsv->bhtv', scores, vi)
             + jnp.einsum('bhtk,bhkv->bhtv', qi * jnp.exp(bi), state))
        b_end = bi[:, :, -1:, :]
        state = (jnp.exp(b_end[:, :, 0, :, None]) * state
                 + jnp.einsum('bhsk,bhsv->bhkv', ki * jnp.exp(b_end - bi), vi))
        return state, o

    state0 = jnp.zeros((b_, h_, dk, dv), jnp.float32)
    _, ys = lax.scan(step, state0, (qc, kc, vc, bc))
    return ys.transpose(1, 0, 3, 2, 4).reshape(b_, s_, h_, dv)


def causal_block_attention(q, k, v, scale, log_f=None):
    b_, s_, h_, _ = q.shape
    dv = v.shape[-1]
    n_blocks = s_ // Q_BLOCK
    k_idx = jnp.arange(s_)
    cum = None if log_f is None else jnp.cumsum(log_f.astype(jnp.float32), axis=1).transpose(0, 2, 1)

    def block(i):
        start = i * Q_BLOCK
        qb = lax.dynamic_slice_in_dim(q, start, Q_BLOCK, axis=1)
        logits = jnp.einsum('bthd,bshd->bhts', qb, k).astype(jnp.float32) * scale
        if cum is not None:
            cb = lax.dynamic_slice_in_dim(cum, start, Q_BLOCK, axis=2)
            logits = logits + (cb[..., :, None] - cum[..., None, :])
        q_idx = start + jnp.arange(Q_BLOCK)
        logits = jnp.where(k_idx[None, :] <= q_idx[:, None], logits, MASK_VALUE)
        p = jax.nn.softmax(logits, axis=-1).astype(v.dtype)
        return jnp.einsum('bhts,bshd->bthd', p, v)

    out = lax.map(block, jnp.arange(n_blocks))
    return out.transpose(1, 0, 2, 3, 4).reshape(b_, s_, h_, dv)


def memory_cross_attention(hn, mem_n, w_q, w_k, w_v, w_out):
    b_, s_, _ = hn.shape
    m_ = mem_n.shape[1]
    q = (hn @ w_q).reshape(b_, s_, MEM_HEADS, MEM_DIM)
    k = (mem_n @ w_k).reshape(b_, m_, MEM_HEADS, MEM_DIM)
    v = (mem_n @ w_v).reshape(b_, m_, MEM_HEADS, MEM_DIM)
    logits = jnp.einsum('bthd,bmhd->bhtm', q, k).astype(jnp.float32) * (MEM_DIM ** -0.5)
    p = jax.nn.softmax(logits, axis=-1).astype(v.dtype)
    o = jnp.einsum('bhtm,bmhd->bthd', p, v).reshape(b_, s_, MEM_HEADS * MEM_DIM)
    return o @ w_out


def setup_inputs(seed: int = 0) -> dict:
    key = jax.random.key(seed)
    ks = jax.random.split(key, 25)
    f32 = jnp.float32

    def nrm(k, shape, scale):
        return jax.random.normal(k, shape, f32) * scale

    def gain(k, shape):
        return 1.0 + 0.02 * jax.random.normal(k, shape, f32)

    x = jax.random.normal(ks[0], (BATCH, SEQ, D_MODEL), f32)
    mem = jax.random.normal(ks[1], (BATCH, MEM_TOKENS, D_MODEL), f32)
    offsets = jax.random.randint(ks[2], (BATCH, 1), 0, 4096, dtype=jnp.int32)
    positions = (jnp.arange(SEQ, dtype=jnp.int32)[None, :] + offsets).astype(jnp.int32)
    return {
        "x": x,
        "mem": mem,
        "positions": positions,
        "w_in": nrm(ks[3], (DEPTH, D_MODEL, IN_COLS), D_MODEL ** -0.5),
        "hg_lb_logits": nrm(ks[4], (DEPTH, HG_HEADS * HG_DK), 0.1),
        "fox_f_bias": FOX_F_BIAS_MEAN + nrm(ks[5], (DEPTH, FOX_HEADS), 0.5),
        "mla_q_norm_g": gain(ks[6], (DEPTH, MLA_Q_LORA)),
        "mla_kv_norm_g": gain(ks[7], (DEPTH, MLA_KV_LORA)),
        "w_uq": nrm(ks[8], (DEPTH, MLA_Q_LORA, MLA_HEADS * (MLA_NOPE + MLA_ROPE)), MLA_Q_LORA ** -0.5),
        "w_ukv": nrm(ks[9], (DEPTH, MLA_KV_LORA, MLA_HEADS * (MLA_NOPE + MLA_V)), MLA_KV_LORA ** -0.5),
        "mix_out_g": gain(ks[10], (DEPTH, MIX_WIDTH)),
        "w_o": nrm(ks[11], (DEPTH, MIX_WIDTH, D_MODEL), MIX_WIDTH ** -0.5),
        "mem_norm_g": gain(ks[12], (DEPTH, D_MODEL)),
        "w_mq": nrm(ks[13], (DEPTH, D_MODEL, MEM_HEADS * MEM_DIM), D_MODEL ** -0.5),
        "w_mk": nrm(ks[14], (DEPTH, D_MODEL, MEM_HEADS * MEM_DIM), D_MODEL ** -0.5),
        "w_mv": nrm(ks[15], (DEPTH, D_MODEL, MEM_HEADS * MEM_DIM), D_MODEL ** -0.5),
        "w_mo": nrm(ks[16], (DEPTH, MEM_HEADS * MEM_DIM, D_MODEL), (MEM_HEADS * MEM_DIM) ** -0.5),
        "w_ff1": nrm(ks[17], (DEPTH, D_MODEL, D_FF), D_MODEL ** -0.5),
        "w_ff2": nrm(ks[18], (DEPTH, D_FF, D_MODEL), D_FF ** -0.5),
        "pre_mix_g": gain(ks[19], (DEPTH, D_MODEL)),
        "post_mix_g": gain(ks[20], (DEPTH, D_MODEL)),
        "pre_mem_g": gain(ks[21], (DEPTH, D_MODEL)),
        "post_mem_g": gain(ks[22], (DEPTH, D_MODEL)),
        "pre_ffn_g": gain(ks[23], (DEPTH, D_MODEL)),
        "post_ffn_g": gain(ks[24], (DEPTH, D_MODEL)),
    }


def reference(x, mem, positions, w_in, hg_lb_logits, fox_f_bias, mla_q_norm_g, mla_kv_norm_g,
              w_uq, w_ukv, mix_out_g, w_o, mem_norm_g, w_mq, w_mk, w_mv, w_mo, w_ff1, w_ff2,
              pre_mix_g, post_mix_g, pre_mem_g, post_mem_g, pre_ffn_g, post_ffn_g):
    b_, s_, _ = x.shape
    split_points = tuple(int(c) for c in np.cumsum(IN_SIZES)[:-1])
    group_points = (HG_HEADS * HG_DV, HG_HEADS * HG_DV + FOX_HEADS * FOX_DIM)

    p_lb = jax.nn.softmax(hg_lb_logits.astype(jnp.float32), axis=0)
    lower_bounds = jnp.cumsum(p_lb, axis=0) - p_lb[0:1]

    h = x
    for l in range(DEPTH):
        hn = rms_norm(h, pre_mix_g[l])
        proj = hn @ w_in[l]
        (hq, hf, hi, hg, fq, fk, fv, ff, cq, ckv, kr) = jnp.split(proj, split_points, axis=-1)
        g_a, g_b, g_c = jnp.split(mix_out_g[l], group_points)

        lb = jnp.clip(lower_bounds[l].reshape(HG_HEADS, HG_DK), 0.0, 1.0 - 1e-6)
        log_lb = jnp.log(jnp.maximum(lb, LB_FLOOR))
        log_one_minus_lb = jnp.log1p(-lb)
        z = hf.astype(jnp.float32).reshape(b_, s_, HG_HEADS, HG_DK)
        log_f_a = jnp.logaddexp(log_lb, log_one_minus_lb + jax.nn.log_sigmoid(z))
        k_a = jnp.exp(log_one_minus_lb + jax.nn.log_sigmoid(-z))
        o_a = hgrn2_chunked(hq.reshape(b_, s_, HG_HEADS, HG_DK), k_a,
                            hi.reshape(b_, s_, HG_HEADS, HG_DV), log_f_a)
        o_a = head_rms_norm(o_a, g_a) * jax.nn.silu(hg.astype(jnp.float32).reshape(b_, s_, HG_HEADS, HG_DV))

        log_f_b = jax.nn.log_sigmoid(ff.astype(jnp.float32) + fox_f_bias[l].astype(jnp.float32))
        o_b = causal_block_attention(fq.reshape(b_, s_, FOX_HEADS, FOX_DIM),
                                     fk.reshape(b_, s_, FOX_HEADS, FOX_DIM),
                                     fv.reshape(b_, s_, FOX_HEADS, FOX_DIM),
                                     FOX_DIM ** -0.5, log_f_b)
        o_b = head_rms_norm(o_b, g_b)

        q_full = (rms_norm(cq, mla_q_norm_g[l]) @ w_uq[l]).reshape(b_, s_, MLA_HEADS, MLA_NOPE + MLA_ROPE)
        kv_full = (rms_norm(ckv, mla_kv_norm_g[l]) @ w_ukv[l]).reshape(b_, s_, MLA_HEADS, MLA_NOPE + MLA_V)
        q_nope, q_rot = jnp.split(q_full, (MLA_NOPE,), axis=-1)
        k_nope, v_c = jnp.split(kv_full, (MLA_NOPE,), axis=-1)
        k_rot = jnp.broadcast_to(rope(kr[:, :, None, :], positions), (b_, s_, MLA_HEADS, MLA_ROPE))
        q_c = jnp.concatenate([q_nope, rope(q_rot, positions)], axis=-1)
        k_c = jnp.concatenate([k_nope, k_rot.astype(k_nope.dtype)], axis=-1)
        o_c = causal_block_attention(q_c, k_c, v_c, (MLA_NOPE + MLA_ROPE) ** -0.5)
        o_c = head_rms_norm(o_c, g_c)

        mix = jnp.concatenate([o_a.reshape(b_, s_, -1), o_b.reshape(b_, s_, -1).astype(jnp.float32),
                               o_c.reshape(b_, s_, -1).astype(jnp.float32)], axis=-1).astype(h.dtype)
        h = h + rms_norm(mix @ w_o[l], post_mix_g[l])

        hn = rms_norm(h, pre_mem_g[l])
        mem_n = rms_norm(mem, mem_norm_g[l])
        y = memory_cross_attention(hn, mem_n, w_mq[l], w_mk[l], w_mv[l], w_mo[l])
        h = h + rms_norm(y, post_mem_g[l])

        hn = rms_norm(h, pre_ffn_g[l])
        y = jnp.square(jax.nn.relu(hn @ w_ff1[l])) @ w_ff2[l]
        h = h + rms_norm(y, post_ffn_g[l])
    return h
```

```cpp
#include <hip/hip_runtime.h>
#include <cstdio>
#include <cstdint>
namespace pg8 {
#define PG8_LAS __attribute__((address_space(3)))
typedef unsigned short bf16_t;
typedef short bf16x8 __attribute__((ext_vector_type(8)));
typedef float f32x4 __attribute__((ext_vector_type(4)));
typedef unsigned u32x4 __attribute__((ext_vector_type(4)));
constexpr int BM = 256, BK = 64, HALF = 128, HTB = HALF * BK * 2  , STAGE_BYTES = 8 * HTB, NXCD = 8, WGM = 8;

__host__ __device__ __forceinline__ int lds_byte(int r, int c) { const int st = (r >> 4) * 2 + (c >> 5), rr = r & 15, cc = c & 31, ob = rr * 64 + cc * 2; return st * 1024 + (ob ^ (((ob >> 9) & 1) << 5)); }
__host__ __device__ __forceinline__ void stage_rc(int b, int& R, int& C) { const int st = b / 1024, sb = b % 1024, swz = sb ^ (((sb >> 9) & 1) << 5); R = (st >> 1) * 16 + swz / 64; C = (st & 1) * 32 + (swz % 64) / 2; }
__host__ __device__ __forceinline__ int perm32(int rho) { const int n = rho >> 4, i = rho & 15; return 8 * (i >> 2) + 4 * n + (i & 3); }

struct Unit { int pm, pn; };
struct Gemm { const bf16_t* A; const bf16_t* Bt; int M, N, K; };

struct StaticOrder {
    int nM, nN, nwg, G, c;
    __host__ __device__ void init(int M, int N, int G_, int c_) { nM = M / BM; nN = N / BM; nwg = nM * nN; G = G_; c = c_; }
    __host__ __device__ bool next(int i, Unit& u) const {
        const long L = (long)i * G + c; if (L >= nwg) return false;
        int wgid = (int)L; { const int q = nwg / NXCD, r = nwg % NXCD, xcd = wgid % NXCD, off = wgid / NXCD; wgid = (xcd < r ? xcd * (q + 1) : r * (q + 1) + (xcd - r) * q) + off; }
        const int nig = WGM * nN, gid = wgid / nig, fm = gid * WGM, gsz = (nM - fm) < WGM ? (nM - fm) : WGM;
        u.pm = fm + ((wgid % nig) % gsz); u.pn = (wgid % nig) / gsz; return true;
    }
    __device__ __forceinline__ void a_ready(const Unit&) const {}
    __device__ __forceinline__ void done(const Unit&) const {}
};

__device__ __forceinline__ unsigned cvt_pk_bf16(float lo, float hi) { unsigned r; asm volatile("v_cvt_pk_bf16_f32 %0, %1, %2" : "=v"(r) : "v"(lo), "v"(hi)); return r; }
typedef float f32x2 __attribute__((ext_vector_type(2)));
__device__ __forceinline__ u32x4 pack8_bf16(const f32x4& v0, const f32x4& v1) { u32x4 w; w.x = cvt_pk_bf16(v0[0], v0[1]); w.y = cvt_pk_bf16(v0[2], v0[3]); w.z = cvt_pk_bf16(v1[0], v1[1]); w.w = cvt_pk_bf16(v1[2], v1[3]); return w; }

struct EpiBf16S {
    static constexpr bool PERM = true, AFTER_DRAIN = false;
    bf16_t* O; int ldc; float scale;
    __device__ __forceinline__ void operator()(const f32x4 (&acc)[2][2][4][2], const Unit& u, int wr, int wc, int fr, int fq) const {
        const int row0 = u.pm * BM + wr * 64 + fr, col0 = u.pn * BM + wc * 32 + 8 * fq;
#pragma unroll
        for (int ai = 0; ai < 2; ++ai)
#pragma unroll
            for (int m = 0; m < 4; ++m) { bf16_t* rowp = O + (size_t)(row0 + ai * HALF + m * 16) * ldc + col0;
#pragma unroll
                for (int bj = 0; bj < 2; ++bj) *(u32x4*)(rowp + bj * HALF) = pack8_bf16(acc[ai][bj][m][0] * scale, acc[ai][bj][m][1] * scale); }
    }
};
struct EpiRelu2 {
    static constexpr bool PERM = true, AFTER_DRAIN = false;
    bf16_t* O; int ldc;
    __device__ __forceinline__ void operator()(const f32x4 (&acc)[2][2][4][2], const Unit& u, int wr, int wc, int fr, int fq) const {
        const int row0 = u.pm * BM + wr * 64 + fr, col0 = u.pn * BM + wc * 32 + 8 * fq;
        const f32x4 z4 = {0.f, 0.f, 0.f, 0.f};
#pragma unroll
        for (int ai = 0; ai < 2; ++ai)
#pragma unroll
            for (int m = 0; m < 4; ++m) { bf16_t* rowp = O + (size_t)(row0 + ai * HALF + m * 16) * ldc + col0;
#pragma unroll
                for (int bj = 0; bj < 2; ++bj) { f32x4 a = __builtin_elementwise_max(acc[ai][bj][m][0], z4), b = __builtin_elementwise_max(acc[ai][bj][m][1], z4);
                    *(u32x4*)(rowp + bj * HALF) = pack8_bf16(a * a, b * b); } }
    }
};
struct EpiF32P {
    static constexpr bool PERM = true, AFTER_DRAIN = false;
    float* C; int ldc;
    __device__ __forceinline__ void operator()(const f32x4 (&acc)[2][2][4][2], const Unit& u, int wr, int wc, int fr, int fq) const {
        const int row0 = u.pm * BM + wr * 64 + fr, col0 = u.pn * BM + wc * 32 + 8 * fq;
#pragma unroll
        for (int ai = 0; ai < 2; ++ai)
#pragma unroll
            for (int m = 0; m < 4; ++m) { float* rowp = C + (size_t)(row0 + ai * HALF + m * 16) * ldc + col0;
#pragma unroll
                for (int bj = 0; bj < 2; ++bj) { *(f32x4*)(rowp + bj * HALF) = acc[ai][bj][m][0]; *(f32x4*)(rowp + bj * HALF + 4) = acc[ai][bj][m][1]; } }
    }
};
template <int RS> __device__ __forceinline__ void store_hm(const f32x4 (&acc)[2][2][4][2], int bj, bf16_t* dst, float sc) {
#pragma unroll
    for (int ai = 0; ai < 2; ++ai)
#pragma unroll
        for (int m = 0; m < 4; ++m) *(u32x4*)(dst + (size_t)(ai * HALF + m * 16) * RS) = pack8_bf16(acc[ai][bj][m][0] * sc, acc[ai][bj][m][1] * sc);
}
struct EpiProj {
    static constexpr bool PERM = true, AFTER_DRAIN = false;
    bf16_t* proj; bf16_t* fox; float* logf; float* projx; const float* lb; float fqscale;
    __device__ __forceinline__ void operator()(const f32x4 (&acc)[2][2][4][2], const Unit& u, int wr, int wc, int fr, int fq) const {
        const int row0 = u.pm * BM + wr * 64 + fr, cl = wc * 32 + 8 * fq;
        if (u.pn >= 28) {
            const int c0 = (u.pn - 28) * BM + cl;
#pragma unroll
            for (int ai = 0; ai < 2; ++ai)
#pragma unroll
                for (int m = 0; m < 4; ++m) { float* rowp = projx + (size_t)(row0 + ai * HALF + m * 16) * 1536 + c0;
#pragma unroll
                    for (int bj = 0; bj < 2; ++bj) { *(f32x4*)(rowp + bj * HALF) = acc[ai][bj][m][0]; *(f32x4*)(rowp + bj * HALF + 4) = acc[ai][bj][m][1]; } }
        } else if (u.pn >= 16) {
            const int part = (u.pn - 16) >> 2, hp = (u.pn - 16) & 3, b = u.pm >> 5, s0 = (u.pm & 31) * BM + wr * 64 + fr;
            const float sc = part == 0 ? fqscale : 1.0f;
#pragma unroll
            for (int bj = 0; bj < 2; ++bj) store_hm<128>(acc, bj, fox + ((size_t)(part * 16 + b * 8 + 2 * hp + bj) * 8192 + s0) * 128 + cl, sc);
        } else if (u.pn >= 4 && u.pn < 8) {
            const int c0 = (u.pn - 4) * BM + cl;
            f32x4 lbv[2][2];
#pragma unroll
            for (int bj = 0; bj < 2; ++bj) { lbv[bj][0] = *(const f32x4*)(lb + c0 + bj * HALF); lbv[bj][1] = *(const f32x4*)(lb + c0 + bj * HALF + 4); }
#pragma unroll
            for (int ai = 0; ai < 2; ++ai)
#pragma unroll
                for (int m = 0; m < 4; ++m) { const size_t r = (size_t)(row0 + ai * HALF + m * 16);
#pragma unroll
                    for (int bj = 0; bj < 2; ++bj) { f32x4 lf[2], ka[2];
#pragma unroll
                        for (int n = 0; n < 2; ++n)
#pragma unroll
                            for (int j = 0; j < 4; ++j) { const float z = acc[ai][bj][m][n][j], L = lbv[bj][n][j];
                                const float t = __expf(-fabsf(z)), rr = __builtin_amdgcn_rcpf(1.0f + t), sm = t * rr;
                                const float s = z >= 0.f ? rr : sm, sn = z >= 0.f ? sm : rr;
                                const float f = L + (1.0f - L) * s;
                                lf[n][j] = __logf(fmaxf(f, 1e-30f)); ka[n][j] = (1.0f - L) * sn; }
                        *(f32x4*)(logf + r * 1024 + c0 + bj * HALF) = lf[0]; *(f32x4*)(logf + r * 1024 + c0 + bj * HALF + 4) = lf[1];
                        *(u32x4*)(proj + r * 4096 + 1024 + c0 + bj * HALF) = pack8_bf16(ka[0], ka[1]); } }
        } else {
            const int c0 = u.pn * BM + cl;
#pragma unroll
            for (int ai = 0; ai < 2; ++ai)
#pragma unroll
                for (int m = 0; m < 4; ++m) { bf16_t* rowp = proj + (size_t)(row0 + ai * HALF + m * 16) * 4096 + c0;
#pragma unroll
                    for (int bj = 0; bj < 2; ++bj) *(u32x4*)(rowp + bj * HALF) = pack8_bf16(acc[ai][bj][m][0], acc[ai][bj][m][1]); }
        }
    }
};
struct EpiQfull {
    static constexpr bool PERM = true, AFTER_DRAIN = false;
    bf16_t* qn; bf16_t* qr; const float* rope; float qscale;
    __device__ __forceinline__ void operator()(const f32x4 (&acc)[2][2][4][2], const Unit& u, int wr, int wc, int fr, int fq) const {
        const int row0 = u.pm * BM + wr * 64 + fr, cl = wc * 32 + 8 * fq, b = u.pm >> 5, s0 = (u.pm & 31) * BM + wr * 64 + fr;
        if (u.pn < 8) {
#pragma unroll
            for (int bj = 0; bj < 2; ++bj) store_hm<128>(acc, bj, qn + ((size_t)(b * 16 + 2 * u.pn + bj) * 8192 + s0) * 128 + cl, qscale);
        } else {
            const int i0 = (cl & 63) >> 1;
#pragma unroll
            for (int ai = 0; ai < 2; ++ai)
#pragma unroll
                for (int m = 0; m < 4; ++m) { const size_t r = (size_t)(row0 + ai * HALF + m * 16); const int s = s0 + ai * HALF + m * 16;
                    const f32x4 cs0 = *(const f32x4*)(rope + (r * 32 + i0) * 2), cs1 = *(const f32x4*)(rope + (r * 32 + i0) * 2 + 4);
#pragma unroll
                    for (int bj = 0; bj < 2; ++bj) { const int head = 4 * (u.pn - 8) + 2 * bj + (cl >> 6);
                        const f32x4 a = acc[ai][bj][m][0], bq = acc[ai][bj][m][1];
                        f32x4 oa, ob;
                        oa[0] = (a[0] * cs0[0] - a[1] * cs0[1]) * qscale; oa[1] = (a[0] * cs0[1] + a[1] * cs0[0]) * qscale;
                        oa[2] = (a[2] * cs0[2] - a[3] * cs0[3]) * qscale; oa[3] = (a[2] * cs0[3] + a[3] * cs0[2]) * qscale;
                        ob[0] = (bq[0] * cs1[0] - bq[1] * cs1[1]) * qscale; ob[1] = (bq[0] * cs1[1] + bq[1] * cs1[0]) * qscale;
                        ob[2] = (bq[2] * cs1[2] - bq[3] * cs1[3]) * qscale; ob[3] = (bq[2] * cs1[3] + bq[3] * cs1[2]) * qscale;
                        *(u32x4*)(qr + ((size_t)(b * 16 + head) * 8192 + s) * 64 + (cl & 63)) = pack8_bf16(oa, ob); }
                    asm volatile("" ::: "memory"); }
        }
    }
};
struct EpiKV {
    static constexpr bool PERM = true, AFTER_DRAIN = false;
    bf16_t* kn; bf16_t* vc;
    __device__ __forceinline__ void operator()(const f32x4 (&acc)[2][2][4][2], const Unit& u, int wr, int wc, int fr, int fq) const {
        const int cl = wc * 32 + 8 * fq, b = u.pm >> 5, s0 = (u.pm & 31) * BM + wr * 64 + fr;
        const size_t off = ((size_t)(b * 16 + u.pn) * 8192 + s0) * 128 + cl;
        store_hm<128>(acc, 0, kn + off, 1.0f); store_hm<128>(acc, 1, vc + off, 1.0f);
    }
};
struct EpiQmem {
    static constexpr bool PERM = true, AFTER_DRAIN = false;
    bf16_t* qm; float scale;
    __device__ __forceinline__ void operator()(const f32x4 (&acc)[2][2][4][2], const Unit& u, int wr, int wc, int fr, int fq) const {
        const int cl = wc * 32 + 8 * fq, b = u.pm >> 5, s0 = (u.pm & 31) * BM + wr * 64 + fr;
#pragma unroll
        for (int bj = 0; bj < 2; ++bj) store_hm<128>(acc, bj, qm + ((size_t)(b * 4 + 2 * u.pn + bj) * 8192 + s0) * 128 + cl, scale);
    }
};
struct EpiKVmem {
    static constexpr bool PERM = true, AFTER_DRAIN = false;
    bf16_t* km; bf16_t* vm;
    __device__ __forceinline__ void operator()(const f32x4 (&acc)[2][2][4][2], const Unit& u, int wr, int wc, int fr, int fq) const {
        const int cl = wc * 32 + 8 * fq, b = u.pm, s0 = wr * 64 + fr;
        bf16_t* base = u.pn < 2 ? km : vm; const int hp = u.pn & 1;
#pragma unroll
        for (int bj = 0; bj < 2; ++bj) store_hm<128>(acc, bj, base + ((size_t)(b * 4 + 2 * hp + bj) * 256 + s0) * 128 + cl, 1.0f);
    }
};
template <class Epi, class Sched, bool ALIGN_EPI = false, bool SP2 = false>
__device__ __forceinline__ void gemm_phase(PG8_LAS unsigned char* lds, const Gemm g, const Sched& S, const Epi& E, int tid_in) {
    int tid_ = tid_in; asm volatile("" : "+v"(tid_));
    const int tid = tid_, wid = __builtin_amdgcn_readfirstlane(tid >> 6), lane = tid & 63, wr = wid >> 2, wc = wid & 3, fr = lane & 15, fq = lane >> 4;
    const int K = g.K, nt = K / BK;
    unsigned voffA[2], voffB[2];
#pragma unroll
    for (int i = 0; i < 2; ++i) { int R, C; stage_rc(tid * 16 + i * 8192, R, C); const int Rb = Epi::PERM ? ((R & ~31) + perm32(R & 31)) : R;
        voffA[i] = (unsigned)(R * K + C) * 2u; voffB[i] = (unsigned)(Rb * K + C) * 2u; }
    const size_t kstep = (size_t)(BK * 2);
    const size_t hstep = (size_t)HALF * K * 2;
    const size_t tstep = 2 * hstep;
    const unsigned ldsw = (unsigned)wid * 1024u;
    const int aoff = lds_byte(wr * 64 + fr, fq * 8), boff = lds_byte(wc * 32 + fr, fq * 8);
#define PG8_SA(b, h) (((b) * 2 + (h)) * HTB)
#define PG8_SB(b, h) ((4 + (b) * 2 + (h)) * HTB)
#define PG8_STAGE(bufoff, gbase, voff) do { _Pragma("unroll") for (int _i = 0; _i < 2; ++_i) \
        __builtin_amdgcn_global_load_lds((const unsigned*)((const char*)(gbase) + (voff)[_i]), (PG8_LAS unsigned*)(lds + (bufoff) + ldsw + _i * 8192), 16, 0, 0); } while (0)
#define PG8_LDA(dst, b, h) do { _Pragma("unroll") for (int m = 0; m < 4; ++m) _Pragma("unroll") for (int k = 0; k < 2; ++k) dst[m][k] = *(const PG8_LAS bf16x8*)(lds + PG8_SA(b, h) + aoff + m * 2048 + k * 1024); } while (0)
#define PG8_LDB(dst, b, h) do { _Pragma("unroll") for (int n = 0; n < 2; ++n) _Pragma("unroll") for (int k = 0; k < 2; ++k) dst[n][k] = *(const PG8_LAS bf16x8*)(lds + PG8_SB(b, h) + boff + n * 2048 + k * 1024); } while (0)
#define PG8_MMA(ai, bj, At, Bt) do { __builtin_amdgcn_s_setprio(1); _Pragma("unroll") for (int m = 0; m < 4; ++m) _Pragma("unroll") for (int n = 0; n < 2; ++n) _Pragma("unroll") for (int k = 0; k < 2; ++k) \
        acc[ai][bj][m][n] = __builtin_amdgcn_mfma_f32_16x16x32_bf16(Bt[n][k], At[m][k], acc[ai][bj][m][n], 0, 0, 0); __builtin_amdgcn_s_setprio(0); } while (0)
#define PG8_WAIT_V(n) asm volatile("s_waitcnt vmcnt(" #n ")" ::: "memory")
#define PG8_WAIT_L(n) asm volatile("s_waitcnt lgkmcnt(" #n ")" ::: "memory")
#define PG8_BAR __builtin_amdgcn_s_barrier()
#define PG8_SCHED __builtin_amdgcn_sched_barrier(0)
    Unit cur, nxt; int ui = 0;
    if (!S.next(0, cur)) return;
    f32x4 acc[2][2][4][2];
#pragma unroll
    for (int a = 0; a < 2; ++a)
#pragma unroll
        for (int b = 0; b < 2; ++b)
#pragma unroll
            for (int m = 0; m < 4; ++m)
#pragma unroll
                for (int n = 0; n < 2; ++n) acc[a][b][m][n] = (f32x4){0.f, 0.f, 0.f, 0.f};
    bf16x8 At[4][2], B0[2][2], B1[2][2];
    const char* cA = (const char*)g.A + (size_t)cur.pm * tstep; const char* cB = (const char*)g.Bt + (size_t)cur.pn * tstep;
    S.a_ready(cur);
    if constexpr (SP2) {
        PG8_STAGE(PG8_SB(0, 0), cB, voffB); PG8_STAGE(PG8_SB(0, 1), cB + hstep, voffB); PG8_STAGE(PG8_SA(0, 0), cA, voffA); PG8_STAGE(PG8_SA(0, 1), cA + hstep, voffA);
        if (wr == 1) PG8_BAR;
        PG8_WAIT_V(2); PG8_BAR;
        PG8_STAGE(PG8_SB(1, 0), cB + kstep, voffB); PG8_STAGE(PG8_SA(1, 0), cA + kstep, voffA); PG8_STAGE(PG8_SB(1, 1), cB + hstep + kstep, voffB);
        PG8_WAIT_V(6); PG8_BAR;
    } else {
        PG8_STAGE(PG8_SB(0, 0), cB, voffB); PG8_STAGE(PG8_SA(0, 0), cA, voffA); PG8_STAGE(PG8_SB(0, 1), cB + hstep, voffB); PG8_STAGE(PG8_SA(0, 1), cA + hstep, voffA);
        if (wr == 1) PG8_BAR;
        PG8_WAIT_V(4); PG8_BAR;
        PG8_STAGE(PG8_SB(1, 0), cB + kstep, voffB); PG8_STAGE(PG8_SA(1, 0), cA + kstep, voffA); PG8_STAGE(PG8_SB(1, 1), cB + hstep + kstep, voffB);
        PG8_WAIT_V(6); PG8_BAR;
    }
    for (;;) {
        const bool has_next = S.next(ui + 1, nxt);
        const char* nA = has_next ? (const char*)g.A + (size_t)nxt.pm * tstep : cA; const char* nB = has_next ? (const char*)g.Bt + (size_t)nxt.pn * tstep : cB;
        for (int t = 0; t < nt; t += 2) {
            const bool last = (t == nt - 2);
            const char* a1 = cA + (size_t)(t + 1) * kstep;
            const char* a2 = last ? nA : cA + (size_t)(t + 2) * kstep; const char* b2 = last ? nB : cB + (size_t)(t + 2) * kstep;
            const char* a3 = a2 + kstep; const char* b3 = b2 + kstep;
            if (last && has_next) S.a_ready(nxt);
            if constexpr (SP2) {
            PG8_LDB(B0, 0, 0); PG8_LDB(B1, 0, 1); PG8_SCHED; PG8_LDA(At, 0, 0); PG8_STAGE(PG8_SA(1, 1), a1 + hstep, voffA);
            PG8_WAIT_V(8); PG8_WAIT_L(0); PG8_BAR; PG8_MMA(0, 0, At, B0); PG8_MMA(0, 1, At, B1); PG8_BAR; PG8_SCHED;
            PG8_LDA(At, 0, 1); PG8_STAGE(PG8_SB(0, 0), b2, voffB); PG8_STAGE(PG8_SB(0, 1), b2 + hstep, voffB); PG8_STAGE(PG8_SA(0, 0), a2, voffA);
            PG8_WAIT_V(8); PG8_WAIT_L(0); PG8_BAR; PG8_MMA(1, 0, At, B0); PG8_MMA(1, 1, At, B1); PG8_BAR; PG8_SCHED;
            PG8_LDB(B0, 1, 0); PG8_LDB(B1, 1, 1); PG8_SCHED; PG8_LDA(At, 1, 0); PG8_STAGE(PG8_SA(0, 1), a2 + hstep, voffA);
            PG8_WAIT_V(8); PG8_WAIT_L(0); PG8_BAR; PG8_MMA(0, 0, At, B0); PG8_MMA(0, 1, At, B1); PG8_BAR; PG8_SCHED;
            PG8_LDA(At, 1, 1); PG8_STAGE(PG8_SB(1, 0), b3, voffB); PG8_STAGE(PG8_SB(1, 1), b3 + hstep, voffB); PG8_STAGE(PG8_SA(1, 0), a3, voffA);
            PG8_WAIT_V(8); PG8_WAIT_L(0); PG8_BAR; PG8_MMA(1, 0, At, B0); PG8_MMA(1, 1, At, B1); PG8_BAR; PG8_SCHED;
            } else {
            PG8_LDB(B0, 0, 0); PG8_SCHED; PG8_LDA(At, 0, 0); PG8_STAGE(PG8_SA(1, 1), a1 + hstep, voffA);
            PG8_WAIT_L(8); PG8_BAR; PG8_WAIT_L(0); PG8_MMA(0, 0, At, B0); PG8_BAR; PG8_SCHED;
            PG8_LDB(B1, 0, 1); PG8_STAGE(PG8_SB(0, 0), b2, voffB);
            PG8_BAR; PG8_WAIT_L(0); PG8_MMA(0, 1, At, B1); PG8_BAR;
            PG8_LDA(At, 0, 1); PG8_STAGE(PG8_SA(0, 0), a2, voffA);
            PG8_BAR; PG8_WAIT_L(0); PG8_MMA(1, 0, At, B0); PG8_BAR; PG8_SCHED;
            PG8_STAGE(PG8_SB(0, 1), b2 + hstep, voffB);
            PG8_WAIT_V(6); PG8_BAR; PG8_MMA(1, 1, At, B1); PG8_BAR;
            PG8_LDB(B0, 1, 0); PG8_SCHED; PG8_LDA(At, 1, 0); PG8_STAGE(PG8_SA(0, 1), a2 + hstep, voffA);
            PG8_WAIT_L(8); PG8_BAR; PG8_WAIT_L(0); PG8_MMA(0, 0, At, B0); PG8_BAR; PG8_SCHED;
            PG8_LDB(B1, 1, 1); PG8_STAGE(PG8_SB(1, 0), b3, voffB);
            PG8_BAR; PG8_WAIT_L(0); PG8_MMA(0, 1, At, B1); PG8_BAR;
            PG8_LDA(At, 1, 1); PG8_STAGE(PG8_SA(1, 0), a3, voffA);
            PG8_BAR; PG8_WAIT_L(0); PG8_MMA(1, 0, At, B0); PG8_BAR; PG8_SCHED;
            PG8_STAGE(PG8_SB(1, 1), b3 + hstep, voffB);
            PG8_WAIT_V(6); PG8_BAR; PG8_MMA(1, 1, At, B1); PG8_BAR;
            }
        }
        if constexpr (ALIGN_EPI) { if (wr == 0) PG8_BAR; }
        if constexpr (!Epi::AFTER_DRAIN) { E(acc, cur, wr, wc, fr, fq); S.done(cur); }
        if (!has_next) break;
#pragma unroll
        for (int a = 0; a < 2; ++a)
#pragma unroll
            for (int b = 0; b < 2; ++b)
#pragma unroll
                for (int m = 0; m < 4; ++m)
#pragma unroll
                    for (int n = 0; n < 2; ++n) acc[a][b][m][n] = (f32x4){0.f, 0.f, 0.f, 0.f};
        cur = nxt; cA = nA; cB = nB; ++ui;
        if constexpr (ALIGN_EPI) { if (wr == 1) PG8_BAR; }
    }
    PG8_WAIT_V(0);
    if constexpr (!ALIGN_EPI) { if (wr == 0) PG8_BAR; }
    PG8_BAR;
    if constexpr (Epi::AFTER_DRAIN) { E.fused(acc, cur, wr, wc, fr, fq, lds, wid, lane); S.done(cur); }
#undef PG8_SA
#undef PG8_SB
#undef PG8_STAGE
#undef PG8_LDA
#undef PG8_LDB
#undef PG8_MMA
#undef PG8_WAIT_V
#undef PG8_WAIT_L
#undef PG8_BAR
#undef PG8_SCHED
}
}
namespace att {
typedef unsigned short bf16;
typedef short bf16x8 __attribute__((ext_vector_type(8)));
typedef short s16x4 __attribute__((ext_vector_type(4)));
typedef float f32x16 __attribute__((ext_vector_type(16)));
typedef float f32x4 __attribute__((ext_vector_type(4)));
typedef unsigned u32x4 __attribute__((ext_vector_type(4)));
constexpr int NW = 8, QBLK = 32, KVBLK = 64, QB = NW * QBLK, D = 128;
constexpr int SHM_V = KVBLK * D * 2, SHM_K = KVBLK * D * 2, XROW = 144, SHM_X = KVBLK * XROW;
constexpr int OFF_V = 0, OFF_K = 2 * SHM_V, OFF_X = OFF_K + 2 * SHM_K, OFF_WS = OFF_X + 2 * SHM_X, OFF_QX = OFF_WS + NW * 64 * 4;
constexpr int QL = 4;
constexpr int QXW = (4 + QL) * 1024, ATT_LDS_BYTES = OFF_QX + NW * QXW;
constexpr float THR = 8.f;
constexpr float RMS_EPS = 1e-6f;

#define KSWZ(row, colB) ((row) * 256 + ((colB) ^ (((row) & 7) << 4)))
#define SBAR() __builtin_amdgcn_sched_barrier(0)
__device__ __forceinline__ int v_st(int k, int c) { const int kk = (k & ~0xC) | ((k & 4) << 1) | ((k & 8) >> 1); return ((kk >> 3) * 4 + (c >> 5)) * 512 + ((kk & 7) * 32 + (c & 31)) * 2; }
__device__ __forceinline__ int v_rd_base(int lane) { return ((lane & 3) << 3) | (((lane >> 2) & 3) << 6) | (((lane >> 4) & 1) << 5) | (((lane >> 5) & 1) << 8); }
constexpr int v_rd_off(int d0, int ks, int half) { return d0 * 512 + ks * 4096 + half * 2048; }
__device__ __forceinline__ int crow(int r, int hi) { return (r & 3) + 8 * (r >> 2) + 4 * hi; }
__device__ __forceinline__ unsigned cvtpk(float lo, float hi) { unsigned r; asm volatile("v_cvt_pk_bf16_f32 %0, %1, %2" : "=v"(r) : "v"(lo), "v"(hi)); return r; }
__device__ __forceinline__ bf16x8 load8(const bf16* p) { return *reinterpret_cast<const bf16x8*>(p); }
__device__ __forceinline__ void mask_tile(f32x16& p0, f32x16& p1, int dq, unsigned W) {
    const float NEG = -__builtin_inff();
#pragma unroll
    for (int r = 0; r < 16; ++r) {
        const int c = (r & 3) + 8 * (r >> 2);
        if ((unsigned)(dq - c) >= W) p0[r] = NEG;
        if ((unsigned)(dq - c - 32) >= W) p1[r] = NEG;
    }
}
__device__ __forceinline__ void partialSM(f32x16& p0, f32x16& p1, float& m_reg, float& mn, float& alpha) {
    float pmax = p0[0]; for (int r = 1; r < 16; ++r) pmax = fmaxf(pmax, p0[r]); for (int r = 0; r < 16; ++r) pmax = fmaxf(pmax, p1[r]);
    { auto rr = __builtin_amdgcn_permlane32_swap(__float_as_uint(pmax), __float_as_uint(pmax), false, false);
      pmax = fmaxf(__uint_as_float(rr[0]), __uint_as_float(rr[1])); }
    if (__builtin_expect(__all((pmax - m_reg) <= THR), 1)) { mn = m_reg; alpha = 1.f; }
    else { mn = fmaxf(m_reg, pmax); alpha = __builtin_amdgcn_exp2f(m_reg - mn); m_reg = mn; }
    for (int r = 0; r < 16; ++r) p0[r] = p0[r] - mn; for (int r = 0; r < 16; ++r) p1[r] = p1[r] - mn;
    for (int r = 0; r < 16; ++r) p0[r] = __builtin_amdgcn_exp2f(p0[r]);
}
__device__ __forceinline__ void finishSM(f32x16& p0, f32x16& p1, float alpha, float& l_reg, bf16x8& pa0, bf16x8& pa1, bf16x8& pa2, bf16x8& pa3) {
    for (int r = 0; r < 16; ++r) p1[r] = __builtin_amdgcn_exp2f(p1[r]);
    float ps = 0; for (int r = 0; r < 16; ++r) ps += p0[r]; for (int r = 0; r < 16; ++r) ps += p1[r];
    { auto rr = __builtin_amdgcn_permlane32_swap(__float_as_uint(ps), __float_as_uint(ps), false, false);
      ps = __uint_as_float(rr[0]) + __uint_as_float(rr[1]); }
    l_reg = l_reg * alpha + ps;
#define PK4(P, B_, OUT) do { unsigned a0 = cvtpk(P[B_+0], P[B_+1]), a1 = cvtpk(P[B_+2], P[B_+3]);                          \
        unsigned b0 = cvtpk(P[B_+4], P[B_+5]), b1 = cvtpk(P[B_+6], P[B_+7]);                                             \
        auto r0 = __builtin_amdgcn_permlane32_swap(a0, b0, false, false); auto r1 = __builtin_amdgcn_permlane32_swap(a1, b1, false, false); \
        u32x4 w = {r0[0], r1[0], r0[1], r1[1]}; OUT = *reinterpret_cast<bf16x8*>(&w); } while (0)
    PK4(p0, 0, pa0); PK4(p0, 8, pa1); PK4(p1, 0, pa2); PK4(p1, 8, pa3);
#undef PK4
}
template <int KB, bool EXT>
__device__ __forceinline__ void qkt(f32x16& p0, f32x16& p1, const char* K_lds, const char* X_lds, int r32, int hi, const bf16x8* qr, const char* qxl) {
    p0 = f32x16{}; p1 = f32x16{};
    const char* kb[4];
#pragma unroll
    for (int dd = 0; dd < 4; ++dd) kb[dd] = K_lds + KB * SHM_K + KSWZ(r32, (dd * 16 + hi * 8) * 2);
#pragma unroll
    for (int d0 = 0; d0 < 8; ++d0) { const char* a = kb[d0 & 3] + (d0 >> 2) * 128;
        bf16x8 b0 = *reinterpret_cast<const bf16x8*>(a);
        bf16x8 b1 = *reinterpret_cast<const bf16x8*>(a + 32 * 256);
        bf16x8 qf; if (EXT && d0 >= 8 - QL) qf = *reinterpret_cast<const bf16x8*>(qxl + (4 + d0 - (8 - QL)) * 1024); else qf = qr[d0];
        p0 = __builtin_amdgcn_mfma_f32_32x32x16_bf16(b0, qf, p0, 0, 0, 0);
        p1 = __builtin_amdgcn_mfma_f32_32x32x16_bf16(b1, qf, p1, 0, 0, 0); }
    if constexpr (EXT) { const char* xb = X_lds + KB * SHM_X + r32 * XROW + hi * 16;
#pragma unroll
        for (int dd = 0; dd < 4; ++dd) {
            bf16x8 b0 = *reinterpret_cast<const bf16x8*>(xb + dd * 32);
            bf16x8 b1 = *reinterpret_cast<const bf16x8*>(xb + dd * 32 + 32 * XROW);
            const bf16x8 qf = *reinterpret_cast<const bf16x8*>(qxl + dd * 1024);
            p0 = __builtin_amdgcn_mfma_f32_32x32x16_bf16(b0, qf, p0, 0, 0, 0);
            p1 = __builtin_amdgcn_mfma_f32_32x32x16_bf16(b1, qf, p1, 0, 0, 0); } }
}
template <int VB>
__device__ __forceinline__ void pv_tile(f32x16* o, int vb0, bf16x8 pa0, bf16x8 pa1, bf16x8 pa2, bf16x8 pa3) {
#define TRRD(dst, off) asm volatile("ds_read_b64_tr_b16 %0, %1 offset:%2" : "=&v"(dst) : "v"(vb0), "i"(off) : "memory")
#define PV_D0(d0) do { s16x4 l0, l1, l2, l3, h0, h1, h2, h3; constexpr int b_ = VB * SHM_V + v_rd_off(d0, 0, 0);     \
        TRRD(l0, b_); TRRD(h0, b_ + 2048); TRRD(l1, b_ + 4096); TRRD(h1, b_ + 6144); TRRD(l2, b_ + 8192); TRRD(h2, b_ + 10240); TRRD(l3, b_ + 12288); TRRD(h3, b_ + 14336); \
        asm volatile("s_waitcnt lgkmcnt(0)" ::: "memory"); SBAR();   \
        o[d0] = __builtin_amdgcn_mfma_f32_32x32x16_bf16(pa0, (bf16x8){l0[0], l0[1], l0[2], l0[3], h0[0], h0[1], h0[2], h0[3]}, o[d0], 0, 0, 0);   \
        o[d0] = __builtin_amdgcn_mfma_f32_32x32x16_bf16(pa1, (bf16x8){l1[0], l1[1], l1[2], l1[3], h1[0], h1[1], h1[2], h1[3]}, o[d0], 0, 0, 0);   \
        o[d0] = __builtin_amdgcn_mfma_f32_32x32x16_bf16(pa2, (bf16x8){l2[0], l2[1], l2[2], l2[3], h2[0], h2[1], h2[2], h2[3]}, o[d0], 0, 0, 0);   \
        o[d0] = __builtin_amdgcn_mfma_f32_32x32x16_bf16(pa3, (bf16x8){l3[0], l3[1], l3[2], l3[3], h3[0], h3[1], h3[2], h3[3]}, o[d0], 0, 0, 0); } while (0)
    PV_D0(0); PV_D0(1); PV_D0(2); PV_D0(3);
#undef PV_D0
#undef TRRD
}

struct BlockRef { const bf16* Q; const bf16* K; const bf16* V; const bf16* QX; const bf16* KX; bf16* O; const float* G; int P0; };
template <bool EXT> struct Seam { bf16x8 qr[8]; bf16x8 qx[4]; bf16x8 st_v0, st_v1, st_k0, st_k1, st_x; };
__device__ __forceinline__ int swa_jlo(int P0, int W) { const int lowk = P0 - W + 1; return lowk > 0 ? lowk / KVBLK : 0; }
#define VMW() asm volatile("s_waitcnt vmcnt(0)" ::: "memory")
#define VMWN(n) asm volatile("s_waitcnt vmcnt(%0)" :: "i"(n) : "memory")
#define SLOAD_H(R, k0) do { S.st_v0 = load8((R).V + (size_t)((k0) + sr) * D + sc); S.st_v1 = load8((R).V + (size_t)((k0) + 32 + sr) * D + sc);              \
                            S.st_k0 = load8((R).K + (size_t)((k0) + sr) * D + sc); S.st_k1 = load8((R).K + (size_t)((k0) + 32 + sr) * D + sc);              \
                            if constexpr (EXT) S.st_x = load8((R).KX + (size_t)((k0) + xr) * 64 + xc * 8); } while (0)
#define SWRITE_HK(bf) do { *(bf16x8*)(K_lds + (bf) * SHM_K + kws) = S.st_k0; *(bf16x8*)(K_lds + (bf) * SHM_K + kws + 32 * 256) = S.st_k1; \
                           if constexpr (EXT) *(bf16x8*)(X_lds + (bf) * SHM_X + xws) = S.st_x; } while (0)
#define SWRITE_HV(bf) do { *(bf16x8*)(V_lds + (bf) * SHM_V + vst0) = S.st_v0; *(bf16x8*)(V_lds + (bf) * SHM_V + vst1) = S.st_v1; } while (0)
#define SWRITE_H(bf) do { SWRITE_HV(bf); SWRITE_HK(bf); } while (0)
#define QLOADS(R) do { _Pragma("unroll") for (int d0 = 0; d0 < 8; ++d0) S.qr[d0] = load8((R).Q + (size_t)(wid * QBLK + r32) * D + d0 * 16 + hi * 8); \
                       if constexpr (EXT) { _Pragma("unroll") for (int dd = 0; dd < 4; ++dd) S.qx[dd] = load8((R).QX + (size_t)(wid * QBLK + r32) * 64 + dd * 16 + hi * 8); } } while (0)
template <bool EXT>
__device__ __forceinline__ void attn_prime(const BlockRef& cur, int W, char* lds, Seam<EXT>& S, int tid_in) {
    int tid_ = tid_in; asm volatile("" : "+v"(tid_));
    const int tid = tid_, wid = __builtin_amdgcn_readfirstlane(tid >> 6), lane = tid & 63, r32 = lane & 31, hi = lane >> 5;
    const int sr = tid >> 4, sc = (tid & 15) * 8, kws = KSWZ(sr, sc * 2), xr = tid >> 3, xc = tid & 7, xws = xr * XROW + xc * 16;
    char* K_lds = lds + OFF_K; char* X_lds = lds + OFF_X;
    const int kb0 = swa_jlo(cur.P0, W) * KVBLK;
    QLOADS(cur);
    SLOAD_H(cur, kb0); VMW(); SWRITE_HK(0);
    __syncthreads();
}
template <bool EXT, bool NORM, int LDO>
__device__ __forceinline__ void attn_block(const BlockRef& cur, const BlockRef& nxt, int skv, int W, char* lds, Seam<EXT>& S, int tid_in) {
    int tid_ = tid_in; asm volatile("" : "+v"(tid_));
    const int tid = tid_, wid = __builtin_amdgcn_readfirstlane(tid >> 6), lane = tid & 63, r32 = lane & 31, hi = lane >> 5;
    const int j_lo = swa_jlo(cur.P0, W);
    int j_hi = (cur.P0 + QB - 1) / KVBLK + 1; if (j_hi > skv / KVBLK) j_hi = skv / KVBLK;
    const int NT = j_hi - j_lo;
    const int kbn = swa_jlo(nxt.P0, W) * KVBLK;
    const int qlo = cur.P0 + wid * QBLK, qm = qlo + r32 - 4 * hi;
    char* V_lds = lds + OFF_V; char* K_lds = lds + OFF_K; char* X_lds = lds + OFF_X;
    float* ws = (float*)(lds + OFF_WS) + wid * 64; float* li_l = ws, * al_l = ws + 32;
    char* qxl = lds + OFF_QX + wid * QXW + lane * 16;
    float m_reg = -1e30f, l_reg = 0; f32x16 o[4] = {};
    const int sr = tid >> 4, sc = (tid & 15) * 8, vst0 = v_st(sr, sc), vst1 = v_st(32 + sr, sc), kws = KSWZ(sr, sc * 2), xr = tid >> 3, xc = tid & 7, xws = xr * XROW + xc * 16;
    const int vb0 = (int)(uintptr_t)V_lds + v_rd_base(lane);
#define RESC(a) do { if (__any((a) < 1.f)) { if (hi == 0) al_l[r32] = (a); asm volatile("s_waitcnt lgkmcnt(0)" ::: "memory");              \
                     for (int d_ = 0; d_ < 4; ++d_) for (int r = 0; r < 16; ++r) o[d_][r] *= al_l[crow(r, hi)]; } } while (0)
#define KBASE(t) ((j_lo + (t)) * KVBLK)
#define MASKT(P0_, P1_, t) do { const int kb_ = KBASE(t); if (kb_ + KVBLK - 1 > qlo || kb_ <= qlo + QBLK - 1 - W) mask_tile(P0_, P1_, qm - kb_, (unsigned)W); } while (0)
    constexpr int NQL = EXT ? 12 : 8;
#define SEAM_K0() do { VMWN(NQL); SWRITE_HK(0); SBAR(); } while (0)
    f32x16 pA0, pA1, pB0, pB1; float mnA, mnB, alA, alB; bf16x8 pa0, pa1, pa2, pa3;
    SWRITE_HV(0); SBAR();
    if constexpr (EXT) { _Pragma("unroll") for (int dd = 0; dd < 4; ++dd) *reinterpret_cast<bf16x8*>(qxl + dd * 1024) = S.qx[dd];
        _Pragma("unroll") for (int d0 = 8 - QL; d0 < 8; ++d0) *reinterpret_cast<bf16x8*>(qxl + (4 + d0 - (8 - QL)) * 1024) = S.qr[d0]; SBAR(); }
    if (NT > 1) { SLOAD_H(cur, KBASE(1)); }
    SBAR(); qkt<0, EXT>(pA0, pA1, K_lds, X_lds, r32, hi, S.qr, qxl);
    MASKT(pA0, pA1, 0); partialSM(pA0, pA1, m_reg, mnA, alA);
    if (NT > 1) { VMW(); SWRITE_H(1); }
    __syncthreads();
#define HALF_STEP(PX0, PX1, mnX, alX, PY0, PY1, alY, t, KB, VB, SB) do {                                                      \
        SBAR(); qkt<KB, EXT>(PX0, PX1, K_lds, X_lds, r32, hi, S.qr, qxl);                                                     \
        finishSM(PY0, PY1, alY, l_reg, pa0, pa1, pa2, pa3); SBAR();                                                           \
        if ((t) + 1 < NT) { SLOAD_H(cur, KBASE((t) + 1)); SBAR(); }                                                           \
        pv_tile<VB>(o, vb0, pa0, pa1, pa2, pa3); MASKT(PX0, PX1, (t)); partialSM(PX0, PX1, m_reg, mnX, alX);                  \
        __syncthreads();                                                                                                      \
        if ((t) + 1 < NT) { VMW(); SWRITE_H(SB); }                                                                            \
        RESC(alX); __syncthreads(); } while (0)
    for (int t = 1; t + 1 < NT; t += 2) {
        HALF_STEP(pB0, pB1, mnB, alB, pA0, pA1, alA, t, 1, 0, 0);
        HALF_STEP(pA0, pA1, mnA, alA, pB0, pB1, alB, t + 1, 0, 1, 1);
    }
    const bool even = (NT & 1) == 0;
    if (even) { SBAR(); qkt<1, EXT>(pB0, pB1, K_lds, X_lds, r32, hi, S.qr, qxl); SBAR(); }
    SLOAD_H(nxt, kbn); SBAR();
    QLOADS(nxt);
    SBAR();
    finishSM(pA0, pA1, alA, l_reg, pa0, pa1, pa2, pa3); SBAR();
    pv_tile<0>(o, vb0, pa0, pa1, pa2, pa3);
    if (even) { MASKT(pB0, pB1, NT - 1); partialSM(pB0, pB1, m_reg, mnB, alB); __syncthreads(); RESC(alB);
        finishSM(pB0, pB1, alB, l_reg, pa0, pa1, pa2, pa3); SBAR(); pv_tile<1>(o, vb0, pa0, pa1, pa2, pa3); }
    SBAR(); SEAM_K0();
    if (hi == 0) li_l[r32] = l_reg; asm volatile("s_waitcnt lgkmcnt(0)" ::: "memory");
    float rli[16];
#pragma unroll
    for (int r = 0; r < 16; ++r) rli[r] = __builtin_amdgcn_rcpf(li_l[crow(r, hi)]);
    if constexpr (NORM) {
        float g4[4];
#pragma unroll
        for (int d0 = 0; d0 < 4; ++d0) g4[d0] = cur.G[d0 * 32 + r32];
#pragma unroll
        for (int r = 0; r < 16; ++r) { float ss = 0.f;
#pragma unroll
            for (int d0 = 0; d0 < 4; ++d0) { o[d0][r] *= rli[r]; ss += o[d0][r] * o[d0][r]; }
            ss += __shfl_xor(ss, 1); ss += __shfl_xor(ss, 2); ss += __shfl_xor(ss, 4); ss += __shfl_xor(ss, 8); ss += __shfl_xor(ss, 16);
            rli[r] = __builtin_amdgcn_rsqf(ss * (1.0f / 128.0f) + RMS_EPS); }
#pragma unroll
        for (int r = 0; r < 16; ++r)
#pragma unroll
            for (int d0 = 0; d0 < 4; ++d0) o[d0][r] *= rli[r] * g4[d0];
    } else {
#pragma unroll
        for (int r = 0; r < 16; ++r)
#pragma unroll
            for (int d0 = 0; d0 < 4; ++d0) o[d0][r] *= rli[r];
    }
    bf16* Ow = cur.O + (size_t)(wid * QBLK) * LDO;
#pragma unroll
    for (int r = 0; r < 16; ++r) { const int orow = crow(r, hi);
#pragma unroll
        for (int d0 = 0; d0 < 4; ++d0) { const float v = o[d0][r];
            const float vn = __shfl_xor(v, 1);
            if ((r32 & 1) == 0) *(unsigned*)(Ow + (size_t)orow * LDO + d0 * 32 + r32) = cvtpk(v, vn); } }
    __syncthreads();
#undef RESC
#undef KBASE
#undef MASKT
#undef SEAM_K0
#undef HALF_STEP
}
#undef VMW
#undef VMWN
#undef SLOAD_H
#undef SWRITE_HK
#undef SWRITE_HV
#undef SWRITE_H
#undef QLOADS
#undef KSWZ
}
constexpr int NWAVES = 8;
constexpr int BATCH = 2, SEQ = 8192, DM = 4096, DEPTH = 4, M = BATCH * SEQ;
constexpr int IN_COLS = 8520, NIN = 8704, DFF = 16384, MEMT = 256;
constexpr float EPS = 1e-6f;
constexpr float LOG2E = 1.4426950408889634f;
constexpr float QSCALE_MLA = 0.07216878364870323f * LOG2E;
constexpr float QSCALE_128 = 0.08838834764831845f * LOG2E;

constexpr size_t MiB = 1u << 20;
constexpr size_t WS_CTL = 0, CTL_ZERO_BYTES = 1 * MiB;
constexpr size_t WS_ROPE = 1 * MiB;
constexpr size_t WS_LB = 5 * MiB;
constexpr size_t WS_FOXLF = 5 * MiB + 512 * 1024;
constexpr size_t WS_ADEC = 6 * MiB;
constexpr size_t WS_MEMN = 8 * MiB;
constexpr size_t WS_KVMEM = 24 * MiB;
constexpr size_t WS_W = 32 * MiB, W_LAYER = 384 * MiB;
constexpr size_t W_IN = 0, W_UQ = 68 * MiB, W_UKV = 73 * MiB, W_O = 77 * MiB, W_MQ = 109 * MiB, W_MKV = 113 * MiB, W_MO = 121 * MiB, W_FF1 = 125 * MiB, W_FF2 = 253 * MiB;
constexpr size_t WS_HN = 1568 * MiB;
constexpr size_t WS_Y = 1696 * MiB;
constexpr size_t WS_QMEM = 1952 * MiB, WS_OMEM = 1968 * MiB;
constexpr size_t WS_MIXER = 1984 * MiB;
constexpr size_t WS_PROJ = WS_MIXER  , WS_FOX = WS_MIXER + 128 * MiB  , WS_LOGF = WS_MIXER + 224 * MiB, WS_PROJX = WS_MIXER + 288 * MiB, WS_CQN = WS_MIXER + 384 * MiB, WS_CKVN = WS_MIXER + 408 * MiB,
                 WS_KROT = WS_MIXER + 424 * MiB, WS_QN = WS_MIXER + 426 * MiB, WS_QR = WS_MIXER + 490 * MiB, WS_KN = WS_MIXER + 522 * MiB, WS_VC = WS_MIXER + 586 * MiB, WS_LT = WS_MIXER + 650 * MiB,
                 WS_ST = WS_MIXER + 778 * MiB, WS_MIX = WS_MIXER + 842 * MiB, WS_QEXT = WS_MIXER + 970 * MiB, WS_KEXT = WS_MIXER + 986 * MiB, WS_MIXER_END = WS_MIXER + 1002 * MiB;
constexpr size_t WS_HID = WS_MIXER;
constexpr size_t WS_END = WS_MIXER_END;
static_assert(WS_HID + 512 * MiB <= WS_MIX, "hidden overlay must not reach MIX/QEXT/KEXT");
constexpr int CW_BAR = 4096;

constexpr int RING_BYTES = 155648;
constexpr int LDSCTL_OFF = RING_BYTES, MISC_OFF = LDSCTL_OFF + 320;
constexpr int LDS_BYTES = 157696;
static_assert(MISC_OFF + 128 <= LDS_BYTES && att::ATT_LDS_BYTES <= RING_BYTES, "LDS map");

#define GAS __attribute__((address_space(1)))
#define LAS __attribute__((address_space(3)))
typedef unsigned short bf16;
typedef unsigned v4u __attribute__((ext_vector_type(4)));
typedef unsigned v2u __attribute__((ext_vector_type(2)));
typedef float f32x4 __attribute__((ext_vector_type(4)));
typedef float f32x2 __attribute__((ext_vector_type(2)));
typedef float f32x16 __attribute__((ext_vector_type(16)));
typedef short bf16x8 __attribute__((ext_vector_type(8)));
typedef GAS unsigned gu32;
#define RLX_AGENT __ATOMIC_RELAXED, __HIP_MEMORY_SCOPE_AGENT
#define LDS_WAIT() asm volatile("s_waitcnt lgkmcnt(0)" ::: "memory")
#define VM_WAIT() asm volatile("s_waitcnt vmcnt(0)" ::: "memory")
__device__ __forceinline__ unsigned f2bf(float f) { unsigned u = __builtin_bit_cast(unsigned, f); return (u + 0x7fffu + ((u >> 16) & 1u)) >> 16; }
__device__ __forceinline__ unsigned pk2(float lo, float hi) { return f2bf(lo) | (f2bf(hi) << 16); }
__device__ __forceinline__ float bf2f(unsigned short b) { return __builtin_bit_cast(float, ((unsigned)b) << 16); }
__device__ __forceinline__ float bflo(unsigned w) { return __builtin_bit_cast(float, w << 16); }
__device__ __forceinline__ float bfhi(unsigned w) { return __builtin_bit_cast(float, w & 0xffff0000u); }

#define XB_TMO      128
#define XB_XCNT(j)  (256  + 64 * (j))
#define XB_XSUB(j)  (1280 + 64 * (j))
#define XB_XGEN(j)  (2304 + 64 * (j))
#define XB_TOP      3328
#define XB_TOPGEN   3392
#define XCD_BAR_WORDS 3456
#define XB_SPIN_CAP (1u << 22)
__device__ __forceinline__ unsigned xb_ld(unsigned* p)              { return __hip_atomic_load(p, __ATOMIC_RELAXED, __HIP_MEMORY_SCOPE_AGENT); }
__device__ __forceinline__ unsigned xb_add(unsigned* p, unsigned v) { return __hip_atomic_fetch_add(p, v, __ATOMIC_RELAXED, __HIP_MEMORY_SCOPE_AGENT); }
__device__ __forceinline__ unsigned xb_xcc_id() { return (unsigned)__builtin_amdgcn_s_getreg((3 << 11) | 20) & 0xFu; }
#define XB_SPIN(cond, bar) do { unsigned _sp = 0; while (cond) { __builtin_amdgcn_s_sleep(1); \
    if ((++_sp & 255u) == 0u) { if (xb_ld(&(bar)[XB_TMO])) break; if (_sp > XB_SPIN_CAP) { atomicAdd(&(bar)[XB_TMO], 1u); break; } } } } while (0)
struct XcdBarrier { unsigned* bar; unsigned x; volatile LAS unsigned* st; };
__device__ __forceinline__ XcdBarrier xcd_barrier_post(unsigned* bar, volatile LAS unsigned* st) {
    XcdBarrier b; b.bar = bar; b.x = xb_xcc_id(); b.st = st;
    if (threadIdx.x == 0) (void)xb_add(&bar[XB_XCNT(b.x)], 1u);
    return b;
}
__device__ __forceinline__ void xcd_barrier_complete(unsigned* bar, unsigned x, unsigned& nloc, unsigned& nx) {
    const unsigned G = gridDim.x * gridDim.y * gridDim.z;
    unsigned sum, cnt, mine, sp = 0u;
    for (;;) {
        sum = 0u; cnt = 0u; mine = 0u;
#pragma unroll
        for (unsigned j = 0; j < 16; ++j) { const unsigned c = xb_ld(&bar[XB_XCNT(j)]); sum += c; cnt += (c > 0u) ? 1u : 0u; mine = (j == x) ? c : mine; }
        if (sum == G) break;
        __builtin_amdgcn_s_sleep(1);
        if ((++sp & 255u) == 0u) { if (xb_ld(&bar[XB_TMO])) break; if (sp > XB_SPIN_CAP) { atomicAdd(&bar[XB_TMO], 1u); break; } }
    }
    nloc = mine > 0u ? mine : 1u; nx = cnt > 0u ? cnt : 1u;
}
__device__ __forceinline__ void xcd_barrier(const XcdBarrier& b, bool leader  ) {
    asm volatile("s_waitcnt vmcnt(0)" ::: "memory");
    __syncthreads();
    if (leader) {
        unsigned* bar = b.bar; unsigned bx_ = b.x; asm volatile("" : "+s"(bar), "+s"(bx_));
        __builtin_amdgcn_s_waitcnt(0);
        unsigned nloc = b.st[0], nx = b.st[1];
        if (nloc == 0u) { xcd_barrier_complete(bar, bx_, nloc, nx); b.st[0] = nloc; b.st[1] = nx; }
        const unsigned old = xb_add(&bar[XB_XSUB(bx_)], 1u);
        const unsigned gen = old / nloc;
        if (old + 1u == (gen + 1u) * nloc) {
            __builtin_amdgcn_fence(__ATOMIC_RELEASE, "agent");
            asm volatile("s_waitcnt vmcnt(0)" ::: "memory");
            const unsigned og = xb_add(&bar[XB_TOP], 1u);
            const unsigned tg = og / nx;
            if (og + 1u == (tg + 1u) * nx) xb_add(&bar[XB_TOPGEN], 1u);
            else XB_SPIN(xb_ld(&bar[XB_TOPGEN]) == tg, bar);
            __builtin_amdgcn_fence(__ATOMIC_ACQUIRE, "agent");
            xb_add(&bar[XB_XGEN(bx_)], 1u);
            asm volatile("s_waitcnt vmcnt(0)" ::: "memory");
        } else {
            XB_SPIN(xb_ld(&bar[XB_XGEN(bx_)]) == gen, bar);
            __builtin_amdgcn_fence(__ATOMIC_ACQUIRE, "agent");
            asm volatile("s_waitcnt vmcnt(0)" ::: "memory");
        }
    }
    __syncthreads();
}

struct Frame {
    LAS unsigned char* lds; char* ldsg;
    volatile LAS unsigned* MISC;
    int tid, lane, wave;
    int vcu, G, bx;
};
__device__ __forceinline__ int fresh_tid(int wave) { int ln_; asm volatile("v_mbcnt_lo_u32_b32 %0, -1, 0\n\tv_mbcnt_hi_u32_b32 %0, -1, %0" : "=v"(ln_)); return wave * 64 + ln_; }
__device__ __forceinline__ float wave_sum(float v) {
#pragma unroll
    for (int o = 1; o < 64; o <<= 1) v += __shfl_xor(v, o);
    return v;
}

template <int MAP> __device__ __forceinline__ int old_col(int n) {
    if (MAP == 0) return n;
    if (MAP == 1) { if (n < 7168) return n; if (n < 8512) return n + 8; if (n < 8520) return n - 8512 + 7168; return -1; }
    if (n < 2048) return (n >> 7) * 192 + (n & 127);
    { const int e = n - 2048, h = e >> 6, w = e & 63, i = w >> 1, p = w & 1; return h * 192 + 128 + i + 32 * p; }
}
template <int MAP>
__device__ __forceinline__ void p0_transpose_item(const float* W, int K, int N, bf16* WT, int row_off, int nblk, LAS float* scr, int item, int lane) {
    const int kb = item / nblk, nb = item % nblk, k0 = 64 * kb, n0 = 32 * nb;
    const int oc = old_col<MAP>(n0 + (lane & 31));
#pragma unroll 8
    for (int i = 0; i < 32; ++i) { const int kk = 2 * i + (lane >> 5); scr[kk * 33 + (lane & 31)] = oc >= 0 ? W[(size_t)(k0 + kk) * N + oc] : 0.f; }
    LDS_WAIT(); asm volatile("" ::: "memory");
    const int c = lane & 7;
#pragma unroll
    for (int j = 0; j < 4; ++j) { const int n = (lane >> 3) + 8 * j; const LAS float* s = scr + (8 * c) * 33 + n;
        v4u o; o.x = pk2(s[0 * 33], s[1 * 33]); o.y = pk2(s[2 * 33], s[3 * 33]); o.z = pk2(s[4 * 33], s[5 * 33]); o.w = pk2(s[6 * 33], s[7 * 33]);
        *(GAS v4u*)(WT + (size_t)(row_off + n0 + n) * K + k0 + 8 * c) = o; }
    LDS_WAIT(); asm volatile("" ::: "memory");
}
template <bool HAS_Y, bool WRITE_H, bool WRITE_HN>
__device__ __forceinline__ void norm_row(int lane, const float* hin, const float* y, const float* gpost, float* hout, const float* gpre, bf16* hn) {
    f32x4 hv[16];
    if constexpr (HAS_Y) {
        f32x4 yv[16]; float ss = 0.f;
#pragma unroll
        for (int j = 0; j < 16; ++j) { yv[j] = *((const GAS f32x4*)y + lane + 64 * j); ss += (yv[j].x * yv[j].x + yv[j].y * yv[j].y) + (yv[j].z * yv[j].z + yv[j].w * yv[j].w); }
        const float rstd = __builtin_amdgcn_rsqf(wave_sum(ss) * (1.f / DM) + EPS);
#pragma unroll
        for (int j = 0; j < 16; ++j) { const f32x4 g = *((const GAS f32x4*)gpost + lane + 64 * j); const f32x4 h0 = *((const GAS f32x4*)hin + lane + 64 * j); hv[j] = h0 + yv[j] * rstd * g; }
    } else {
#pragma unroll
        for (int j = 0; j < 16; ++j) hv[j] = *((const GAS f32x4*)hin + lane + 64 * j);
    }
    if constexpr (WRITE_H) {
#pragma unroll
        for (int j = 0; j < 16; ++j) *((GAS f32x4*)hout + lane + 64 * j) = hv[j];
    }
    if constexpr (WRITE_HN) {
        float s2 = 0.f;
#pragma unroll
        for (int j = 0; j < 16; ++j) s2 += (hv[j].x * hv[j].x + hv[j].y * hv[j].y) + (hv[j].z * hv[j].z + hv[j].w * hv[j].w);
        const float rstd2 = __builtin_amdgcn_rsqf(wave_sum(s2) * (1.f / DM) + EPS);
#pragma unroll
        for (int j = 0; j < 16; ++j) { const f32x4 g = *((const GAS f32x4*)gpre + lane + 64 * j); const f32x4 v = hv[j] * rstd2 * g;
            v2u w; w.x = pk2(v.x, v.y); w.y = pk2(v.z, v.w); *((GAS v2u*)hn + lane + 64 * j) = w; }
    }
}
struct Args { const float* in[25]; float* out; unsigned char* ws; int ph_lo, ph_hi; };
typedef const __attribute__((address_space(4))) Args CArgs;
struct Ptrs { const CArgs* a; float* out; unsigned char* ws;
    __device__ __forceinline__ const float* inp(int k) const { return a->in[k]; } };
#define WSP(T, off) ((T*)(P.ws + (off)))
#define WLAYER(T, l, off) ((T*)(P.ws + WS_W + (size_t)(l) * W_LAYER + (off)))

__device__ __forceinline__ void p0_prologue(Frame& F, const Ptrs& P) {
    LAS float* scr = (LAS float*)(F.lds + F.wave * 16384);
    const int gw = F.vcu * NWAVES + F.wave, NGW = F.G * NWAVES;
    constexpr int I_IN = (DM / 64) * (NIN / 32), I_UQ = (768 / 64) * (3072 / 32), I_UKV = (512 / 64) * (4096 / 32), I_O = (DM / 64) * (DM / 32), I_MQ = (DM / 64) * (512 / 32),
                  I_MO = (512 / 64) * (DM / 32), I_F1 = (DM / 64) * (DFF / 32), I_F2 = (DFF / 64) * (DM / 32);
    constexpr int PER_LAYER = I_IN + I_UQ + I_UKV + I_O + 3 * I_MQ + I_MO + I_F1 + I_F2;
    for (int it = gw; it < DEPTH * PER_LAYER; it += NGW) {
        const int l = it / PER_LAYER; int r = it - l * PER_LAYER;
        if (r < I_IN) { p0_transpose_item<1>(P.inp(3) + (size_t)l * DM * IN_COLS, DM, IN_COLS, WLAYER(bf16, l, W_IN), 0, NIN / 32, scr, r, F.lane); continue; } r -= I_IN;
        if (r < I_UQ) { p0_transpose_item<2>(P.inp(8) + (size_t)l * 768 * 3072, 768, 3072, WLAYER(bf16, l, W_UQ), 0, 3072 / 32, scr, r, F.lane); continue; } r -= I_UQ;
        if (r < I_UKV) { p0_transpose_item<0>(P.inp(9) + (size_t)l * 512 * 4096, 512, 4096, WLAYER(bf16, l, W_UKV), 0, 4096 / 32, scr, r, F.lane); continue; } r -= I_UKV;
        if (r < I_O) { p0_transpose_item<0>(P.inp(11) + (size_t)l * DM * DM, DM, DM, WLAYER(bf16, l, W_O), 0, DM / 32, scr, r, F.lane); continue; } r -= I_O;
        if (r < I_MQ) { p0_transpose_item<0>(P.inp(13) + (size_t)l * DM * 512, DM, 512, WLAYER(bf16, l, W_MQ), 0, 512 / 32, scr, r, F.lane); continue; } r -= I_MQ;
        if (r < I_MQ) { p0_transpose_item<0>(P.inp(14) + (size_t)l * DM * 512, DM, 512, WLAYER(bf16, l, W_MKV), 0, 512 / 32, scr, r, F.lane); continue; } r -= I_MQ;
        if (r < I_MQ) { p0_transpose_item<0>(P.inp(15) + (size_t)l * DM * 512, DM, 512, WLAYER(bf16, l, W_MKV), 512, 512 / 32, scr, r, F.lane); continue; } r -= I_MQ;
        if (r < I_MO) { p0_transpose_item<0>(P.inp(16) + (size_t)l * 512 * DM, 512, DM, WLAYER(bf16, l, W_MO), 0, DM / 32, scr, r, F.lane); continue; } r -= I_MO;
        if (r < I_F1) { p0_transpose_item<0>(P.inp(17) + (size_t)l * DM * DFF, DM, DFF, WLAYER(bf16, l, W_FF1), 0, DFF / 32, scr, r, F.lane); continue; } r -= I_F1;
        p0_transpose_item<0>(P.inp(18) + (size_t)l * DFF * DM, DFF, DM, WLAYER(bf16, l, W_FF2), 0, DM / 32, scr, r, F.lane);
    }
    for (int m = gw; m < M; m += NGW) norm_row<false, false, true>(F.lane, P.inp(0) + (size_t)m * DM, nullptr, nullptr, nullptr, P.inp(19), WSP(bf16, WS_HN) + (size_t)m * DM);
    for (int m = gw; m < DEPTH * BATCH * MEMT; m += NGW) { const int l = m / (BATCH * MEMT), r = m % (BATCH * MEMT);
        norm_row<false, false, true>(F.lane, P.inp(1) + (size_t)r * DM, nullptr, nullptr, nullptr, P.inp(12) + (size_t)l * DM, WSP(bf16, WS_MEMN) + (size_t)m * DM); }
    { const int gt = gw * 64 + F.lane, NT = NGW * 64; const int* pos = (const int*)P.inp(2); f32x2* rope = WSP(f32x2, WS_ROPE);
      for (int e = gt; e < M * 32; e += NT) { const int tok = e >> 5, i = e & 31;
          const float inv = exp2f(-(float)i * (13.287712379549449f / 32.0f));
          const float ang = (float)pos[tok] * inv;
          const double k = rint((double)ang * 0.15915494309189535);
          const float red = (float)((double)ang - k * 6.283185307179586);
          f32x2 cs; cs.x = cosf(red); cs.y = sinf(red); rope[e] = cs; } }
    { const int gt = gw * 64 + F.lane; if (gt < 1024) { const float* G = P.inp(4); float g[4], mx = -3.0e38f;
          for (int l = 0; l < 4; ++l) { g[l] = G[l * 1024 + gt]; mx = fmaxf(mx, g[l]); }
          float e[4], s = 0.f; for (int l = 0; l < 4; ++l) { e[l] = expf(g[l] - mx); s += e[l]; }
          float* LB = WSP(float, WS_LB); float cum = 0.f;
          for (int l = 0; l < 4; ++l) { if (l > 0) cum += e[l] / s; LB[l * 1024 + gt] = fminf(fmaxf(cum, 0.f), 1.0f - 1e-6f); } } }
    { const int gt = gw * 64 + F.lane, NT = NGW * 64; GAS v4u* z = (GAS v4u*)WSP(char, WS_QEXT); const v4u zero = {0u, 0u, 0u, 0u};
      for (int e = gt; e < (int)(32 * MiB / 16); e += NT) z[e] = zero; }
}

__device__ __forceinline__ void p2_rows(Frame& F, const Ptrs& P, int l) {
    const int gw = F.vcu * NWAVES + F.wave, NGW = F.G * NWAVES, lane = F.lane;
    const float* gq = P.inp(6) + l * 768; const float* gkv = P.inp(7) + l * 512; const float* fb = P.inp(5) + l * 8;
    const f32x2* rope = WSP(f32x2, WS_ROPE);
    for (int m = gw; m < M; m += NGW) {
        const float* px = WSP(float, WS_PROJX) + (size_t)m * 1536;
        f32x4 a[3]; float ss = 0.f;
#pragma unroll
        for (int j = 0; j < 3; ++j) { a[j] = *((const GAS f32x4*)px + lane + 64 * j); ss += (a[j].x * a[j].x + a[j].y * a[j].y) + (a[j].z * a[j].z + a[j].w * a[j].w); }
        f32x4 b[2]; float s2 = 0.f;
#pragma unroll
        for (int j = 0; j < 2; ++j) { b[j] = *((const GAS f32x4*)(px + 768) + lane + 64 * j); s2 += (b[j].x * b[j].x + b[j].y * b[j].y) + (b[j].z * b[j].z + b[j].w * b[j].w); }
        const float rq = __builtin_amdgcn_rsqf(wave_sum(ss) * (1.f / 768.f) + EPS), rkv = __builtin_amdgcn_rsqf(wave_sum(s2) * (1.f / 512.f) + EPS);
        bf16* cq = WSP(bf16, WS_CQN) + (size_t)m * 768; bf16* ckv = WSP(bf16, WS_CKVN) + (size_t)m * 512;
#pragma unroll
        for (int j = 0; j < 3; ++j) { const f32x4 g = *((const GAS f32x4*)gq + lane + 64 * j); const f32x4 v = a[j] * rq * g; v2u w; w.x = pk2(v.x, v.y); w.y = pk2(v.z, v.w); *((GAS v2u*)cq + lane + 64 * j) = w; }
#pragma unroll
        for (int j = 0; j < 2; ++j) { const f32x4 g = *((const GAS f32x4*)gkv + lane + 64 * j); const f32x4 v = b[j] * rkv * g; v2u w; w.x = pk2(v.x, v.y); w.y = pk2(v.z, v.w); *((GAS v2u*)ckv + lane + 64 * j) = w; }
        if (lane < 32) { const float x1 = px[1280 + lane], x2 = px[1280 + 32 + lane]; const f32x2 cs = rope[(size_t)m * 32 + lane];
            ((GAS unsigned*)(WSP(bf16, WS_KROT) + (size_t)m * 64))[lane] = pk2(x1 * cs.x - x2 * cs.y, x1 * cs.y + x2 * cs.x); }
        else if (lane < 40) { const int h = lane - 32; const float x = px[1344 + h] + fb[h];
            WSP(float, WS_FOXLF)[(size_t)m * 8 + h] = fminf(x, 0.f) - __logf(1.0f + __expf(-fabsf(x))); }
    }
}

__device__ __forceinline__ void fox_scan(Frame& F, const Ptrs& P, int bh) {
    const int b = bh >> 3, h = bh & 7, tid = F.tid;
    LAS float* wtot = (LAS float*)(F.lds);
    const float* lf = WSP(float, WS_FOXLF) + ((size_t)b * SEQ) * 8 + h;
    float v[16], run = 0.f;
#pragma unroll
    for (int i = 0; i < 16; ++i) { run += lf[(size_t)(tid * 16 + i) * 8]; v[i] = run; }
    float incl = run;
#pragma unroll
    for (int o = 1; o < 64; o <<= 1) { const float t = __shfl_up(incl, o); if (F.lane >= o) incl += t; }
    if (F.lane == 63) wtot[F.wave] = incl;
    LDS_WAIT(); __syncthreads();
    float off = incl - run;
    for (int w = 0; w < F.wave; ++w) off += wtot[w];
    bf16* qe = WSP(bf16, WS_QEXT) + (size_t)bh * SEQ * 64; bf16* ke = WSP(bf16, WS_KEXT) + (size_t)bh * SEQ * 64;
    const unsigned one = 0x3f80u;
#pragma unroll
    for (int i = 0; i < 16; ++i) { const float c = (v[i] + off) * LOG2E;
        const unsigned c1 = f2bf(c); const float r1 = c - bf2f((unsigned short)c1); const unsigned c2 = f2bf(r1); const float r2 = r1 - bf2f((unsigned short)c2); const unsigned c3 = f2bf(r2);
        const size_t t = (size_t)(tid * 16 + i) * 64;
        v4u q; q.x = c1 | (c2 << 16); q.y = c3 | (one << 16); q.z = one | (one << 16); q.w = 0u;
        v4u k; k.x = one | (one << 16); k.y = one | ((c1 ^ 0x8000u) << 16); k.z = (c2 ^ 0x8000u) | ((c3 ^ 0x8000u) << 16); k.w = 0u;
        *(GAS v4u*)(qe + t) = q; *(GAS v4u*)(ke + t) = k; }
    __syncthreads();
}

constexpr int HL_QT = 0, HL_KT = 17408, HL_QH = 34816, HL_VT = 52224, HL_SC = 70656, HL_QTOT = 79872, HL_RS = 81920, HL_KHT = 0  ;
__device__ __forceinline__ float clampe(float x) { return __expf(fminf(x, 80.f)); }
__device__ __forceinline__ void hgrn_local(Frame& F, const Ptrs& P, int ch) {
    const int tid = F.tid, col = tid & 127, q = tid >> 7, t0 = 16 * q;
    const int bh = ch >> 7, n = ch & 127, b = bh >> 3, h = bh & 7;
    const size_t tok0 = (size_t)b * SEQ + (size_t)n * 64; const int cb = h * 128;
    const float* logf = WSP(float, WS_LOGF); const bf16* proj = WSP(bf16, WS_PROJ);
    LAS float* QTOT = (LAS float*)(F.lds + HL_QTOT);
    float bl[16], run = 0.f;
#pragma unroll
    for (int i = 0; i < 16; ++i) { run += logf[(tok0 + t0 + i) * 1024 + cb + col]; bl[i] = run; }
    QTOT[q * 128 + col] = run;
    LDS_WAIT(); __syncthreads();
    float off = 0.f, bend = 0.f;
#pragma unroll
    for (int qq = 0; qq < 4; ++qq) { const float t = QTOT[qq * 128 + col]; bend += t; if (qq < q) off += t; }
    unsigned kw[8], vw[8];
#pragma unroll
    for (int i = 0; i < 16; i += 2) {
        const float k0 = bf2f(proj[(tok0 + t0 + i) * 4096 + 1024 + cb + col]) * __expf(bend - (bl[i] + off));
        const float k1 = bf2f(proj[(tok0 + t0 + i + 1) * 4096 + 1024 + cb + col]) * __expf(bend - (bl[i + 1] + off));
        kw[i >> 1] = pk2(k0, k1);
        vw[i >> 1] = (unsigned)proj[(tok0 + t0 + i) * 4096 + 2048 + cb + col] | ((unsigned)proj[(tok0 + t0 + i + 1) * 4096 + 2048 + cb + col] << 16); }
    { LAS v4u* kd = (LAS v4u*)(F.lds + HL_KHT + col * 144 + t0 * 2); kd[0] = (v4u){kw[0], kw[1], kw[2], kw[3]}; kd[1] = (v4u){kw[4], kw[5], kw[6], kw[7]};
      LAS v4u* vd = (LAS v4u*)(F.lds + HL_VT + col * 144 + t0 * 2); vd[0] = (v4u){vw[0], vw[1], vw[2], vw[3]}; vd[1] = (v4u){vw[4], vw[5], vw[6], vw[7]}; }
    if (q == 0) WSP(float, WS_ADEC)[(size_t)ch * 128 + col] = __expf(bend);
    LDS_WAIT(); __syncthreads();
    const int w = F.wave, r32 = F.lane & 31, hi = F.lane >> 5, mt = w >> 1;
    float* LT = WSP(float, WS_LT) + (size_t)ch * 16384;
#pragma unroll
    for (int n2 = 0; n2 < 2; ++n2) { const int nt = (w & 1) * 2 + n2; f32x16 acc = {};
#pragma unroll
        for (int ks = 0; ks < 4; ++ks) {
            const bf16x8 A = *(const LAS bf16x8*)(F.lds + HL_VT + (32 * mt + r32) * 144 + (16 * ks + 8 * hi) * 2);
            const bf16x8 B = *(const LAS bf16x8*)(F.lds + HL_KHT + (32 * nt + r32) * 144 + (16 * ks + 8 * hi) * 2);
            acc = __builtin_amdgcn_mfma_f32_32x32x16_bf16(A, B, acc, 0, 0, 0); }
#pragma unroll
        for (int r = 0; r < 16; ++r) LT[(32 * mt + att::crow(r, hi)) * 128 + 32 * nt + r32] = acc[r]; }
    __syncthreads();
}
__device__ __forceinline__ void hgrn_scan(Frame& F, const Ptrs& P) {
    const int gt = (F.vcu * NWAVES + F.wave) * 64 + F.lane, NT = F.G * NWAVES * 64;
    for (int e = gt; e < 16 * 128 * 64; e += NT) {
        const int bh = e >> 13, v = (e >> 6) & 127, k = (e & 63) * 2;
        const float* LT = WSP(float, WS_LT) + (size_t)bh * 128 * 16384 + v * 128 + k;
        const float* ad = WSP(float, WS_ADEC) + (size_t)bh * 128 * 128 + k;
        bf16* ST = WSP(bf16, WS_ST) + (size_t)bh * 128 * 16384 + v * 128 + k;
        float s0 = 0.f, s1 = 0.f;
#pragma unroll 8
        for (int n = 0; n < 128; ++n) {
            const f32x2 lt = *(const GAS f32x2*)(LT + (size_t)n * 16384); const f32x2 a = *(const GAS f32x2*)(ad + n * 128);
            *(GAS unsigned*)(ST + (size_t)n * 16384) = pk2(s0, s1);
            s0 = a.x * s0 + lt.x; s1 = a.y * s1 + lt.y; }
    }
}
__device__ __forceinline__ void hgrn_out(Frame& F, const Ptrs& P, int ch, int l) {
    const int tid = F.tid, col = tid & 127, q = tid >> 7, t0 = 16 * q;
    const int bh = ch >> 7, n = ch & 127, b = bh >> 3, h = bh & 7;
    const size_t tok0 = (size_t)b * SEQ + (size_t)n * 64; const int cb = h * 128;
    const float* logf = WSP(float, WS_LOGF); const bf16* proj = WSP(bf16, WS_PROJ);
    LAS float* QTOT = (LAS float*)(F.lds + HL_QTOT); LAS float* RS = (LAS float*)(F.lds + HL_RS);
    float bl[16], run = 0.f;
#pragma unroll
    for (int i = 0; i < 16; ++i) { run += logf[(tok0 + t0 + i) * 1024 + cb + col]; bl[i] = run; }
    QTOT[q * 128 + col] = run;
    LDS_WAIT(); __syncthreads();
    float off = 0.f;
#pragma unroll
    for (int qq = 0; qq < 4; ++qq) { const float t = QTOT[qq * 128 + col]; if (qq < q) off += t; }
    const float rref = QTOT[col] + QTOT[128 + col];
    unsigned vw[8];
#pragma unroll
    for (int i = 0; i < 16; ++i) { const int t = t0 + i; const float bb = bl[i] + off;
        const float qv = bf2f(proj[(tok0 + t) * 4096 + cb + col]), ka = bf2f(proj[(tok0 + t) * 4096 + 1024 + cb + col]);
        *(LAS unsigned short*)(F.lds + HL_QT + t * 272 + col * 2) = (unsigned short)f2bf(qv * clampe(bb - rref));
        *(LAS unsigned short*)(F.lds + HL_KT + t * 272 + col * 2) = (unsigned short)f2bf(ka * clampe(rref - bb));
        *(LAS unsigned short*)(F.lds + HL_QH + t * 272 + col * 2) = (unsigned short)f2bf(qv * __expf(bb));
        const unsigned vv = proj[(tok0 + t) * 4096 + 2048 + cb + col]; if (i & 1) vw[i >> 1] |= vv << 16; else vw[i >> 1] = vv; }
    { LAS v4u* vd = (LAS v4u*)(F.lds + HL_VT + col * 144 + t0 * 2); vd[0] = (v4u){vw[0], vw[1], vw[2], vw[3]}; vd[1] = (v4u){vw[4], vw[5], vw[6], vw[7]}; }
    LDS_WAIT(); __syncthreads();
    const int w = F.wave, r32 = F.lane & 31, hi = F.lane >> 5;
    if (w < 4) { const int mt = w >> 1, nt = w & 1; f32x16 acc = {};
#pragma unroll
        for (int ks = 0; ks < 8; ++ks) {
            const bf16x8 A = *(const LAS bf16x8*)(F.lds + HL_QT + (32 * mt + r32) * 272 + (16 * ks + 8 * hi) * 2);
            const bf16x8 B = *(const LAS bf16x8*)(F.lds + HL_KT + (32 * nt + r32) * 272 + (16 * ks + 8 * hi) * 2);
            acc = __builtin_amdgcn_mfma_f32_32x32x16_bf16(A, B, acc, 0, 0, 0); }
#pragma unroll
        for (int r = 0; r < 16; ++r) { const int t = 32 * mt + att::crow(r, hi), s = 32 * nt + r32;
            *(LAS unsigned short*)(F.lds + HL_SC + t * 144 + s * 2) = (unsigned short)f2bf(s <= t ? acc[r] : 0.f); } }
    LDS_WAIT(); __syncthreads();
    const int mt = w >> 2, nt = w & 3; f32x16 acc = {};
#pragma unroll
    for (int ks = 0; ks < 4; ++ks) {
        const bf16x8 A = *(const LAS bf16x8*)(F.lds + HL_SC + (32 * mt + r32) * 144 + (16 * ks + 8 * hi) * 2);
        const bf16x8 B = *(const LAS bf16x8*)(F.lds + HL_VT + (32 * nt + r32) * 144 + (16 * ks + 8 * hi) * 2);
        acc = __builtin_amdgcn_mfma_f32_32x32x16_bf16(A, B, acc, 0, 0, 0); }
    const bf16* ST = WSP(bf16, WS_ST) + (size_t)ch * 16384 + (32 * nt + r32) * 128 + 8 * hi;
#pragma unroll
    for (int ks = 0; ks < 8; ++ks) {
        const bf16x8 A = *(const LAS bf16x8*)(F.lds + HL_QH + (32 * mt + r32) * 272 + (16 * ks + 8 * hi) * 2);
        const bf16x8 B = *(const GAS bf16x8*)(ST + 16 * ks);
        acc = __builtin_amdgcn_mfma_f32_32x32x16_bf16(A, B, acc, 0, 0, 0); }
#pragma unroll
    for (int r = 0; r < 16; ++r) { float ss = acc[r] * acc[r];
        ss += __shfl_xor(ss, 1); ss += __shfl_xor(ss, 2); ss += __shfl_xor(ss, 4); ss += __shfl_xor(ss, 8); ss += __shfl_xor(ss, 16);
        if (r32 == 0) RS[nt * 64 + 32 * mt + att::crow(r, hi)] = ss; }
    LDS_WAIT(); __syncthreads();
    const int vc = cb + 32 * nt + r32; const float ga = P.inp(10)[(size_t)l * 4096 + vc];
    bf16* mix = WSP(bf16, WS_MIX);
#pragma unroll
    for (int r = 0; r < 16; ++r) { const int t = 32 * mt + att::crow(r, hi);
        const float tot = (RS[t] + RS[64 + t]) + (RS[128 + t] + RS[192 + t]);
        const float rstd = __builtin_amdgcn_rsqf(tot * (1.f / 128.f) + EPS);
        const float g = bf2f(proj[(tok0 + t) * 4096 + 3072 + vc]);
        const float o = acc[r] * rstd * ga * (g * __builtin_amdgcn_rcpf(1.0f + __expf(-g)));
        const float on = __shfl_xor(o, 1);
        if ((r32 & 1) == 0) *(GAS unsigned*)(mix + (tok0 + t) * 4096 + vc) = pk2(o, on); }
    __syncthreads();
}
constexpr int ATT_ITEMS = 768;
__device__ __forceinline__ att::BlockRef mix_block(const Ptrs& P, int l, int j, int pass) {
    att::BlockRef r;
    const int x = j & 15, qb = pass ? 31 - x : x;
    if (j < 512) { const int bh = j >> 4, b = bh >> 4, h = bh & 15; const size_t q0 = (size_t)bh * SEQ + (size_t)qb * 256;
        r.Q = WSP(bf16, WS_QN) + q0 * 128; r.QX = WSP(bf16, WS_QR) + q0 * 64;
        r.K = WSP(bf16, WS_KN) + (size_t)bh * SEQ * 128; r.V = WSP(bf16, WS_VC) + (size_t)bh * SEQ * 128; r.KX = WSP(bf16, WS_KROT) + (size_t)b * SEQ * 64;
        r.O = WSP(bf16, WS_MIX) + ((size_t)b * SEQ + (size_t)qb * 256) * 4096 + 2048 + h * 128; r.G = P.inp(10) + (size_t)l * 4096 + 2048 + h * 128; }
    else { const int bh = (j - 512) >> 4, b = bh >> 3, h = bh & 7; const size_t q0 = (size_t)bh * SEQ + (size_t)qb * 256;
        r.Q = WSP(bf16, WS_FOX) + q0 * 128; r.QX = WSP(bf16, WS_QEXT) + q0 * 64;
        r.K = WSP(bf16, WS_FOX) + ((size_t)(16 + bh) * SEQ) * 128; r.V = WSP(bf16, WS_FOX) + ((size_t)(32 + bh) * SEQ) * 128; r.KX = WSP(bf16, WS_KEXT) + (size_t)bh * SEQ * 64;
        r.O = WSP(bf16, WS_MIX) + ((size_t)b * SEQ + (size_t)qb * 256) * 4096 + 1024 + h * 128; r.G = P.inp(10) + (size_t)l * 4096 + 1024 + h * 128; }
    r.P0 = qb * 256;
    return r;
}
__device__ __forceinline__ void mix_attention(Frame& F, const Ptrs& P, int l) {
    const int nit = (ATT_ITEMS - F.vcu + F.G - 1) / F.G;
    if (nit <= 0) return;
    const int nblk = 2 * nit;
    att::Seam<true> S;
    att::BlockRef cur = mix_block(P, l, F.vcu, 0);
    att::attn_prime<true>(cur, 1 << 30, F.ldsg, S, fresh_tid(F.wave));
    for (int k = 0; k < nblk; ++k) {
        const int kn = (k + 1 < nblk) ? k + 1 : k;
        const att::BlockRef nxt = mix_block(P, l, F.vcu + (kn >> 1) * F.G, kn & 1);
        att::attn_block<true, true, 4096>(cur, nxt, SEQ, 1 << 30, F.ldsg, S, fresh_tid(F.wave));
        cur = nxt;
    }
}
__device__ __forceinline__ att::BlockRef mem_block(const Ptrs& P, int l, int j) {
    att::BlockRef r; const int bh = j >> 5, qb = j & 31, b = bh >> 2, h = bh & 3;
    r.Q = WSP(bf16, WS_QMEM) + ((size_t)bh * SEQ + (size_t)qb * 256) * 128; r.QX = r.Q;
    r.K = WSP(bf16, WS_KVMEM) + ((size_t)l * 2 * 8 + bh) * 256 * 128; r.V = r.K + (size_t)8 * 256 * 128; r.KX = r.K;
    r.O = WSP(bf16, WS_OMEM) + ((size_t)b * SEQ + (size_t)qb * 256) * 512 + h * 128; r.G = nullptr; r.P0 = MEMT;
    return r;
}
__device__ __forceinline__ void mem_attention(Frame& F, const Ptrs& P, int l) {
    const int nblk = (256 - F.vcu + F.G - 1) / F.G;
    if (nblk <= 0) return;
    att::Seam<false> S;
    att::BlockRef cur = mem_block(P, l, F.vcu);
    att::attn_prime<false>(cur, 1 << 30, F.ldsg, S, fresh_tid(F.wave));
    for (int k = 0; k < nblk; ++k) {
        const int kn = (k + 1 < nblk) ? k + 1 : k;
        const att::BlockRef nxt = mem_block(P, l, F.vcu + kn * F.G);
        att::attn_block<false, false, 512>(cur, nxt, MEMT, 1 << 30, F.ldsg, S, fresh_tid(F.wave));
        cur = nxt;
    }
}

constexpr int NPH = 13;
constexpr int NPHASES = 1 + DEPTH * NPH;
__global__ void __launch_bounds__(NWAVES * 64, 2) trunk_fwd(Args args) {
    extern __shared__ __attribute__((aligned(16))) unsigned char lds[];
    const int wave_s = __builtin_amdgcn_readfirstlane(threadIdx.x >> 6);
    for (int u = threadIdx.x; u < (LDS_BYTES - LDSCTL_OFF) / 4; u += NWAVES * 64) ((LAS unsigned*)((LAS unsigned char*)lds + LDSCTL_OFF))[u] = 0u;
    __syncthreads();
    XcdBarrier bar = xcd_barrier_post((unsigned*)(args.ws + WS_CTL) + CW_BAR, (volatile LAS unsigned*)((LAS unsigned char*)lds + MISC_OFF) + 8);
#define PH_BEGIN() Frame F; { int ln_; asm volatile("v_mbcnt_lo_u32_b32 %0, -1, 0\n\tv_mbcnt_hi_u32_b32 %0, -1, %0" : "=v"(ln_)); F.tid = wave_s * 64 + ln_; } F.lds = (LAS unsigned char*)lds; F.ldsg = (char*)lds; F.lane = F.tid & 63; F.wave = __builtin_amdgcn_readfirstlane(F.tid >> 6); \
    F.G = gridDim.x; { int bx = blockIdx.x; asm volatile("" : "+s"(bx)); F.vcu = (F.G % 8 == 0) ? (bx % 8) * (F.G / 8) + bx / 8 : bx; F.bx = bx; } \
    const CArgs* ap_ = (const CArgs*)__builtin_amdgcn_kernarg_segment_ptr(); asm volatile("" : "+s"(ap_)); const Ptrs P{ap_, ap_->out, ap_->ws}; LAS unsigned char* ring = F.lds;
    const int lo = args.ph_lo, hi = args.ph_hi;
#ifndef PH_MASK
#define PH_MASK 0xFFFFFFFFu
#endif
#define RUN(g) (lo <= (g) && (g) < hi)
#define EN(p) ((PH_MASK >> (p)) & 1u)
#define PHASE_END(g) do { if ((g) + 1 < hi) xcd_barrier(bar, fresh_tid(F.wave) == 0); } while (0)

    if (EN(0) && RUN(0)) { PH_BEGIN(); p0_prologue(F, P); PHASE_END(0); }

    for (int l = 0; l < DEPTH; ++l) {
        const int g0 = 1 + l * NPH;
        if (EN(1) && RUN(g0 + 0)) { PH_BEGIN();
            { pg8::Gemm g{WSP(bf16, WS_HN), WLAYER(bf16, l, W_IN), M, NIN, DM}; pg8::StaticOrder S; S.init(M, NIN, F.G, F.bx);
              pg8::EpiProj E{WSP(bf16, WS_PROJ), WSP(bf16, WS_FOX), WSP(float, WS_LOGF), WSP(float, WS_PROJX), WSP(float, WS_LB) + l * 1024, QSCALE_128};
              pg8::gemm_phase<pg8::EpiProj, pg8::StaticOrder, true, true>(ring, g, S, E, F.tid); }
            if (l == 0) {
                for (int ll = 0; ll < DEPTH; ++ll) {
                    pg8::Gemm g{WSP(bf16, WS_MEMN) + (size_t)ll * 512 * DM, WLAYER(bf16, ll, W_MKV), BATCH * MEMT, 1024, DM}; pg8::StaticOrder S;
                    S.init(BATCH * MEMT, 1024, F.G, (int)((F.bx + F.G - (F.G / 2 + 8 * ll) % F.G) % F.G));
                    pg8::EpiKVmem E{WSP(bf16, WS_KVMEM) + (size_t)ll * 2 * 8 * 256 * 128, WSP(bf16, WS_KVMEM) + ((size_t)ll * 2 + 1) * 8 * 256 * 128};
                    pg8::gemm_phase<pg8::EpiKVmem, pg8::StaticOrder, true, true>(ring, g, S, E, F.tid); }
            }
            PHASE_END(g0 + 0);
        }
        if (EN(2) && RUN(g0 + 1)) { PH_BEGIN();
            p2_rows(F, P, l);
            for (int ch = F.vcu; ch < 2048; ch += F.G) hgrn_local(F, P, ch);
            PHASE_END(g0 + 1);
        }
        if (EN(3) && RUN(g0 + 2)) { PH_BEGIN();
#ifndef NO_SCANS
            for (int bh = F.vcu; bh < 16; bh += F.G) fox_scan(F, P, bh);
            hgrn_scan(F, P);
            __syncthreads();
#endif
#ifndef NO_QFULL
            { pg8::Gemm g{WSP(bf16, WS_CQN), WLAYER(bf16, l, W_UQ), M, 3072, 768}; pg8::StaticOrder S; S.init(M, 3072, F.G, F.bx);
              pg8::EpiQfull E{WSP(bf16, WS_QN), WSP(bf16, WS_QR), WSP(float, WS_ROPE), QSCALE_MLA};
              pg8::gemm_phase<pg8::EpiQfull, pg8::StaticOrder, true, true>(ring, g, S, E, F.tid); }
#endif
            { pg8::Gemm g{WSP(bf16, WS_CKVN), WLAYER(bf16, l, W_UKV), M, 4096, 512}; pg8::StaticOrder S; S.init(M, 4096, F.G, F.bx);
              pg8::EpiKV E{WSP(bf16, WS_KN), WSP(bf16, WS_VC)};
              pg8::gemm_phase<pg8::EpiKV, pg8::StaticOrder, true, true>(ring, g, S, E, F.tid); }
            PHASE_END(g0 + 2);
        }
        if (EN(4) && RUN(g0 + 3)) { PH_BEGIN();
#ifndef NO_ATT
            mix_attention(F, P, l);
            __syncthreads();
#endif
#ifndef NO_HOUT
            { PH_BEGIN(); for (int ch = F.vcu; ch < 2048; ch += F.G) hgrn_out(F, P, ch, l); }
#endif
            PHASE_END(g0 + 3);
        }
        if (EN(5) && RUN(g0 + 4)) { PH_BEGIN();
            pg8::Gemm g{WSP(bf16, WS_MIX), WLAYER(bf16, l, W_O), M, DM, DM}; pg8::StaticOrder S; S.init(M, DM, F.G, F.bx);
            pg8::EpiF32P E{WSP(float, WS_Y), DM};
            pg8::gemm_phase<pg8::EpiF32P, pg8::StaticOrder, true, true>(ring, g, S, E, F.tid);
            PHASE_END(g0 + 4);
        }
        if (EN(6) && RUN(g0 + 5)) { PH_BEGIN();
            const int gw = F.vcu * NWAVES + F.wave, NGW = F.G * NWAVES;
            for (int m = gw; m < M; m += NGW) norm_row<true, true, true>(F.lane, ((l == 0) ? P.inp(0) : (const float*)P.out) + (size_t)m * DM, WSP(float, WS_Y) + (size_t)m * DM, P.inp(20) + (size_t)l * DM, P.out + (size_t)m * DM, P.inp(21) + (size_t)l * DM, WSP(bf16, WS_HN) + (size_t)m * DM);
            PHASE_END(g0 + 5);
        }
        if (EN(7) && RUN(g0 + 6)) { PH_BEGIN();
            pg8::Gemm g{WSP(bf16, WS_HN), WLAYER(bf16, l, W_MQ), M, 512, DM}; pg8::StaticOrder S; S.init(M, 512, F.G, F.bx);
            pg8::EpiQmem E{WSP(bf16, WS_QMEM), QSCALE_128};
            pg8::gemm_phase<pg8::EpiQmem, pg8::StaticOrder, true, true>(ring, g, S, E, F.tid);
            PHASE_END(g0 + 6);
        }
        if (EN(8) && RUN(g0 + 7)) { PH_BEGIN(); mem_attention(F, P, l); PHASE_END(g0 + 7); }
        if (EN(9) && RUN(g0 + 8)) { PH_BEGIN();
            pg8::Gemm g{WSP(bf16, WS_OMEM), WLAYER(bf16, l, W_MO), M, DM, 512}; pg8::StaticOrder S; S.init(M, DM, F.G, F.bx);
            pg8::EpiF32P E{WSP(float, WS_Y), DM};
            pg8::gemm_phase<pg8::EpiF32P, pg8::StaticOrder, true, true>(ring, g, S, E, F.tid);
            PHASE_END(g0 + 8);
        }
        if (EN(10) && RUN(g0 + 9)) { PH_BEGIN();
            const int gw = F.vcu * NWAVES + F.wave, NGW = F.G * NWAVES;
            for (int m = gw; m < M; m += NGW) norm_row<true, true, true>(F.lane, P.out + (size_t)m * DM, WSP(float, WS_Y) + (size_t)m * DM, P.inp(22) + (size_t)l * DM, P.out + (size_t)m * DM, P.inp(23) + (size_t)l * DM, WSP(bf16, WS_HN) + (size_t)m * DM);
            PHASE_END(g0 + 9);
        }
        if (EN(11) && RUN(g0 + 10)) { PH_BEGIN();
            pg8::Gemm g{WSP(bf16, WS_HN), WLAYER(bf16, l, W_FF1), M, DFF, DM}; pg8::StaticOrder S; S.init(M, DFF, F.G, F.bx);
            pg8::EpiRelu2 E{WSP(bf16, WS_HID), DFF};
            pg8::gemm_phase<pg8::EpiRelu2, pg8::StaticOrder, true, true>(ring, g, S, E, F.tid);
            PHASE_END(g0 + 10);
        }
        if (EN(12) && RUN(g0 + 11)) { PH_BEGIN();
            pg8::Gemm g{WSP(bf16, WS_HID), WLAYER(bf16, l, W_FF2), M, DM, DFF}; pg8::StaticOrder S; S.init(M, DM, F.G, F.bx);
            pg8::EpiF32P E{WSP(float, WS_Y), DM};
            pg8::gemm_phase<pg8::EpiF32P, pg8::StaticOrder, true, true>(ring, g, S, E, F.tid);
            PHASE_END(g0 + 11);
        }
        if (EN(13) && RUN(g0 + 12)) { PH_BEGIN();
            const int gw = F.vcu * NWAVES + F.wave, NGW = F.G * NWAVES;
            const float* gnext = P.inp(19) + (size_t)(l + 1 < DEPTH ? l + 1 : l) * DM;
            if (l + 1 < DEPTH) { for (int m = gw; m < M; m += NGW) norm_row<true, true, true>(F.lane, P.out + (size_t)m * DM, WSP(float, WS_Y) + (size_t)m * DM, P.inp(24) + (size_t)l * DM, P.out + (size_t)m * DM, gnext, WSP(bf16, WS_HN) + (size_t)m * DM); }
            else { for (int m = gw; m < M; m += NGW) norm_row<true, true, false>(F.lane, P.out + (size_t)m * DM, WSP(float, WS_Y) + (size_t)m * DM, P.inp(24) + (size_t)l * DM, P.out + (size_t)m * DM, nullptr, nullptr); }
            PHASE_END(g0 + 12);
        }
    }
#undef RUN
#undef PHASE_END
}

#ifndef MK_PER_PHASE
#define MK_PER_PHASE 0
#endif
extern "C" void kernel_launch(void* const* d_in, const int* in_sizes, int n_in, void* d_out, int out_size, void* d_ws, size_t ws_size, hipStream_t stream) {
    static int grid = 0;
    if (grid == 0) {
        if (n_in != 25 || in_sizes[0] != M * DM || out_size != M * DM || ws_size < WS_END) { fprintf(stderr, "kernel_launch: unexpected shapes (n_in %d, in0 %d, out %d, ws %zu; need ws >= %zu); nothing launched\n", n_in, n_in > 0 ? in_sizes[0] : -1, out_size, ws_size, (size_t)WS_END); grid = -1; return; }
        int dev = 0, cus = 0, per_cu = 0;
        if (hipGetDevice(&dev) != hipSuccess || hipDeviceGetAttribute(&cus, hipDeviceAttributeMultiprocessorCount, dev) != hipSuccess) { fprintf(stderr, "kernel_launch: device query failed\n"); grid = -1; return; }
        if (hipFuncSetAttribute((const void*)trunk_fwd, hipFuncAttributeMaxDynamicSharedMemorySize, LDS_BYTES) != hipSuccess) { fprintf(stderr, "kernel_launch: hipFuncSetAttribute failed\n"); grid = -1; return; }
        if (hipOccupancyMaxActiveBlocksPerMultiprocessor(&per_cu, (const void*)trunk_fwd, NWAVES * 64, LDS_BYTES) != hipSuccess || per_cu < 1)
            fprintf(stderr, "kernel_launch: note: occupancy query reports %d workgroups per CU\n", per_cu);
        (void)hipGetLastError();
        grid = cus;
    }
    if (grid < 0) return;
    if (hipMemsetAsync((char*)d_ws + WS_CTL, 0, CTL_ZERO_BYTES, stream) != hipSuccess) { fprintf(stderr, "kernel_launch: memset failed\n"); return; }
    Args a{};
    for (int i = 0; i < 25; ++i) a.in[i] = (const float*)d_in[i];
    a.out = (float*)d_out; a.ws = (unsigned char*)d_ws;
#if MK_PER_PHASE
    for (int p = 0; p < NPHASES; ++p) { a.ph_lo = p; a.ph_hi = p + 1; hipLaunchKernelGGL(trunk_fwd, dim3(grid), dim3(NWAVES * 64), LDS_BYTES, stream, a); }
#else
    a.ph_lo = 0; a.ph_hi = NPHASES;
    hipLaunchKernelGGL(trunk_fwd, dim3(grid), dim3(NWAVES * 64), LDS_BYTES, stream, a);
#endif
    const hipError_t le = hipPeekAtLastError();
    if (le != hipSuccess) fprintf(stderr, "kernel_launch: launch failed: %s\n", hipGetErrorName(le));
}
```

```cpp
#define CV_SKD 8
#define CVB8 5440
#include <hip/hip_runtime.h>
#include <cstdio>
#include <cstdint>
namespace pg8 {
#define PG8_LAS __attribute__((address_space(3)))
typedef unsigned short bf16_t;
typedef short bf16x8 __attribute__((ext_vector_type(8)));
typedef float f32x4 __attribute__((ext_vector_type(4)));
typedef unsigned u32x4 __attribute__((ext_vector_type(4)));
constexpr int BM = 256, BK = 64, HALF = 128, HTB = HALF * BK * 2  , STAGE_BYTES = 8 * HTB, NXCD = 8, WGM = 8;

__host__ __device__ __forceinline__ int lds_byte(int r, int c) { const int st = (r >> 4) * 2 + (c >> 5), rr = r & 15, cc = c & 31, ob = rr * 64 + cc * 2; return st * 1024 + (ob ^ (((ob >> 9) & 1) << 5)); }
__host__ __device__ __forceinline__ void stage_rc(int b, int& R, int& C) { const int st = b / 1024, sb = b % 1024, swz = sb ^ (((sb >> 9) & 1) << 5); R = (st >> 1) * 16 + swz / 64; C = (st & 1) * 32 + (swz % 64) / 2; }
__host__ __device__ __forceinline__ int perm32(int rho) { const int n = rho >> 4, i = rho & 15; return 8 * (i >> 2) + 4 * n + (i & 3); }

struct Unit { int pm, pn, ko; };
struct Gemm { const bf16_t* A; const bf16_t* Bt; int M, N, K; int ld; };

struct StaticOrder {
    int nM, nN, nwg, G, c;
    __host__ __device__ void init(int M, int N, int G_, int c_) { nM = M / BM; nN = N / BM; nwg = nM * nN; G = G_; c = c_; }
    __host__ __device__ bool next(int i, Unit& u) const {
        const long L = (long)i * G + c; if (L >= nwg) return false;
        int wgid = (int)L; { const int q = nwg / NXCD, r = nwg % NXCD, xcd = wgid % NXCD, off = wgid / NXCD; wgid = (xcd < r ? xcd * (q + 1) : r * (q + 1) + (xcd - r) * q) + off; }
        const int nig = WGM * nN, gid = wgid / nig, fm = gid * WGM, gsz = (nM - fm) < WGM ? (nM - fm) : WGM;
        u.pm = fm + ((wgid % nig) % gsz); u.pn = (wgid % nig) / gsz; u.ko = 0; return true;
    }
    __device__ __forceinline__ void a_ready(const Unit&) const {}
    __device__ __forceinline__ void done(const Unit&) const {}
};

struct HalfKOrder {
    StaticOrder s; int round, c, khalf;
    __device__ __forceinline__ bool next(int i, Unit& u) const { if (i > 0 || !s.next(round, u)) return false; u.ko = (c >> 7) * khalf; return true; }
    __device__ __forceinline__ void a_ready(const Unit&) const {}
    __device__ __forceinline__ void done(const Unit&) const {}
};
struct RoundOrder {
    StaticOrder s; int lo, hi;
    __device__ __forceinline__ bool next(int i, Unit& u) const { return (i + lo < hi) && s.next(i + lo, u); }
    __device__ __forceinline__ void a_ready(const Unit&) const {}
    __device__ __forceinline__ void done(const Unit&) const {}
};
__device__ __forceinline__ unsigned cvt_pk_bf16(float lo, float hi) { unsigned r; asm volatile("v_cvt_pk_bf16_f32 %0, %1, %2" : "=v"(r) : "v"(lo), "v"(hi)); return r; }
typedef float f32x2 __attribute__((ext_vector_type(2)));
__device__ __forceinline__ u32x4 pack8_bf16(const f32x4& v0, const f32x4& v1) { u32x4 w; w.x = cvt_pk_bf16(v0[0], v0[1]); w.y = cvt_pk_bf16(v0[2], v0[3]); w.z = cvt_pk_bf16(v1[0], v1[1]); w.w = cvt_pk_bf16(v1[2], v1[3]); return w; }

struct EpiBf16S {
    static constexpr bool PERM = true, AFTER_DRAIN = false;
    bf16_t* O; int ldc; float scale;
    __device__ __forceinline__ void operator()(const f32x4 (&acc)[2][2][4][2], const Unit& u, int wr, int wc, int fr, int fq) const {
        const int row0 = u.pm * BM + wr * 64 + fr, col0 = u.pn * BM + wc * 32 + 8 * fq;
#pragma unroll
        for (int ai = 0; ai < 2; ++ai)
#pragma unroll
            for (int m = 0; m < 4; ++m) { bf16_t* rowp = O + (size_t)(row0 + ai * HALF + m * 16) * ldc + col0;
#pragma unroll
                for (int bj = 0; bj < 2; ++bj) *(u32x4*)(rowp + bj * HALF) = pack8_bf16(acc[ai][bj][m][0] * scale, acc[ai][bj][m][1] * scale); }
    }
};
struct EpiRelu2 {
    static constexpr bool PERM = true, AFTER_DRAIN = false;
    bf16_t* O; int ldc; const float* rs;
    __device__ __forceinline__ void operator()(const f32x4 (&acc)[2][2][4][2], const Unit& u, int wr, int wc, int fr, int fq) const {
        const int row0 = u.pm * BM + wr * 64 + fr, col0 = u.pn * BM + wc * 32 + 8 * fq;
        const f32x4 z4 = {0.f, 0.f, 0.f, 0.f};
        float rv[2][4];
#pragma unroll
        for (int ai = 0; ai < 2; ++ai)
#pragma unroll
            for (int m = 0; m < 4; ++m) rv[ai][m] = rs[row0 + ai * HALF + m * 16];
#pragma unroll
        for (int ai = 0; ai < 2; ++ai)
#pragma unroll
            for (int m = 0; m < 4; ++m) { bf16_t* rowp = O + (size_t)(row0 + ai * HALF + m * 16) * ldc + col0; const float r2 = rv[ai][m] * rv[ai][m];
#pragma unroll
                for (int bj = 0; bj < 2; ++bj) { f32x4 a = __builtin_elementwise_max(acc[ai][bj][m][0], z4), b = __builtin_elementwise_max(acc[ai][bj][m][1], z4);
                    *(u32x4*)(rowp + bj * HALF) = pack8_bf16(a * a * r2, b * b * r2); } }
    }
};
struct EpiY {
    static constexpr bool PERM = true, AFTER_DRAIN = false;
    bf16_t* Y; float* yss;
    __device__ __forceinline__ void operator()(const f32x4 (&acc)[2][2][4][2], const Unit& u, int wr, int wc, int fr, int fq) const {
        const int row0 = u.pm * BM + wr * 64 + fr, col0 = u.pn * BM + wc * 32 + 8 * fq;
#pragma unroll
        for (int ai = 0; ai < 2; ++ai)
#pragma unroll
            for (int m = 0; m < 4; ++m) { const size_t r = (size_t)(row0 + ai * HALF + m * 16); bf16_t* rowp = Y + r * 4096 + col0; float s = 0.f;
#pragma unroll
                for (int bj = 0; bj < 2; ++bj) { const f32x4 a = acc[ai][bj][m][0], c = acc[ai][bj][m][1];
                    s += (a[0] * a[0] + a[1] * a[1]) + (a[2] * a[2] + a[3] * a[3]) + (c[0] * c[0] + c[1] * c[1]) + (c[2] * c[2] + c[3] * c[3]);
                    *(u32x4*)(rowp + bj * HALF) = pack8_bf16(a, c); }
                s += __shfl_xor(s, 16); s += __shfl_xor(s, 32);
                if (fq == 0) yss[r * 64 + u.pn * 4 + wc] = s; }
    }
};
template <int RS> __device__ __forceinline__ void store_hm(const f32x4 (&acc)[2][2][4][2], int bj, bf16_t* dst, float sc) {
#pragma unroll
    for (int ai = 0; ai < 2; ++ai)
#pragma unroll
        for (int m = 0; m < 4; ++m) *(u32x4*)(dst + (size_t)(ai * HALF + m * 16) * RS) = pack8_bf16(acc[ai][bj][m][0] * sc, acc[ai][bj][m][1] * sc);
}
struct EpiProj {
    static constexpr bool PERM = true, AFTER_DRAIN = false;
    bf16_t* proj; bf16_t* fox; float* logf; float* projx; bf16_t* cqb; bf16_t* ckvb; float* css; const float* lb; float fqscale; const float* rs;
    __device__ __forceinline__ void operator()(const f32x4 (&acc)[2][2][4][2], const Unit& u, int wr, int wc, int fr, int fq) const {
        const int row0 = u.pm * BM + wr * 64 + fr, cl = wc * 32 + 8 * fq;
#define RVLOAD() float rv[2][4]; _Pragma("unroll") for (int ai = 0; ai < 2; ++ai) _Pragma("unroll") for (int m = 0; m < 4; ++m) rv[ai][m] = rs[row0 + ai * HALF + m * 16]
#define RV(ai, m) rv[ai][m]
        if (u.pn == 31) {
            RVLOAD();
#pragma unroll
            for (int ai = 0; ai < 2; ++ai)
#pragma unroll
                for (int m = 0; m < 4; ++m) { float* rowp = projx + (size_t)(row0 + ai * HALF + m * 16) * 256 + cl; const float rvv = RV(ai, m);
#pragma unroll
                    for (int bj = 0; bj < 2; ++bj) { *(f32x4*)(rowp + bj * HALF) = acc[ai][bj][m][0] * rvv; *(f32x4*)(rowp + bj * HALF + 4) = acc[ai][bj][m][1] * rvv; } }
        } else if (u.pn >= 26 && u.pn < 31) {
            RVLOAD(); const bool isq = u.pn < 29; bf16_t* dst = isq ? cqb + (u.pn - 26) * BM : ckvb + (u.pn - 29) * BM; const int ld = isq ? 768 : 512;
#pragma unroll
            for (int ai = 0; ai < 2; ++ai)
#pragma unroll
                for (int m = 0; m < 4; ++m) { const size_t r = (size_t)(row0 + ai * HALF + m * 16); const float rvv = RV(ai, m); float s = 0.f;
#pragma unroll
                    for (int bj = 0; bj < 2; ++bj) { const f32x4 a = acc[ai][bj][m][0] * rvv, c = acc[ai][bj][m][1] * rvv;
                        s += (a[0] * a[0] + a[1] * a[1]) + (a[2] * a[2] + a[3] * a[3]) + (c[0] * c[0] + c[1] * c[1]) + (c[2] * c[2] + c[3] * c[3]);
                        *(u32x4*)(dst + r * ld + cl + bj * HALF) = pack8_bf16(a, c); }
                    s += __shfl_xor(s, 16); s += __shfl_xor(s, 32);
                    if (fq == 0) css[r * 20 + (u.pn - 26) * 4 + wc] = s; }
        } else if (u.pn >= 14 && u.pn < 26) {
            const int part = (u.pn - 14) >> 2, hp = (u.pn - 14) & 3, b = u.pm >> 5, s0 = (u.pm & 31) * BM + wr * 64 + fr;
            const float sc = part == 0 ? fqscale : 1.0f; RVLOAD();
#pragma unroll
            for (int bj = 0; bj < 2; ++bj) { bf16_t* dst = fox + ((size_t)(part * 16 + b * 8 + 2 * hp + bj) * 8192 + s0) * 128 + cl;
#pragma unroll
                for (int ai = 0; ai < 2; ++ai)
#pragma unroll
                    for (int m = 0; m < 4; ++m) { const float f = sc * RV(ai, m); *(u32x4*)(dst + (size_t)(ai * HALF + m * 16) * 128) = pack8_bf16(acc[ai][bj][m][0] * f, acc[ai][bj][m][1] * f); } }
        } else if (u.pn >= 4 && u.pn < 8) {
            const int c0 = (u.pn - 4) * BM + cl;
            f32x4 lbv[2][2];
#pragma unroll
            for (int bj = 0; bj < 2; ++bj) { lbv[bj][0] = *(const f32x4*)(lb + c0 + bj * HALF); lbv[bj][1] = *(const f32x4*)(lb + c0 + bj * HALF + 4); }
#pragma unroll
            for (int ai = 0; ai < 2; ++ai)
#pragma unroll
                for (int m = 0; m < 4; ++m) { const size_t r = (size_t)(row0 + ai * HALF + m * 16); const float rvv = rs[r];
#pragma unroll
                    for (int bj = 0; bj < 2; ++bj) { f32x4 lf[2], ka[2];
#pragma unroll
                        for (int n = 0; n < 2; ++n)
#pragma unroll
                            for (int j = 0; j < 4; ++j) { const float z = acc[ai][bj][m][n][j] * rvv, L = lbv[bj][n][j];
                                const float t = __expf(-fabsf(z)), rr = __builtin_amdgcn_rcpf(1.0f + t), sm = t * rr;
                                const float s = z >= 0.f ? rr : sm, sn = z >= 0.f ? sm : rr;
                                const float f = L + (1.0f - L) * s;
                                lf[n][j] = __logf(fmaxf(f, 1e-30f)); ka[n][j] = (1.0f - L) * sn; }
                        *(f32x4*)(logf + r * 1024 + c0 + bj * HALF) = lf[0]; *(f32x4*)(logf + r * 1024 + c0 + bj * HALF + 4) = lf[1];
                        *(u32x4*)(proj + r * 4096 + 1024 + c0 + bj * HALF) = pack8_bf16(ka[0], ka[1]); } }
        } else {
            const int c0 = (u.pn < 14 ? u.pn * BM : 3584 + (u.pn - 32) * BM) + cl; RVLOAD();
#pragma unroll
            for (int ai = 0; ai < 2; ++ai)
#pragma unroll
                for (int m = 0; m < 4; ++m) { bf16_t* rowp = proj + (size_t)(row0 + ai * HALF + m * 16) * 4096 + c0; const float rvv = RV(ai, m);
#pragma unroll
                    for (int bj = 0; bj < 2; ++bj) *(u32x4*)(rowp + bj * HALF) = pack8_bf16(acc[ai][bj][m][0] * rvv, acc[ai][bj][m][1] * rvv); }
        }
    }
};
#undef RV
#undef RVLOAD
struct EpiQfull {
    static constexpr bool PERM = true, AFTER_DRAIN = false;
    bf16_t* qn; bf16_t* qr; const float* rope; float qscale; const float* rq;
    __device__ __forceinline__ void operator()(const f32x4 (&acc)[2][2][4][2], const Unit& u, int wr, int wc, int fr, int fq) const {
        const int row0 = u.pm * BM + wr * 64 + fr, cl = wc * 32 + 8 * fq, b = u.pm >> 5, s0 = (u.pm & 31) * BM + wr * 64 + fr;
        float rv[2][4];
#pragma unroll
        for (int ai = 0; ai < 2; ++ai)
#pragma unroll
            for (int m = 0; m < 4; ++m) rv[ai][m] = qscale * rq[row0 + ai * HALF + m * 16];
        if (u.pn < 8) {
#pragma unroll
            for (int bj = 0; bj < 2; ++bj) { bf16_t* dst = qn + ((size_t)(b * 16 + 2 * u.pn + bj) * 8192 + s0) * 128 + cl;
#pragma unroll
                for (int ai = 0; ai < 2; ++ai)
#pragma unroll
                    for (int m = 0; m < 4; ++m) { const float f = rv[ai][m]; *(u32x4*)(dst + (size_t)(ai * HALF + m * 16) * 128) = pack8_bf16(acc[ai][bj][m][0] * f, acc[ai][bj][m][1] * f); } }
        } else {
            const int i0 = (cl & 63) >> 1;
#pragma unroll
            for (int ai = 0; ai < 2; ++ai) {
                f32x4 cs[4][2];
#pragma unroll
                for (int m = 0; m < 4; ++m) { const size_t r = (size_t)(row0 + ai * HALF + m * 16); cs[m][0] = *(const f32x4*)(rope + (r * 32 + i0) * 2); cs[m][1] = *(const f32x4*)(rope + (r * 32 + i0) * 2 + 4); }
#pragma unroll
                for (int m = 0; m < 4; ++m) { const int s = s0 + ai * HALF + m * 16; const float qs = rv[ai][m]; const f32x4 cs0 = cs[m][0], cs1 = cs[m][1];
#pragma unroll
                    for (int bj = 0; bj < 2; ++bj) { const int head = 4 * (u.pn - 8) + 2 * bj + (cl >> 6);
                        const f32x4 a = acc[ai][bj][m][0], bq = acc[ai][bj][m][1];
                        f32x4 oa, ob;
                        oa[0] = (a[0] * cs0[0] - a[1] * cs0[1]) * qs; oa[1] = (a[0] * cs0[1] + a[1] * cs0[0]) * qs;
                        oa[2] = (a[2] * cs0[2] - a[3] * cs0[3]) * qs; oa[3] = (a[2] * cs0[3] + a[3] * cs0[2]) * qs;
                        ob[0] = (bq[0] * cs1[0] - bq[1] * cs1[1]) * qs; ob[1] = (bq[0] * cs1[1] + bq[1] * cs1[0]) * qs;
                        ob[2] = (bq[2] * cs1[2] - bq[3] * cs1[3]) * qs; ob[3] = (bq[2] * cs1[3] + bq[3] * cs1[2]) * qs;
                        *(u32x4*)(qr + ((size_t)(b * 16 + head) * 8192 + s) * 64 + (cl & 63)) = pack8_bf16(oa, ob); } }
                asm volatile("" ::: "memory"); }
        }
    }
};
struct EpiKV {
    static constexpr bool PERM = true, AFTER_DRAIN = false;
    bf16_t* kn; bf16_t* vc; const float* rkv;
    __device__ __forceinline__ void operator()(const f32x4 (&acc)[2][2][4][2], const Unit& u, int wr, int wc, int fr, int fq) const {
        const int cl = wc * 32 + 8 * fq, b = u.pm >> 5, s0 = (u.pm & 31) * BM + wr * 64 + fr;
        const size_t off = ((size_t)(b * 16 + u.pn) * 8192 + s0) * 128 + cl;
        float rv[2][4];
#pragma unroll
        for (int ai = 0; ai < 2; ++ai)
#pragma unroll
            for (int m = 0; m < 4; ++m) rv[ai][m] = rkv[u.pm * BM + wr * 64 + fr + ai * HALF + m * 16];
#pragma unroll
        for (int ai = 0; ai < 2; ++ai)
#pragma unroll
            for (int m = 0; m < 4; ++m) { const float f = rv[ai][m]; const size_t o2 = off + (size_t)(ai * HALF + m * 16) * 128;
                *(u32x4*)(kn + o2) = pack8_bf16(acc[ai][0][m][0] * f, acc[ai][0][m][1] * f); *(u32x4*)(vc + o2) = pack8_bf16(acc[ai][1][m][0] * f, acc[ai][1][m][1] * f); }
    }
};
struct EpiQmem {
    static constexpr bool PERM = true, AFTER_DRAIN = false;
    bf16_t* qm; float scale; const float* rs;
    __device__ __forceinline__ void operator()(const f32x4 (&acc)[2][2][4][2], const Unit& u, int wr, int wc, int fr, int fq) const {
        const int cl = wc * 32 + 8 * fq, b = u.pm >> 5, s0 = (u.pm & 31) * BM + wr * 64 + fr;
        float rv[2][4];
#pragma unroll
        for (int ai = 0; ai < 2; ++ai)
#pragma unroll
            for (int m = 0; m < 4; ++m) rv[ai][m] = scale * rs[u.pm * BM + wr * 64 + fr + ai * HALF + m * 16];
#pragma unroll
        for (int bj = 0; bj < 2; ++bj) { bf16_t* dst = qm + ((size_t)(b * 4 + 2 * u.pn + bj) * 8192 + s0) * 128 + cl;
#pragma unroll
            for (int ai = 0; ai < 2; ++ai)
#pragma unroll
                for (int m = 0; m < 4; ++m) { const float f = rv[ai][m]; *(u32x4*)(dst + (size_t)(ai * HALF + m * 16) * 128) = pack8_bf16(acc[ai][bj][m][0] * f, acc[ai][bj][m][1] * f); } }
    }
};
struct EpiKVmem {
    static constexpr bool PERM = true, AFTER_DRAIN = false;
    bf16_t* km; bf16_t* vm;
    __device__ __forceinline__ void operator()(const f32x4 (&acc)[2][2][4][2], const Unit& u, int wr, int wc, int fr, int fq) const {
        const int cl = wc * 32 + 8 * fq, b = u.pm, s0 = wr * 64 + fr;
        bf16_t* base = u.pn < 2 ? km : vm; const int hp = u.pn & 1;
#pragma unroll
        for (int bj = 0; bj < 2; ++bj) store_hm<128>(acc, bj, base + ((size_t)(b * 4 + 2 * hp + bj) * 256 + s0) * 128 + cl, 1.0f);
    }
};
template <class Epi, class Sched, bool ALIGN_EPI = false, bool SP2 = false>
__device__ __forceinline__ void gemm_phase(PG8_LAS unsigned char* lds, const Gemm g, const Sched& S, const Epi& E, int tid_in) {
    int tid_ = tid_in; asm volatile("" : "+v"(tid_));
    const int tid = tid_, wid = __builtin_amdgcn_readfirstlane(tid >> 6), lane = tid & 63, wr = wid >> 2, wc = wid & 3, fr = lane & 15, fq = lane >> 4;
    const int K = g.ld ? g.ld : g.K  , nt = g.K / BK;
    unsigned voffA[2], voffB[2];
#pragma unroll
    for (int i = 0; i < 2; ++i) { int R, C; stage_rc(tid * 16 + i * 8192, R, C); const int Rb = Epi::PERM ? ((R & ~31) + perm32(R & 31)) : R;
        voffA[i] = (unsigned)(R * K + C) * 2u; voffB[i] = (unsigned)(Rb * K + C) * 2u; }
    const size_t kstep = (size_t)(BK * 2);
    const size_t hstep = (size_t)HALF * K * 2;
    const size_t tstep = 2 * hstep;
    const unsigned ldsw = (unsigned)wid * 1024u;
    const int aoff = lds_byte(wr * 64 + fr, fq * 8), boff = lds_byte(wc * 32 + fr, fq * 8);
#define PG8_SA(b, h) (((b) * 2 + (h)) * HTB)
#define PG8_SB(b, h) ((4 + (b) * 2 + (h)) * HTB)
#define PG8_STAGE(bufoff, gbase, voff) do { _Pragma("unroll") for (int _i = 0; _i < 2; ++_i) \
        __builtin_amdgcn_global_load_lds((const unsigned*)((const char*)(gbase) + (voff)[_i]), (PG8_LAS unsigned*)(lds + (bufoff) + ldsw + _i * 8192), 16, 0, 0); } while (0)
#define PG8_LDA(dst, b, h) do { _Pragma("unroll") for (int m = 0; m < 4; ++m) _Pragma("unroll") for (int k = 0; k < 2; ++k) dst[m][k] = *(const PG8_LAS bf16x8*)(lds + PG8_SA(b, h) + aoff + m * 2048 + k * 1024); } while (0)
#define PG8_LDB(dst, b, h) do { _Pragma("unroll") for (int n = 0; n < 2; ++n) _Pragma("unroll") for (int k = 0; k < 2; ++k) dst[n][k] = *(const PG8_LAS bf16x8*)(lds + PG8_SB(b, h) + boff + n * 2048 + k * 1024); } while (0)
#define PG8_MMA(ai, bj, At, Bt) do { __builtin_amdgcn_s_setprio(1); _Pragma("unroll") for (int m = 0; m < 4; ++m) _Pragma("unroll") for (int n = 0; n < 2; ++n) _Pragma("unroll") for (int k = 0; k < 2; ++k) \
        acc[ai][bj][m][n] = __builtin_amdgcn_mfma_f32_16x16x32_bf16(Bt[n][k], At[m][k], acc[ai][bj][m][n], 0, 0, 0); __builtin_amdgcn_s_setprio(0); } while (0)
#define PG8_WAIT_V(n) asm volatile("s_waitcnt vmcnt(" #n ")" ::: "memory")
#define PG8_WAIT_L(n) asm volatile("s_waitcnt lgkmcnt(" #n ")" ::: "memory")
#define PG8_BAR __builtin_amdgcn_s_barrier()
#define PG8_SCHED __builtin_amdgcn_sched_barrier(0)
    Unit cur, nxt; int ui = 0;
    if (!S.next(0, cur)) return;
    f32x4 acc[2][2][4][2];
#pragma unroll
    for (int a = 0; a < 2; ++a)
#pragma unroll
        for (int b = 0; b < 2; ++b)
#pragma unroll
            for (int m = 0; m < 4; ++m)
#pragma unroll
                for (int n = 0; n < 2; ++n) acc[a][b][m][n] = (f32x4){0.f, 0.f, 0.f, 0.f};
    bf16x8 At[4][2], B0[2][2], B1[2][2];
    const char* cA = (const char*)g.A + (size_t)cur.pm * tstep + (size_t)cur.ko * 2; const char* cB = (const char*)g.Bt + (size_t)cur.pn * tstep + (size_t)cur.ko * 2;
    S.a_ready(cur);
    if constexpr (SP2) {
        PG8_STAGE(PG8_SB(0, 0), cB, voffB); PG8_STAGE(PG8_SB(0, 1), cB + hstep, voffB); PG8_STAGE(PG8_SA(0, 0), cA, voffA); PG8_STAGE(PG8_SA(0, 1), cA + hstep, voffA);
        if (wr == 1) PG8_BAR;
        PG8_WAIT_V(2); PG8_BAR;
        PG8_STAGE(PG8_SB(1, 0), cB + kstep, voffB); PG8_STAGE(PG8_SA(1, 0), cA + kstep, voffA); PG8_STAGE(PG8_SB(1, 1), cB + hstep + kstep, voffB);
        PG8_WAIT_V(6); PG8_BAR;
    } else {
        PG8_STAGE(PG8_SB(0, 0), cB, voffB); PG8_STAGE(PG8_SA(0, 0), cA, voffA); PG8_STAGE(PG8_SB(0, 1), cB + hstep, voffB); PG8_STAGE(PG8_SA(0, 1), cA + hstep, voffA);
        if (wr == 1) PG8_BAR;
        PG8_WAIT_V(4); PG8_BAR;
        PG8_STAGE(PG8_SB(1, 0), cB + kstep, voffB); PG8_STAGE(PG8_SA(1, 0), cA + kstep, voffA); PG8_STAGE(PG8_SB(1, 1), cB + hstep + kstep, voffB);
        PG8_WAIT_V(6); PG8_BAR;
    }
    for (;;) {
        const bool has_next = S.next(ui + 1, nxt);
        const char* nA = has_next ? (const char*)g.A + (size_t)nxt.pm * tstep + (size_t)nxt.ko * 2 : cA; const char* nB = has_next ? (const char*)g.Bt + (size_t)nxt.pn * tstep + (size_t)nxt.ko * 2 : cB;
        for (int t = 0; t < nt; t += 2) {
            const bool last = (t == nt - 2);
            const char* a1 = cA + (size_t)(t + 1) * kstep;
            const char* a2 = last ? nA : cA + (size_t)(t + 2) * kstep; const char* b2 = last ? nB : cB + (size_t)(t + 2) * kstep;
            const char* a3 = a2 + kstep; const char* b3 = b2 + kstep;
            if (last && has_next) S.a_ready(nxt);
            if constexpr (SP2) {
            PG8_LDB(B0, 0, 0); PG8_LDB(B1, 0, 1); PG8_SCHED; PG8_LDA(At, 0, 0); PG8_STAGE(PG8_SA(1, 1), a1 + hstep, voffA);
            PG8_WAIT_V(8); PG8_WAIT_L(0); PG8_BAR; PG8_MMA(0, 0, At, B0); PG8_MMA(0, 1, At, B1); PG8_BAR; PG8_SCHED;
            PG8_LDA(At, 0, 1); PG8_STAGE(PG8_SB(0, 0), b2, voffB); PG8_STAGE(PG8_SB(0, 1), b2 + hstep, voffB); PG8_STAGE(PG8_SA(0, 0), a2, voffA);
            PG8_WAIT_V(8); PG8_WAIT_L(0); PG8_BAR; PG8_MMA(1, 0, At, B0); PG8_MMA(1, 1, At, B1); PG8_BAR; PG8_SCHED;
            PG8_LDB(B0, 1, 0); PG8_LDB(B1, 1, 1); PG8_SCHED; PG8_LDA(At, 1, 0); PG8_STAGE(PG8_SA(0, 1), a2 + hstep, voffA);
            PG8_WAIT_V(8); PG8_WAIT_L(0); PG8_BAR; PG8_MMA(0, 0, At, B0); PG8_MMA(0, 1, At, B1); PG8_BAR; PG8_SCHED;
            PG8_LDA(At, 1, 1); PG8_STAGE(PG8_SB(1, 0), b3, voffB); PG8_STAGE(PG8_SB(1, 1), b3 + hstep, voffB); PG8_STAGE(PG8_SA(1, 0), a3, voffA);
            PG8_WAIT_V(8); PG8_WAIT_L(0); PG8_BAR; PG8_MMA(1, 0, At, B0); PG8_MMA(1, 1, At, B1); PG8_BAR; PG8_SCHED;
            } else {
            PG8_LDB(B0, 0, 0); PG8_SCHED; PG8_LDA(At, 0, 0); PG8_STAGE(PG8_SA(1, 1), a1 + hstep, voffA);
            PG8_WAIT_L(8); PG8_BAR; PG8_WAIT_L(0); PG8_MMA(0, 0, At, B0); PG8_BAR; PG8_SCHED;
            PG8_LDB(B1, 0, 1); PG8_STAGE(PG8_SB(0, 0), b2, voffB);
            PG8_BAR; PG8_WAIT_L(0); PG8_MMA(0, 1, At, B1); PG8_BAR;
            PG8_LDA(At, 0, 1); PG8_STAGE(PG8_SA(0, 0), a2, voffA);
            PG8_BAR; PG8_WAIT_L(0); PG8_MMA(1, 0, At, B0); PG8_BAR; PG8_SCHED;
            PG8_STAGE(PG8_SB(0, 1), b2 + hstep, voffB);
            PG8_WAIT_V(6); PG8_BAR; PG8_MMA(1, 1, At, B1); PG8_BAR;
            PG8_LDB(B0, 1, 0); PG8_SCHED; PG8_LDA(At, 1, 0); PG8_STAGE(PG8_SA(0, 1), a2 + hstep, voffA);
            PG8_WAIT_L(8); PG8_BAR; PG8_WAIT_L(0); PG8_MMA(0, 0, At, B0); PG8_BAR; PG8_SCHED;
            PG8_LDB(B1, 1, 1); PG8_STAGE(PG8_SB(1, 0), b3, voffB);
            PG8_BAR; PG8_WAIT_L(0); PG8_MMA(0, 1, At, B1); PG8_BAR;
            PG8_LDA(At, 1, 1); PG8_STAGE(PG8_SA(1, 0), a3, voffA);
            PG8_BAR; PG8_WAIT_L(0); PG8_MMA(1, 0, At, B0); PG8_BAR; PG8_SCHED;
            PG8_STAGE(PG8_SB(1, 1), b3 + hstep, voffB);
            PG8_WAIT_V(6); PG8_BAR; PG8_MMA(1, 1, At, B1); PG8_BAR;
            }
        }
        if constexpr (ALIGN_EPI) { if (wr == 0) PG8_BAR; }
        if constexpr (!Epi::AFTER_DRAIN) { E(acc, cur, wr, wc, fr, fq); S.done(cur); }
        if (!has_next) break;
#pragma unroll
        for (int a = 0; a < 2; ++a)
#pragma unroll
            for (int b = 0; b < 2; ++b)
#pragma unroll
                for (int m = 0; m < 4; ++m)
#pragma unroll
                    for (int n = 0; n < 2; ++n) acc[a][b][m][n] = (f32x4){0.f, 0.f, 0.f, 0.f};
        cur = nxt; cA = nA; cB = nB; ++ui;
        if constexpr (ALIGN_EPI) { if (wr == 1) PG8_BAR; }
    }
    PG8_WAIT_V(0);
    if constexpr (!ALIGN_EPI) { if (wr == 0) PG8_BAR; }
    PG8_BAR;
    if constexpr (Epi::AFTER_DRAIN) { E.fused(acc, cur, wr, wc, fr, fq, lds, wid, lane); S.done(cur); }
#undef PG8_SA
#undef PG8_SB
#undef PG8_STAGE
#undef PG8_LDA
#undef PG8_LDB
#undef PG8_MMA
#undef PG8_WAIT_V
#undef PG8_WAIT_L
#undef PG8_BAR
#undef PG8_SCHED
}
}
namespace att {
typedef unsigned short bf16;
typedef short bf16x8 __attribute__((ext_vector_type(8)));
typedef short s16x4 __attribute__((ext_vector_type(4)));
typedef float f32x16 __attribute__((ext_vector_type(16)));
typedef float f32x4 __attribute__((ext_vector_type(4)));
typedef unsigned u32x4 __attribute__((ext_vector_type(4)));
constexpr int NW = 8, QBLK = 32, KVBLK = 64, QB = NW * QBLK, D = 128;
constexpr int SHM_V = KVBLK * D * 2, SHM_K = KVBLK * D * 2, XROW = 144, SHM_X = KVBLK * XROW;
constexpr int OFF_V = 0, OFF_K = 2 * SHM_V, OFF_X = OFF_K + 2 * SHM_K, OFF_WS = OFF_X + 2 * SHM_X, OFF_QX = OFF_WS + NW * 64 * 4;
constexpr int QL = 5;
constexpr int QXW = (4 + QL) * 1024, ATT_LDS_BYTES = OFF_QX + NW * QXW;
constexpr float THR = 11.5f;
constexpr float RMS_EPS = 1e-6f;

#define KSWZ(row, colB) ((row) * 256 + ((colB) ^ (((row) & 7) << 4)))
#define SBAR() __builtin_amdgcn_sched_barrier(0)
__device__ __forceinline__ int v_st(int k, int c) { const int kk = (k & ~0xC) | ((k & 4) << 1) | ((k & 8) >> 1); return ((kk >> 3) * 4 + (c >> 5)) * 512 + ((kk & 7) * 32 + (c & 31)) * 2; }
__device__ __forceinline__ int v_rd_base(int lane) { return ((lane & 3) << 3) | (((lane >> 2) & 3) << 6) | (((lane >> 4) & 1) << 5) | (((lane >> 5) & 1) << 8); }
constexpr int v_rd_off(int d0, int ks, int half) { return d0 * 512 + ks * 4096 + half * 2048; }
__device__ __forceinline__ int crow(int r, int hi) { return (r & 3) + 8 * (r >> 2) + 4 * hi; }
__device__ __forceinline__ unsigned cvtpk(float lo, float hi) { unsigned r; asm volatile("v_cvt_pk_bf16_f32 %0, %1, %2" : "=v"(r) : "v"(lo), "v"(hi)); return r; }
__device__ __forceinline__ bf16x8 load8(const bf16* p) { return *reinterpret_cast<const bf16x8*>(p); }
__device__ __forceinline__ void mask_tile(f32x16& p0, f32x16& p1, int dq, unsigned W) {
    const float NEG = -__builtin_inff();
#pragma unroll
    for (int r = 0; r < 16; ++r) {
        const int c = (r & 3) + 8 * (r >> 2);
        if ((unsigned)(dq - c) >= W) p0[r] = NEG;
        if ((unsigned)(dq - c - 32) >= W) p1[r] = NEG;
    }
}
__device__ __forceinline__ void partialSM(f32x16& p0, f32x16& p1, float& m_reg, float& mn, float& alpha) {
    float pmax = p0[0]; for (int r = 1; r < 16; ++r) pmax = fmaxf(pmax, p0[r]); for (int r = 0; r < 16; ++r) pmax = fmaxf(pmax, p1[r]);
    { auto rr = __builtin_amdgcn_permlane32_swap(__float_as_uint(pmax), __float_as_uint(pmax), false, false);
      pmax = fmaxf(__uint_as_float(rr[0]), __uint_as_float(rr[1])); }
    if (__builtin_expect(__all((pmax - m_reg) <= THR), 1)) { mn = m_reg; alpha = 1.f; }
    else { mn = fmaxf(m_reg, pmax); alpha = __builtin_amdgcn_exp2f(m_reg - mn); m_reg = mn; }
    for (int r = 0; r < 16; ++r) p0[r] = p0[r] - mn; for (int r = 0; r < 16; ++r) p1[r] = p1[r] - mn;
    for (int r = 0; r < 16; ++r) p0[r] = __builtin_amdgcn_exp2f(p0[r]);
}
__device__ __forceinline__ void finishSM(f32x16& p0, f32x16& p1, float alpha, float& l_reg, bf16x8& pa0, bf16x8& pa1, bf16x8& pa2, bf16x8& pa3) {
    for (int r = 0; r < 16; ++r) p1[r] = __builtin_amdgcn_exp2f(p1[r]);
    float ps = 0; for (int r = 0; r < 16; ++r) ps += p0[r]; for (int r = 0; r < 16; ++r) ps += p1[r];
    { auto rr = __builtin_amdgcn_permlane32_swap(__float_as_uint(ps), __float_as_uint(ps), false, false);
      ps = __uint_as_float(rr[0]) + __uint_as_float(rr[1]); }
    l_reg = l_reg * alpha + ps;
#define PK4(P, B_, OUT) do { unsigned a0 = cvtpk(P[B_+0], P[B_+1]), a1 = cvtpk(P[B_+2], P[B_+3]);                          \
        unsigned b0 = cvtpk(P[B_+4], P[B_+5]), b1 = cvtpk(P[B_+6], P[B_+7]);                                             \
        auto r0 = __builtin_amdgcn_permlane32_swap(a0, b0, false, false); auto r1 = __builtin_amdgcn_permlane32_swap(a1, b1, false, false); \
        u32x4 w = {r0[0], r1[0], r0[1], r1[1]}; OUT = *reinterpret_cast<bf16x8*>(&w); } while (0)
    PK4(p0, 0, pa0); PK4(p0, 8, pa1); PK4(p1, 0, pa2); PK4(p1, 8, pa3);
#undef PK4
}
template <int KB, bool EXT>
__device__ __forceinline__ void qkt(f32x16& p0, f32x16& p1, const char* K_lds, const char* X_lds, int r32, int hi, const bf16x8* qr, const char* qxl) {
    p0 = f32x16{}; p1 = f32x16{};
    const char* kb[4];
#pragma unroll
    for (int dd = 0; dd < 4; ++dd) kb[dd] = K_lds + KB * SHM_K + KSWZ(r32, (dd * 16 + hi * 8) * 2);
#pragma unroll
    for (int d0 = 0; d0 < 8; ++d0) { const char* a = kb[d0 & 3] + (d0 >> 2) * 128;
        bf16x8 b0 = *reinterpret_cast<const bf16x8*>(a);
        bf16x8 b1 = *reinterpret_cast<const bf16x8*>(a + 32 * 256);
        bf16x8 qf; if (EXT && d0 >= 8 - QL) qf = *reinterpret_cast<const bf16x8*>(qxl + (4 + d0 - (8 - QL)) * 1024); else qf = qr[d0];
        p0 = __builtin_amdgcn_mfma_f32_32x32x16_bf16(b0, qf, p0, 0, 0, 0);
        p1 = __builtin_amdgcn_mfma_f32_32x32x16_bf16(b1, qf, p1, 0, 0, 0); }
    if constexpr (EXT) { const char* xb = X_lds + KB * SHM_X + r32 * XROW + hi * 16;
#pragma unroll
        for (int dd = 0; dd < 4; ++dd) {
            bf16x8 b0 = *reinterpret_cast<const bf16x8*>(xb + dd * 32);
            bf16x8 b1 = *reinterpret_cast<const bf16x8*>(xb + dd * 32 + 32 * XROW);
            const bf16x8 qf = *reinterpret_cast<const bf16x8*>(qxl + dd * 1024);
            p0 = __builtin_amdgcn_mfma_f32_32x32x16_bf16(b0, qf, p0, 0, 0, 0);
            p1 = __builtin_amdgcn_mfma_f32_32x32x16_bf16(b1, qf, p1, 0, 0, 0); } }
}
template <int VB>
__device__ __forceinline__ void pv_tile(f32x16* o, int vb0, bf16x8 pa0, bf16x8 pa1, bf16x8 pa2, bf16x8 pa3) {
#define TRRD(dst, off) asm volatile("ds_read_b64_tr_b16 %0, %1 offset:%2" : "=&v"(dst) : "v"(vb0), "i"(off) : "memory")
#define PV_D0(d0) do { s16x4 l0, l1, l2, l3, h0, h1, h2, h3; constexpr int b_ = VB * SHM_V + v_rd_off(d0, 0, 0);     \
        TRRD(l0, b_); TRRD(h0, b_ + 2048); TRRD(l1, b_ + 4096); TRRD(h1, b_ + 6144); TRRD(l2, b_ + 8192); TRRD(h2, b_ + 10240); TRRD(l3, b_ + 12288); TRRD(h3, b_ + 14336); \
        asm volatile("s_waitcnt lgkmcnt(0)" ::: "memory"); SBAR();   \
        o[d0] = __builtin_amdgcn_mfma_f32_32x32x16_bf16(pa0, (bf16x8){l0[0], l0[1], l0[2], l0[3], h0[0], h0[1], h0[2], h0[3]}, o[d0], 0, 0, 0);   \
        o[d0] = __builtin_amdgcn_mfma_f32_32x32x16_bf16(pa1, (bf16x8){l1[0], l1[1], l1[2], l1[3], h1[0], h1[1], h1[2], h1[3]}, o[d0], 0, 0, 0);   \
        o[d0] = __builtin_amdgcn_mfma_f32_32x32x16_bf16(pa2, (bf16x8){l2[0], l2[1], l2[2], l2[3], h2[0], h2[1], h2[2], h2[3]}, o[d0], 0, 0, 0);   \
        o[d0] = __builtin_amdgcn_mfma_f32_32x32x16_bf16(pa3, (bf16x8){l3[0], l3[1], l3[2], l3[3], h3[0], h3[1], h3[2], h3[3]}, o[d0], 0, 0, 0); } while (0)
    PV_D0(0); PV_D0(1); PV_D0(2); PV_D0(3);
#undef PV_D0
#undef TRRD
}

struct BlockRef { const bf16* Q; const bf16* K; const bf16* V; const bf16* QX; const bf16* KX; bf16* O; const float* G; int P0; int jlo; };
template <bool EXT> struct Seam { bf16x8 qr[8]; bf16x8 st_v0, st_v1, st_k0, st_k1, st_x; };
__device__ __forceinline__ int swa_jlo(int P0, int W) { const int lowk = P0 - W + 1; return lowk > 0 ? lowk / KVBLK : 0; }
#define VMW() asm volatile("s_waitcnt vmcnt(0)" ::: "memory")
#define VMWN(n) asm volatile("s_waitcnt vmcnt(%0)" :: "i"(n) : "memory")
#define SLOAD_H(R, k0) do { S.st_v0 = load8((R).V + (size_t)((k0) + sr) * D + sc); S.st_v1 = load8((R).V + (size_t)((k0) + 32 + sr) * D + sc);              \
                            S.st_k0 = load8((R).K + (size_t)((k0) + sr) * D + sc); S.st_k1 = load8((R).K + (size_t)((k0) + 32 + sr) * D + sc);              \
                            if constexpr (EXT) S.st_x = load8((R).KX + (size_t)((k0) + xr) * 64 + xc * 8); } while (0)
#define SWRITE_HK(bf) do { *(bf16x8*)(K_lds + (bf) * SHM_K + kws) = S.st_k0; *(bf16x8*)(K_lds + (bf) * SHM_K + kws + 32 * 256) = S.st_k1; \
                           if constexpr (EXT) *(bf16x8*)(X_lds + (bf) * SHM_X + xws) = S.st_x; } while (0)
#define SWRITE_HV(bf) do { *(bf16x8*)(V_lds + (bf) * SHM_V + vst0) = S.st_v0; *(bf16x8*)(V_lds + (bf) * SHM_V + vst1) = S.st_v1; } while (0)
#define SWRITE_H(bf) do { SWRITE_HV(bf); SWRITE_HK(bf); } while (0)
#define LDS3 __attribute__((address_space(3)))
#define QLOADS(R) do { const bf16* qrow_ = (R).Q + (size_t)(wid * QBLK + r32) * D + hi * 8; \
        if constexpr (EXT) { _Pragma("unroll") for (int d0 = 0; d0 < 8 - QL; ++d0) S.qr[d0] = load8(qrow_ + d0 * 16); \
            const bf16* qxrow_ = (R).QX + (size_t)(wid * QBLK + r32) * 64 + hi * 8; \
            _Pragma("unroll") for (int dd = 0; dd < 4; ++dd) __builtin_amdgcn_global_load_lds((const unsigned*)(qxrow_ + dd * 16), (LDS3 unsigned*)(qxw + dd * 1024), 16, 0, 0); \
            _Pragma("unroll") for (int d0 = 8 - QL; d0 < 8; ++d0) __builtin_amdgcn_global_load_lds((const unsigned*)(qrow_ + d0 * 16), (LDS3 unsigned*)(qxw + (4 + d0 - (8 - QL)) * 1024), 16, 0, 0); } \
        else { _Pragma("unroll") for (int d0 = 0; d0 < 8; ++d0) S.qr[d0] = load8(qrow_ + d0 * 16); } } while (0)
template <bool EXT>
__device__ __forceinline__ void attn_prime(const BlockRef& cur, int W, char* lds, Seam<EXT>& S, int tid_in) {
    int tid_ = tid_in; asm volatile("" : "+v"(tid_));
    const int tid = tid_, wid = __builtin_amdgcn_readfirstlane(tid >> 6), lane = tid & 63, r32 = lane & 31, hi = lane >> 5;
    const int sr = tid >> 4, sc = (tid & 15) * 8, kws = KSWZ(sr, sc * 2), xr = tid >> 3, xc = tid & 7, xws = xr * XROW + xc * 16;
    char* K_lds = lds + OFF_K; char* X_lds = lds + OFF_X; char* qxw = lds + OFF_QX + wid * QXW;
    const int kb0 = cur.jlo * KVBLK;
    QLOADS(cur);
    SLOAD_H(cur, kb0); VMW(); SWRITE_HK(0);
    __syncthreads();
}
template <bool EXT, bool NORM, int LDO>
__device__ __forceinline__ void attn_block(const BlockRef& cur, const BlockRef& nxt, int skv, int W, char* lds, Seam<EXT>& S, int tid_in) {
    int tid_ = tid_in; asm volatile("" : "+v"(tid_));
    const int tid = tid_, wid = __builtin_amdgcn_readfirstlane(tid >> 6), lane = tid & 63, r32 = lane & 31, hi = lane >> 5;
    const int j_lo = cur.jlo;
    int j_hi = (cur.P0 + QB - 1) / KVBLK + 1; if (j_hi > skv / KVBLK) j_hi = skv / KVBLK;
    const int NT = j_hi - j_lo;
    const int kbn = nxt.jlo * KVBLK;
    const int qlo = cur.P0 + wid * QBLK, qm = qlo + r32 - 4 * hi;
    char* V_lds = lds + OFF_V; char* K_lds = lds + OFF_K; char* X_lds = lds + OFF_X;
    float* ws = (float*)(lds + OFF_WS) + wid * 64; float* li_l = ws, * al_l = ws + 32;
    char* qxw = lds + OFF_QX + wid * QXW; char* qxl = qxw + lane * 16;
    float m_reg = -1e30f, l_reg = 0; f32x16 o[4] = {};
    const int sr = tid >> 4, sc = (tid & 15) * 8, vst0 = v_st(sr, sc), vst1 = v_st(32 + sr, sc), kws = KSWZ(sr, sc * 2), xr = tid >> 3, xc = tid & 7, xws = xr * XROW + xc * 16;
    const int vb0 = (int)(uintptr_t)V_lds + v_rd_base(lane);
#define RESC(a) do { if (__any((a) < 1.f)) { if (hi == 0) al_l[r32] = (a); asm volatile("s_waitcnt lgkmcnt(0)" ::: "memory");              \
                     for (int d_ = 0; d_ < 4; ++d_) for (int r = 0; r < 16; ++r) o[d_][r] *= al_l[crow(r, hi)]; } } while (0)
#define KBASE(t) ((j_lo + (t)) * KVBLK)
#define MASKT(P0_, P1_, t) do { const int kb_ = KBASE(t); if (kb_ + KVBLK - 1 > qlo || kb_ <= qlo + QBLK - 1 - W) mask_tile(P0_, P1_, qm - kb_, (unsigned)W); } while (0)
    constexpr int NQL = EXT ? 12 : 8;
#define SEAM_K0() do { VMWN(NQL); SWRITE_HK(0); SBAR(); } while (0)
    f32x16 pA0, pA1, pB0, pB1; float mnA, mnB, alA, alB; bf16x8 pa0, pa1, pa2, pa3;
    SWRITE_HV(0); SBAR();
    if constexpr (EXT) { VMW(); SBAR(); }
    if (NT > 1) { SLOAD_H(cur, KBASE(1)); }
    SBAR(); qkt<0, EXT>(pA0, pA1, K_lds, X_lds, r32, hi, S.qr, qxl);
    MASKT(pA0, pA1, 0); partialSM(pA0, pA1, m_reg, mnA, alA);
    if (NT > 1) { VMW(); SWRITE_H(1); }
    __syncthreads();
#define HALF_STEP(PX0, PX1, mnX, alX, PY0, PY1, alY, t, KB, VB, SB) do {                                                      \
        SBAR(); qkt<KB, EXT>(PX0, PX1, K_lds, X_lds, r32, hi, S.qr, qxl);                                                     \
        finishSM(PY0, PY1, alY, l_reg, pa0, pa1, pa2, pa3); SBAR();                                                           \
        if ((t) + 1 < NT) { SLOAD_H(cur, KBASE((t) + 1)); SBAR(); }                                                           \
        pv_tile<VB>(o, vb0, pa0, pa1, pa2, pa3); MASKT(PX0, PX1, (t)); partialSM(PX0, PX1, m_reg, mnX, alX);                  \
        __syncthreads();                                                                                                      \
        if ((t) + 1 < NT) { VMW(); SWRITE_H(SB); }                                                                            \
        RESC(alX); __syncthreads(); } while (0)
    for (int t = 1; t + 1 < NT; t += 2) {
        HALF_STEP(pB0, pB1, mnB, alB, pA0, pA1, alA, t, 1, 0, 0);
        HALF_STEP(pA0, pA1, mnA, alA, pB0, pB1, alB, t + 1, 0, 1, 1);
    }
    const bool even = (NT & 1) == 0;
    if (even) { SBAR(); qkt<1, EXT>(pB0, pB1, K_lds, X_lds, r32, hi, S.qr, qxl); SBAR(); }
    SLOAD_H(nxt, kbn); SBAR();
    QLOADS(nxt);
    SBAR();
    finishSM(pA0, pA1, alA, l_reg, pa0, pa1, pa2, pa3); SBAR();
    pv_tile<0>(o, vb0, pa0, pa1, pa2, pa3);
    if (even) { MASKT(pB0, pB1, NT - 1); partialSM(pB0, pB1, m_reg, mnB, alB); __syncthreads(); RESC(alB);
        finishSM(pB0, pB1, alB, l_reg, pa0, pa1, pa2, pa3); SBAR(); pv_tile<1>(o, vb0, pa0, pa1, pa2, pa3); }
    SBAR(); SEAM_K0();
    if (hi == 0) li_l[r32] = l_reg; asm volatile("s_waitcnt lgkmcnt(0)" ::: "memory");
    float rli[16];
#pragma unroll
    for (int r = 0; r < 16; ++r) rli[r] = __builtin_amdgcn_rcpf(li_l[crow(r, hi)]);
    if constexpr (NORM) {
        float g4[4];
#pragma unroll
        for (int d0 = 0; d0 < 4; ++d0) g4[d0] = cur.G[d0 * 32 + r32];
#pragma unroll
        for (int r = 0; r < 16; ++r) { float ss = 0.f;
#pragma unroll
            for (int d0 = 0; d0 < 4; ++d0) { o[d0][r] *= rli[r]; ss += o[d0][r] * o[d0][r]; }
            ss += __shfl_xor(ss, 1); ss += __shfl_xor(ss, 2); ss += __shfl_xor(ss, 4); ss += __shfl_xor(ss, 8); ss += __shfl_xor(ss, 16);
            rli[r] = __builtin_amdgcn_rsqf(ss * (1.0f / 128.0f) + RMS_EPS); }
#pragma unroll
        for (int r = 0; r < 16; ++r)
#pragma unroll
            for (int d0 = 0; d0 < 4; ++d0) o[d0][r] *= rli[r] * g4[d0];
    } else {
#pragma unroll
        for (int r = 0; r < 16; ++r)
#pragma unroll
            for (int d0 = 0; d0 < 4; ++d0) o[d0][r] *= rli[r];
    }
    bf16* Ow = cur.O + (size_t)(wid * QBLK) * LDO;
#pragma unroll
    for (int r = 0; r < 16; ++r) { const int orow = crow(r, hi);
#pragma unroll
        for (int d0 = 0; d0 < 4; ++d0) { const float v = o[d0][r];
            const float vn = __shfl_xor(v, 1);
            if ((r32 & 1) == 0) *(unsigned*)(Ow + (size_t)orow * LDO + d0 * 32 + r32) = cvtpk(v, vn); } }
    __syncthreads();
#undef RESC
#undef KBASE
#undef MASKT
#undef SEAM_K0
#undef HALF_STEP
}
#undef VMW
#undef VMWN
#undef SLOAD_H
#undef SWRITE_HK
#undef SWRITE_HV
#undef SWRITE_H
#undef QLOADS
#undef LDS3
#undef KSWZ
}
constexpr int NWAVES = 8;
constexpr int BATCH = 2, SEQ = 8192, DM = 4096, DEPTH = 4, M = BATCH * SEQ;
constexpr int IN_COLS = 8520, NIN = 8704, DFF = 16384, MEMT = 256;
constexpr float EPS = 1e-6f;
constexpr float LOG2E = 1.4426950408889634f;
constexpr float QSCALE_MLA = 0.07216878364870323f * LOG2E;
constexpr float QSCALE_128 = 0.08838834764831845f * LOG2E;

constexpr size_t MiB = 1u << 20;
constexpr size_t WS_CTL = 0, CTL_ZERO_BYTES = 1 * MiB;
constexpr size_t WS_ROPE = 1 * MiB;
constexpr size_t WS_LB = 5 * MiB;
constexpr size_t WS_FOXLF = 5 * MiB + 512 * 1024;
constexpr size_t WS_ADEC = 6 * MiB;
constexpr size_t WS_FOXC = 7 * MiB;
constexpr size_t WS_FOXQM = 7 * MiB + 512 * 1024;
constexpr size_t WS_FOXKM = 7 * MiB + 516 * 1024;
constexpr size_t WS_RQ = 7 * MiB + 640 * 1024, WS_RKV = 7 * MiB + 704 * 1024;
constexpr size_t WS_CSS = 28 * MiB;
constexpr size_t WS_MEMN = 8 * MiB;
constexpr size_t WS_KVMEM = 24 * MiB;
constexpr size_t WS_W = 32 * MiB, W_LAYER = 384 * MiB;
constexpr size_t W_IN = 0, W_UQ = 68 * MiB, W_UKV = 73 * MiB, W_O = 77 * MiB, W_MQ = 109 * MiB, W_MKV = 113 * MiB, W_MO = 121 * MiB, W_FF1 = 125 * MiB, W_FF2 = 253 * MiB;
constexpr size_t WS_HN = 1568 * MiB;
constexpr size_t WS_Y = 1696 * MiB;
constexpr size_t WS_YSS = 1824 * MiB;
constexpr size_t WS_HSS = 1828 * MiB;
constexpr size_t WS_QMEM = 1952 * MiB, WS_OMEM = 1968 * MiB;
constexpr size_t WS_MIXER = 1984 * MiB;
constexpr size_t WS_PROJ = WS_MIXER  , WS_FOX = WS_MIXER + 128 * MiB  , WS_LOGF = WS_MIXER + 224 * MiB, WS_PROJX = WS_MIXER + 288 * MiB  , WS_GP = WS_MIXER + 304 * MiB  , WS_CQN = WS_MIXER + 384 * MiB, WS_CKVN = WS_MIXER + 408 * MiB,
                 WS_KROT = WS_MIXER + 424 * MiB, WS_QN = WS_MIXER + 426 * MiB, WS_QR = WS_MIXER + 490 * MiB, WS_KN = WS_MIXER + 522 * MiB, WS_VC = WS_MIXER + 586 * MiB, WS_LT = WS_MIXER + 650 * MiB,
                 WS_ST = WS_MIXER + 778 * MiB, WS_MIX = WS_MIXER + 842 * MiB, WS_QEXT = WS_MIXER + 970 * MiB, WS_KEXT = WS_MIXER + 986 * MiB, WS_MIXER_END = WS_MIXER + 1002 * MiB;
constexpr size_t WS_HID = WS_MIXER;
constexpr size_t WS_END = WS_MIXER_END;
static_assert(WS_HID + 512 * MiB <= WS_MIX, "hidden overlay must not reach MIX/QEXT/KEXT");
constexpr int CW_BAR = 4096, CW_Q = 8192;

constexpr int RING_BYTES = 159744;
constexpr int LDSCTL_OFF = RING_BYTES, MISC_OFF = LDSCTL_OFF + 320;
constexpr int LDS_BYTES = 160256;
static_assert(MISC_OFF + 128 <= LDS_BYTES && att::ATT_LDS_BYTES <= RING_BYTES, "LDS map");

#define GAS __attribute__((address_space(1)))
#define LAS __attribute__((address_space(3)))
typedef unsigned short bf16;
typedef unsigned v4u __attribute__((ext_vector_type(4)));
typedef unsigned v2u __attribute__((ext_vector_type(2)));
typedef float f32x4 __attribute__((ext_vector_type(4)));
typedef float f32x2 __attribute__((ext_vector_type(2)));
typedef float f32x16 __attribute__((ext_vector_type(16)));
typedef short bf16x8 __attribute__((ext_vector_type(8)));
typedef GAS unsigned gu32;
#define RLX_AGENT __ATOMIC_RELAXED, __HIP_MEMORY_SCOPE_AGENT
#define LDS_WAIT() asm volatile("s_waitcnt lgkmcnt(0)" ::: "memory")
#define VM_WAIT() asm volatile("s_waitcnt vmcnt(0)" ::: "memory")
__device__ __forceinline__ unsigned f2bf(float f) { unsigned u = __builtin_bit_cast(unsigned, f); return (u + 0x7fffu + ((u >> 16) & 1u)) >> 16; }
__device__ __forceinline__ unsigned pk2(float lo, float hi) { return f2bf(lo) | (f2bf(hi) << 16); }
__device__ __forceinline__ float bf2f(unsigned short b) { return __builtin_bit_cast(float, ((unsigned)b) << 16); }
__device__ __forceinline__ float bflo(unsigned w) { return __builtin_bit_cast(float, w << 16); }
__device__ __forceinline__ float bfhi(unsigned w) { return __builtin_bit_cast(float, w & 0xffff0000u); }

#define XB_TMO      128
#define XB_XCNT(j)  (256  + 64 * (j))
#define XB_XSUB(j)  (1280 + 64 * (j))
#define XB_XGEN(j)  (2304 + 64 * (j))
#define XB_TOP      3328
#define XB_TOPGEN   3392
#define XCD_BAR_WORDS 3456
#define XB_SPIN_CAP (1u << 22)
__device__ __forceinline__ unsigned xb_ld(unsigned* p)              { return __hip_atomic_load(p, __ATOMIC_RELAXED, __HIP_MEMORY_SCOPE_AGENT); }
__device__ __forceinline__ unsigned xb_add(unsigned* p, unsigned v) { return __hip_atomic_fetch_add(p, v, __ATOMIC_RELAXED, __HIP_MEMORY_SCOPE_AGENT); }
__device__ __forceinline__ unsigned xb_xcc_id() { return (unsigned)__builtin_amdgcn_s_getreg((3 << 11) | 20) & 0xFu; }
#define XB_SPIN(cond, bar) do { unsigned _sp = 0; while (cond) { __builtin_amdgcn_s_sleep(1); \
    if ((++_sp & 255u) == 0u) { if (xb_ld(&(bar)[XB_TMO])) break; if (_sp > XB_SPIN_CAP) { atomicAdd(&(bar)[XB_TMO], 1u); break; } } } } while (0)
struct XcdBarrier { unsigned* bar; unsigned x; volatile LAS unsigned* st; };
__device__ __forceinline__ XcdBarrier xcd_barrier_post(unsigned* bar, volatile LAS unsigned* st) {
    XcdBarrier b; b.bar = bar; b.x = xb_xcc_id(); b.st = st;
    if (threadIdx.x == 0) (void)xb_add(&bar[XB_XCNT(b.x)], 1u);
    return b;
}
__device__ __forceinline__ void xcd_barrier_complete(unsigned* bar, unsigned x, unsigned& nloc, unsigned& nx) {
    const unsigned G = gridDim.x * gridDim.y * gridDim.z;
    unsigned sum, cnt, mine, sp = 0u;
    for (;;) {
        sum = 0u; cnt = 0u; mine = 0u;
#pragma unroll
        for (unsigned j = 0; j < 16; ++j) { const unsigned c = xb_ld(&bar[XB_XCNT(j)]); sum += c; cnt += (c > 0u) ? 1u : 0u; mine = (j == x) ? c : mine; }
        if (sum == G) break;
        __builtin_amdgcn_s_sleep(1);
        if ((++sp & 255u) == 0u) { if (xb_ld(&bar[XB_TMO])) break; if (sp > XB_SPIN_CAP) { atomicAdd(&bar[XB_TMO], 1u); break; } }
    }
    nloc = mine > 0u ? mine : 1u; nx = cnt > 0u ? cnt : 1u;
}
__device__ __forceinline__ void xcd_barrier(const XcdBarrier& b, bool leader  ) {
    asm volatile("s_waitcnt vmcnt(0)" ::: "memory");
    __syncthreads();
    if (leader) {
        unsigned* bar = b.bar; unsigned bx_ = b.x; asm volatile("" : "+s"(bar), "+s"(bx_));
        __builtin_amdgcn_s_waitcnt(0);
        unsigned nloc = b.st[0], nx = b.st[1];
        if (nloc == 0u) { xcd_barrier_complete(bar, bx_, nloc, nx); b.st[0] = nloc; b.st[1] = nx; }
        const unsigned old = xb_add(&bar[XB_XSUB(bx_)], 1u);
        const unsigned gen = old / nloc;
        if (old + 1u == (gen + 1u) * nloc) {
            __builtin_amdgcn_fence(__ATOMIC_RELEASE, "agent");
            asm volatile("s_waitcnt vmcnt(0)" ::: "memory");
            const unsigned og = xb_add(&bar[XB_TOP], 1u);
            const unsigned tg = og / nx;
            if (og + 1u == (tg + 1u) * nx) xb_add(&bar[XB_TOPGEN], 1u);
            else XB_SPIN(xb_ld(&bar[XB_TOPGEN]) == tg, bar);
            __builtin_amdgcn_fence(__ATOMIC_ACQUIRE, "agent");
            xb_add(&bar[XB_XGEN(bx_)], 1u);
            asm volatile("s_waitcnt vmcnt(0)" ::: "memory");
        } else {
            XB_SPIN(xb_ld(&bar[XB_XGEN(bx_)]) == gen, bar);
            __builtin_amdgcn_fence(__ATOMIC_ACQUIRE, "agent");
            asm volatile("s_waitcnt vmcnt(0)" ::: "memory");
        }
    }
    __syncthreads();
}

struct Frame {
    LAS unsigned char* lds; char* ldsg;
    volatile LAS unsigned* MISC;
    int tid, lane, wave;
    int vcu, G, bx;
};
__device__ __forceinline__ int fresh_tid(int wave) { int ln_; asm volatile("v_mbcnt_lo_u32_b32 %0, -1, 0\n\tv_mbcnt_hi_u32_b32 %0, -1, %0" : "=v"(ln_)); return wave * 64 + ln_; }
__device__ __forceinline__ float wave_sum(float v) {
#pragma unroll
    for (int o = 1; o < 64; o <<= 1) v += __shfl_xor(v, o);
    return v;
}

template <int MAP> __device__ __forceinline__ int old_col(int n) {
    if (MAP == 0) return n;
    if (MAP == 1) { if (n < 3584) return n; if (n < 6656) return n + 512; if (n < 8000) return n + 520; if (n < 8008) return n - 8000 + 7168; if (n < 8192) return -1; return n - 4608; }
    if (n < 2048) return (n >> 7) * 192 + (n & 127);
    { const int e = n - 2048, h = e >> 6, w = e & 63, i = w >> 1, p = w & 1; return h * 192 + 128 + i + 32 * p; }
}
template <int MAP> __device__ __forceinline__ f32x4 load4_cols(const float* rowp, int n) {
    if (MAP == 0) return __builtin_nontemporal_load((const GAS f32x4*)(rowp + n));
    if (MAP == 1) { const int oc = old_col<1>(n); if (oc >= 0) return __builtin_nontemporal_load((const GAS f32x4*)(rowp + oc)); return (f32x4){0.f, 0.f, 0.f, 0.f}; }
    if (n < 2048) return __builtin_nontemporal_load((const GAS f32x4*)(rowp + (n >> 7) * 192 + (n & 127)));
    { const int e = n - 2048, h = e >> 6, i = (e & 63) >> 1; const float* p = rowp + h * 192 + 128 + i;
      const f32x2 a = *(const GAS f32x2*)p, b = *(const GAS f32x2*)(p + 32); return (f32x4){a.x, b.x, a.y, b.y}; }
}
struct CvPend { bf16* wt; int K, sk; };
template <int CV_SK>
__device__ __forceinline__ void cv_flush_sk(LAS unsigned char* T, int tid, bf16* wt, int K) {
    constexpr int SN = 8 / CV_SK, PITCH = 128 * CV_SK + 16, ROWS = 64 * SN, PPR = 8 * CV_SK  ;
    v4u o[(ROWS * PPR) / 512];
#pragma unroll
    for (int j = 0; j < (ROWS * PPR) / 512; ++j) { const int p = j * 512 + tid, row = p / PPR, pc = p % PPR; o[j] = *(const LAS v4u*)(T + row * PITCH + pc * 16); }
#pragma unroll
    for (int j = 0; j < (ROWS * PPR) / 512; ++j) { const int p = j * 512 + tid, row = p / PPR, pc = p % PPR; __builtin_nontemporal_store(o[j], (GAS v4u*)(wt + (size_t)row * K + pc * 8)); }
}
__device__ __forceinline__ void cv_flush(LAS unsigned char* T, int tid, CvPend& pend) {
    if (pend.sk == 8) cv_flush_sk<8>(T, tid, pend.wt, pend.K); else if (pend.sk == 4) cv_flush_sk<4>(T, tid, pend.wt, pend.K);
    pend.sk = 0;
    LDS_WAIT(); __syncthreads();
}
template <int MAP, int CV_SK>
__device__ __forceinline__ void p0_transpose_item(CvPend& pend, LAS unsigned char* T, int tid, const float* W, int K, int N, bf16* WT, int row_off, int nblk, int item, int lane, const float* gk = nullptr  ) {
    constexpr int SN = 8 / CV_SK; const int g_ = item >> 3, sub = item & 7, nbg = nblk / SN, kband = g_ / nbg, nbq = g_ - kband * nbg;
    const int kb = kband * CV_SK + sub / SN, nb = nbq * SN + sub % SN, k0 = 64 * kb, n0 = 64 * nb, c = lane & 7, kq = lane >> 3;
    f32x4 v[2][8];
#pragma unroll
    for (int hh = 0; hh < 2; ++hh)
#pragma unroll
        for (int i = 0; i < 8; ++i) v[hh][i] = load4_cols<MAP>(W + (size_t)(k0 + 8 * kq + i) * N, n0 + 32 * hh + 4 * c);
    cv_flush(T, tid, pend);
    if (gk) { const f32x4 g0 = *(const GAS f32x4*)(gk + k0 + 8 * kq), g1 = *(const GAS f32x4*)(gk + k0 + 8 * kq + 4);
#pragma unroll
        for (int hh = 0; hh < 2; ++hh) { v[hh][0] = v[hh][0] * g0[0]; v[hh][1] = v[hh][1] * g0[1]; v[hh][2] = v[hh][2] * g0[2]; v[hh][3] = v[hh][3] * g0[3];
            v[hh][4] = v[hh][4] * g1[0]; v[hh][5] = v[hh][5] * g1[1]; v[hh][6] = v[hh][6] * g1[2]; v[hh][7] = v[hh][7] * g1[3]; } }
    constexpr int PITCH = 128 * CV_SK + 16;
    { LAS unsigned char* tw = T + ((sub % SN) * 64 + 4 * c) * PITCH + ((sub / SN) * 64 + 8 * kq) * 2;
#pragma unroll
      for (int hh = 0; hh < 2; ++hh)
#pragma unroll
        for (int nn = 0; nn < 4; ++nn) { v4u o; o.x = pk2(v[hh][0][nn], v[hh][1][nn]); o.y = pk2(v[hh][2][nn], v[hh][3][nn]); o.z = pk2(v[hh][4][nn], v[hh][5][nn]); o.w = pk2(v[hh][6][nn], v[hh][7][nn]);
            *(LAS v4u*)(tw + (32 * hh + nn) * PITCH) = o; } }
    LDS_WAIT(); __syncthreads();
    pend.wt = WT + (size_t)(row_off + 64 * SN * nbq) * K + 64 * CV_SK * kband; pend.K = K; pend.sk = CV_SK;
}
__device__ __forceinline__ v4u pack8f(const f32x4& a, const f32x4& b) { v4u w; w.x = pk2(a.x, a.y); w.y = pk2(a.z, a.w); w.z = pk2(b.x, b.y); w.w = pk2(b.z, b.w); return w; }
template <bool FULL>
__device__ __forceinline__ void norm_first(int lane, const float* x, const float* g, bf16* a, float* hss) {
    f32x4 v[8][2]; float ss = 0.f;
#pragma unroll
    for (int j = 0; j < 8; ++j) { v[j][0] = *((const GAS f32x4*)x + 2 * lane + 128 * j); v[j][1] = *((const GAS f32x4*)x + 2 * lane + 128 * j + 1);
        ss += (v[j][0].x * v[j][0].x + v[j][0].y * v[j][0].y) + (v[j][0].z * v[j][0].z + v[j][0].w * v[j][0].w) + (v[j][1].x * v[j][1].x + v[j][1].y * v[j][1].y) + (v[j][1].z * v[j][1].z + v[j][1].w * v[j][1].w); }
    const float rstd = __builtin_amdgcn_rsqf(wave_sum(ss) * (1.f / DM) + EPS);
#pragma unroll
    for (int j = 0; j < 8; ++j) {
        if constexpr (FULL) { const f32x4 g0 = *((const GAS f32x4*)g + 2 * lane + 128 * j), g1 = *((const GAS f32x4*)g + 2 * lane + 128 * j + 1);
            *((GAS v4u*)a + lane + 64 * j) = pack8f(v[j][0] * g0 * rstd, v[j][1] * g1 * rstd); }
        else *((GAS v4u*)a + lane + 64 * j) = pack8f(v[j][0], v[j][1]); }
    if (!FULL && lane == 0) *hss = rstd;
}
__device__ __forceinline__ void norm_first_rows(int lane, int first, int stride, int nrows, const float* x, bf16* a, float* hss) {
    if (first >= nrows) return;
    f32x4 v[8][2];
#pragma unroll
    for (int j = 0; j < 8; ++j) { v[j][0] = *((const GAS f32x4*)(x + (size_t)first * DM) + 2 * lane + 128 * j); v[j][1] = *((const GAS f32x4*)(x + (size_t)first * DM) + 2 * lane + 128 * j + 1); }
    for (int m = first; m < nrows; m += stride) {
        v4u o[8]; float ss = 0.f;
#pragma unroll
        for (int j = 0; j < 8; ++j) {
            ss += (v[j][0].x * v[j][0].x + v[j][0].y * v[j][0].y) + (v[j][0].z * v[j][0].z + v[j][0].w * v[j][0].w) + (v[j][1].x * v[j][1].x + v[j][1].y * v[j][1].y) + (v[j][1].z * v[j][1].z + v[j][1].w * v[j][1].w);
            o[j] = pack8f(v[j][0], v[j][1]); }
        const int mn = m + stride;
        if (mn < nrows) {
#pragma unroll
            for (int j = 0; j < 8; ++j) { v[j][0] = *((const GAS f32x4*)(x + (size_t)mn * DM) + 2 * lane + 128 * j); v[j][1] = *((const GAS f32x4*)(x + (size_t)mn * DM) + 2 * lane + 128 * j + 1); } }
#pragma unroll
        for (int j = 0; j < 8; ++j) *((GAS v4u*)(a + (size_t)m * DM) + lane + 64 * j) = o[j];
        const float rstd = __builtin_amdgcn_rsqf(wave_sum(ss) * (1.f / DM) + EPS); if (lane == 0) hss[m] = rstd;
    }
}
template <bool XIN, bool LAST>
__device__ __forceinline__ void norm_step(int lane, const float* x, bf16* hb, const bf16* y, const float* yss, const float* gpost, float* out, float* hss) {
    const float rstd = __builtin_amdgcn_rsqf(wave_sum(yss[lane]) * (1.f / DM) + EPS);
    float ss = 0.f;
#pragma unroll
    for (int j = 0; j < 8; ++j) {
        const v4u yw = *((const GAS v4u*)y + lane + 64 * j);
        f32x4 h0, h1;
        if constexpr (XIN) { h0 = *((const GAS f32x4*)x + 2 * lane + 128 * j); h1 = *((const GAS f32x4*)x + 2 * lane + 128 * j + 1); }
        else { const v4u hw = *((const GAS v4u*)hb + lane + 64 * j); h0 = (f32x4){bflo(hw.x), bfhi(hw.x), bflo(hw.y), bfhi(hw.y)}; h1 = (f32x4){bflo(hw.z), bfhi(hw.z), bflo(hw.w), bfhi(hw.w)}; }
        const f32x4 p0 = *((const GAS f32x4*)gpost + 2 * lane + 128 * j), p1 = *((const GAS f32x4*)gpost + 2 * lane + 128 * j + 1);
        const f32x4 y0 = {bflo(yw.x), bfhi(yw.x), bflo(yw.y), bfhi(yw.y)}, y1 = {bflo(yw.z), bfhi(yw.z), bflo(yw.w), bfhi(yw.w)};
        h0 = h0 + y0 * rstd * p0; h1 = h1 + y1 * rstd * p1;
        if constexpr (LAST) { *((GAS f32x4*)out + 2 * lane + 128 * j) = h0; *((GAS f32x4*)out + 2 * lane + 128 * j + 1) = h1; }
        else { ss += (h0.x * h0.x + h0.y * h0.y) + (h0.z * h0.z + h0.w * h0.w) + (h1.x * h1.x + h1.y * h1.y) + (h1.z * h1.z + h1.w * h1.w);
            *((GAS v4u*)hb + lane + 64 * j) = pack8f(h0, h1); }
    }
    if constexpr (!LAST) { const float r2 = __builtin_amdgcn_rsqf(wave_sum(ss) * (1.f / DM) + EPS); if (lane == 0) *hss = r2; }
}
template <bool XIN, bool LAST>
__device__ __forceinline__ void norm_rows(int lane, int first, int stride, int nrows, const float* x, bf16* hb, const bf16* y, const float* yss, const float* gpost, float* out, float* hss) {
    if (first >= nrows) return;
    f32x4 g[8][2];
#pragma unroll
    for (int j = 0; j < 8; ++j) { g[j][0] = *((const GAS f32x4*)gpost + 2 * lane + 128 * j); g[j][1] = *((const GAS f32x4*)gpost + 2 * lane + 128 * j + 1); }
    v4u yw[8], hw[8]; f32x4 xv[XIN ? 8 : 1][2]; float ys = yss[(size_t)first * 64 + lane];
#pragma unroll
    for (int j = 0; j < 8; ++j) { yw[j] = *((const GAS v4u*)(y + (size_t)first * DM) + lane + 64 * j);
        if constexpr (XIN) { xv[j][0] = *((const GAS f32x4*)(x + (size_t)first * DM) + 2 * lane + 128 * j); xv[j][1] = *((const GAS f32x4*)(x + (size_t)first * DM) + 2 * lane + 128 * j + 1); }
        else hw[j] = *((const GAS v4u*)(hb + (size_t)first * DM) + lane + 64 * j); }
    for (int m = first; m < nrows; m += stride) {
        const float rstd = __builtin_amdgcn_rsqf(wave_sum(ys) * (1.f / DM) + EPS);
        v4u o[LAST ? 1 : 8]; f32x4 of[LAST ? 8 : 1][2]; float ss = 0.f;
#pragma unroll
        for (int j = 0; j < 8; ++j) {
            f32x4 h0, h1;
            if constexpr (XIN) { h0 = xv[j][0]; h1 = xv[j][1]; }
            else { h0 = (f32x4){bflo(hw[j].x), bfhi(hw[j].x), bflo(hw[j].y), bfhi(hw[j].y)}; h1 = (f32x4){bflo(hw[j].z), bfhi(hw[j].z), bflo(hw[j].w), bfhi(hw[j].w)}; }
            const f32x4 y0 = {bflo(yw[j].x), bfhi(yw[j].x), bflo(yw[j].y), bfhi(yw[j].y)}, y1 = {bflo(yw[j].z), bfhi(yw[j].z), bflo(yw[j].w), bfhi(yw[j].w)};
            h0 = h0 + y0 * rstd * g[j][0]; h1 = h1 + y1 * rstd * g[j][1];
            if constexpr (LAST) { of[j][0] = h0; of[j][1] = h1; }
            else { ss += (h0.x * h0.x + h0.y * h0.y) + (h0.z * h0.z + h0.w * h0.w) + (h1.x * h1.x + h1.y * h1.y) + (h1.z * h1.z + h1.w * h1.w); o[j] = pack8f(h0, h1); } }
        const int mn = m + stride;
        if (mn < nrows) { ys = yss[(size_t)mn * 64 + lane];
#pragma unroll
            for (int j = 0; j < 8; ++j) { yw[j] = *((const GAS v4u*)(y + (size_t)mn * DM) + lane + 64 * j);
                if constexpr (XIN) { xv[j][0] = *((const GAS f32x4*)(x + (size_t)mn * DM) + 2 * lane + 128 * j); xv[j][1] = *((const GAS f32x4*)(x + (size_t)mn * DM) + 2 * lane + 128 * j + 1); }
                else hw[j] = *((const GAS v4u*)(hb + (size_t)mn * DM) + lane + 64 * j); } }
#pragma unroll
        for (int j = 0; j < 8; ++j) {
            if constexpr (LAST) { *((GAS f32x4*)(out + (size_t)m * DM) + 2 * lane + 128 * j) = of[j][0]; *((GAS f32x4*)(out + (size_t)m * DM) + 2 * lane + 128 * j + 1) = of[j][1]; }
            else *((GAS v4u*)(hb + (size_t)m * DM) + lane + 64 * j) = o[j]; }
        if constexpr (!LAST) { const float r2 = __builtin_amdgcn_rsqf(wave_sum(ss) * (1.f / DM) + EPS); if (lane == 0) hss[m] = r2; }
    }
}
struct Args { const float* in[25]; float* out; unsigned char* ws; int ph_lo, ph_hi; };
typedef const __attribute__((address_space(4))) Args CArgs;
struct Ptrs { const CArgs* a; float* out; unsigned char* ws;
    __device__ __forceinline__ const float* inp(int k) const { return a->in[k]; } };
#define WSP(T, off) ((T*)(P.ws + (off)))
#define WLAYER(T, l, off) ((T*)(P.ws + WS_W + (size_t)(l) * W_LAYER + (off)))

constexpr int I_IN = (DM / 64) * (NIN / 64), I_UQ = (768 / 64) * (3072 / 64), I_UKV = (512 / 64) * (4096 / 64), I_O = (DM / 64) * (DM / 64), I_MQ = (DM / 64) * (512 / 64),
              I_MO = (512 / 64) * (DM / 64), I_F1 = (DM / 64) * (DFF / 64), I_F2 = (DFF / 64) * (DM / 64);
constexpr int PER_LAYER = I_IN + I_UQ + I_UKV + I_O + 3 * I_MQ + I_MO + I_F1 + I_F2;
#ifndef CV_SKD
#define CV_SKD 4
#endif
constexpr int CV_A = 0, CV_B = (CV_SKD == 8) ? CVB8 : 5984;
static_assert(CV_B % (CV_SKD * (NIN / 64)) == 0, "slot range = whole k bands");
__device__ __forceinline__ void convert_item(CvPend& pend, LAS unsigned char* T, int tid, const Ptrs& P, int l, int r, int lane) {
    if (r < I_IN) { p0_transpose_item<1, CV_SKD>(pend, T, tid, P.inp(3) + (size_t)l * DM * IN_COLS, DM, IN_COLS, WLAYER(bf16, l, W_IN), 0, NIN / 64, r, lane, P.inp(19) + (size_t)l * DM); return; } r -= I_IN;
    if (r < I_UQ) { p0_transpose_item<2, 4>(pend, T, tid, P.inp(8) + (size_t)l * 768 * 3072, 768, 3072, WLAYER(bf16, l, W_UQ), 0, 3072 / 64, r, lane, P.inp(6) + (size_t)l * 768); return; } r -= I_UQ;
    if (r < I_UKV) { p0_transpose_item<0, CV_SKD>(pend, T, tid, P.inp(9) + (size_t)l * 512 * 4096, 512, 4096, WLAYER(bf16, l, W_UKV), 0, 4096 / 64, r, lane, P.inp(7) + (size_t)l * 512); return; } r -= I_UKV;
    if (r < I_O) { p0_transpose_item<0, CV_SKD>(pend, T, tid, P.inp(11) + (size_t)l * DM * DM, DM, DM, WLAYER(bf16, l, W_O), 0, DM / 64, r, lane); return; } r -= I_O;
    if (r < I_MQ) { p0_transpose_item<0, CV_SKD>(pend, T, tid, P.inp(13) + (size_t)l * DM * 512, DM, 512, WLAYER(bf16, l, W_MQ), 0, 512 / 64, r, lane, P.inp(21) + (size_t)l * DM); return; } r -= I_MQ;
    if (r < I_MQ) { p0_transpose_item<0, CV_SKD>(pend, T, tid, P.inp(14) + (size_t)l * DM * 512, DM, 512, WLAYER(bf16, l, W_MKV), 0, 512 / 64, r, lane); return; } r -= I_MQ;
    if (r < I_MQ) { p0_transpose_item<0, CV_SKD>(pend, T, tid, P.inp(15) + (size_t)l * DM * 512, DM, 512, WLAYER(bf16, l, W_MKV), 512, 512 / 64, r, lane); return; } r -= I_MQ;
    if (r < I_MO) { p0_transpose_item<0, CV_SKD>(pend, T, tid, P.inp(16) + (size_t)l * 512 * DM, 512, DM, WLAYER(bf16, l, W_MO), 0, DM / 64, r, lane); return; } r -= I_MO;
    if (r < I_F1) { p0_transpose_item<0, CV_SKD>(pend, T, tid, P.inp(17) + (size_t)l * DM * DFF, DM, DFF, WLAYER(bf16, l, W_FF1), 0, DFF / 64, r, lane, P.inp(23) + (size_t)l * DM); return; } r -= I_F1;
    p0_transpose_item<0, CV_SKD>(pend, T, tid, P.inp(18) + (size_t)l * DFF * DM, DFF, DM, WLAYER(bf16, l, W_FF2), 0, DM / 64, r, lane);
}
__device__ __forceinline__ void convert_slot(Frame& F, const Ptrs& P, int l, int lo, int hi) {
    CvPend pend; pend.sk = 0; pend.wt = nullptr; pend.K = 0;
    for (int it = lo + (F.bx - 128) * NWAVES + F.wave; it < hi; it += 128 * NWAVES) convert_item(pend, F.lds, F.tid, P, l, it, F.lane);
    cv_flush(F.lds, F.tid, pend);
}

constexpr int PER8 = PER_LAYER / 8, MKV8_LO = (I_IN + I_UQ + I_UKV + I_O + I_MQ) / 8, MKV8_N = (2 * I_MQ) / 8, Q8_LAYER = PER8 - MKV8_N, Q8_TOTAL = (DEPTH - 1) * Q8_LAYER;
constexpr int CW_CVQ = CW_Q + 1024;
__device__ __forceinline__ void steal_tile(Frame& F, const Ptrs& P, int t, CvPend& pend) {
    const int l = 1 + t / Q8_LAYER; int q8 = t - (l - 1) * Q8_LAYER; if (q8 >= MKV8_LO) q8 += MKV8_N;
    convert_item(pend, F.lds, F.tid, P, l, 8 * q8 + F.wave, F.lane);
}
__device__ __forceinline__ void steal_upto(Frame& F, const Ptrs& P, int upto, int maxn) {
    gu32* qctr = (gu32*)(P.ws + WS_CTL) + CW_CVQ; volatile LAS unsigned* sh = F.MISC + 16;
    CvPend pend; pend.sk = 0; pend.wt = nullptr; pend.K = 0;
    for (int i = 0; i < maxn; ++i) {
        if (F.tid == 0) sh[2] = __hip_atomic_fetch_add(qctr, 1u, RLX_AGENT);
        LDS_WAIT(); __syncthreads();
        const int t = (int)sh[2];
        __syncthreads();
        if (t < Q8_TOTAL) steal_tile(F, P, t, pend);
        if (t >= upto) break;
    }
    cv_flush(F.lds, F.tid, pend);
}
__device__ __forceinline__ void xcd_barrier_steal(const XcdBarrier& b, Frame& F, const Ptrs& P) {
    asm volatile("s_waitcnt vmcnt(0)" ::: "memory");
    __syncthreads();
    volatile LAS unsigned* sh = F.MISC + 16;
    const bool leader = F.tid == 0;
    unsigned* bar = b.bar; unsigned bx_ = b.x; asm volatile("" : "+s"(bar), "+s"(bx_));
    if (leader) {
        __builtin_amdgcn_s_waitcnt(0);
        unsigned nloc = b.st[0], nx = b.st[1];
        if (nloc == 0u) { xcd_barrier_complete(bar, bx_, nloc, nx); b.st[0] = nloc; b.st[1] = nx; }
        const unsigned old = xb_add(&bar[XB_XSUB(bx_)], 1u);
        const unsigned gen = old / nloc;
        if (old + 1u == (gen + 1u) * nloc) {
            __builtin_amdgcn_fence(__ATOMIC_RELEASE, "agent");
            asm volatile("s_waitcnt vmcnt(0)" ::: "memory");
            const unsigned og = xb_add(&bar[XB_TOP], 1u);
            const unsigned tg = og / nx;
            if (og + 1u == (tg + 1u) * nx) xb_add(&bar[XB_TOPGEN], 1u);
            else XB_SPIN(xb_ld(&bar[XB_TOPGEN]) == tg, bar);
            __builtin_amdgcn_fence(__ATOMIC_ACQUIRE, "agent");
            xb_add(&bar[XB_XGEN(bx_)], 1u);
            asm volatile("s_waitcnt vmcnt(0)" ::: "memory");
            sh[0] = 0xffffffffu;
        } else sh[0] = gen;
    }
    LDS_WAIT(); __syncthreads();
    const unsigned gen = sh[0];
    if (gen != 0xffffffffu) {
        gu32* qctr = (gu32*)(P.ws + WS_CTL) + CW_CVQ;
        CvPend pend; pend.sk = 0; pend.wt = nullptr; pend.K = 0;
        for (;;) {
            if (leader) { const unsigned rel = (xb_ld(&bar[XB_XGEN(bx_)]) != gen) ? 1u : 0u; sh[1] = rel; sh[2] = rel ? 0u : __hip_atomic_fetch_add(qctr, 1u, RLX_AGENT); }
            LDS_WAIT(); __syncthreads();
            const unsigned rel = sh[1]; const int t = (int)sh[2];
            __syncthreads();
            if (rel) { cv_flush(F.lds, F.tid, pend); break; }
            if (t >= Q8_TOTAL) { cv_flush(F.lds, F.tid, pend); if (leader) XB_SPIN(xb_ld(&bar[XB_XGEN(bx_)]) == gen, bar); break; }
            steal_tile(F, P, t, pend);
        }
        asm volatile("s_waitcnt vmcnt(0)" ::: "memory");
        if (leader) { __builtin_amdgcn_fence(__ATOMIC_ACQUIRE, "agent"); asm volatile("s_waitcnt vmcnt(0)" ::: "memory"); }
    }
    __syncthreads();
}

__device__ __forceinline__ void p0_prologue(Frame& F, const Ptrs& P) {
    const int gw = F.vcu * NWAVES + F.wave, NGW = F.G * NWAVES;
    CvPend pend; pend.sk = 0; pend.wt = nullptr; pend.K = 0;
    for (int it = gw; it < PER_LAYER + (DEPTH - 1) * 8 * MKV8_N; it += NGW) {
        if (it < PER_LAYER) convert_item(pend, F.lds, F.tid, P, 0, it, F.lane);
        else { const int q = it - PER_LAYER, l = 1 + q / (8 * MKV8_N); convert_item(pend, F.lds, F.tid, P, l, 8 * MKV8_LO + (q - (l - 1) * 8 * MKV8_N), F.lane); }
    }
    cv_flush(F.lds, F.tid, pend);
    norm_first_rows(F.lane, gw, NGW, M, P.inp(0), WSP(bf16, WS_HN), WSP(float, WS_HSS));
    for (int m = gw; m < DEPTH * BATCH * MEMT; m += NGW) { const int l = m / (BATCH * MEMT), r = m % (BATCH * MEMT);
        norm_first<true>(F.lane, P.inp(1) + (size_t)r * DM, P.inp(12) + (size_t)l * DM, WSP(bf16, WS_MEMN) + (size_t)m * DM, nullptr); }
    { const int gt = gw * 64 + F.lane, NT = NGW * 64; const int* pos = (const int*)P.inp(2); f32x2* rope = WSP(f32x2, WS_ROPE);
      for (int e = gt; e < M * 32; e += NT) { const int tok = e >> 5, i = e & 31;
          const float inv = exp2f(-(float)i * (13.287712379549449f / 32.0f));
          const float ang = (float)pos[tok] * inv;
          const double k = rint((double)ang * 0.15915494309189535);
          const float red = (float)((double)ang - k * 6.283185307179586);
          f32x2 cs; cs.x = cosf(red); cs.y = sinf(red); rope[e] = cs; } }
    { const int gt = gw * 64 + F.lane; if (gt < 1024) { const float* G = P.inp(4); float g[4], mx = -3.0e38f;
          for (int l = 0; l < 4; ++l) { g[l] = G[l * 1024 + gt]; mx = fmaxf(mx, g[l]); }
          float e[4], s = 0.f; for (int l = 0; l < 4; ++l) { e[l] = expf(g[l] - mx); s += e[l]; }
          float* LB = WSP(float, WS_LB); float cum = 0.f;
          for (int l = 0; l < 4; ++l) { if (l > 0) cum += e[l] / s; LB[l * 1024 + gt] = fminf(fmaxf(cum, 0.f), 1.0f - 1e-6f); } } }
    { const int gt = gw * 64 + F.lane, NT = NGW * 64; GAS v4u* z = (GAS v4u*)WSP(char, WS_QEXT); const v4u zero = {0u, 0u, 0u, 0u};
      for (int e = gt; e < (int)(32 * MiB / 16); e += NT) z[e] = zero; }
}

__device__ __forceinline__ void p2_rows(Frame& F, const Ptrs& P, int l, int blk  ) {
    const int l16 = F.lane & 15, rsub = F.lane >> 4;
    const float* fb = P.inp(5) + l * 8; const f32x2* rope = WSP(f32x2, WS_ROPE);
#pragma unroll
    for (int it = 0; it < 2; ++it) { const int m = blk * 64 + F.wave * 8 + it * 4 + rsub;
        const float* css = WSP(float, WS_CSS) + (size_t)m * 20; const float* px = WSP(float, WS_PROJX) + (size_t)m * 256;
        const float c0 = css[l16], c1 = l16 < 4 ? css[16 + l16] : 0.f;
        const float x1a = px[l16], x2a = px[32 + l16], x1b = px[16 + l16], x2b = px[48 + l16];
        const f32x2 csa = rope[(size_t)m * 32 + l16], csb = rope[(size_t)m * 32 + 16 + l16];
        const float xf = l16 < 8 ? px[64 + l16] + fb[l16] : 0.f;
        float sq = l16 < 12 ? c0 : 0.f, skv = (l16 >= 12 ? c0 : 0.f) + c1;
#pragma unroll
        for (int x = 1; x < 16; x <<= 1) { sq += __shfl_xor(sq, x); skv += __shfl_xor(skv, x); }
        if (l16 == 0) { WSP(float, WS_RQ)[m] = __builtin_amdgcn_rsqf(sq * (1.f / 768.f) + EPS); WSP(float, WS_RKV)[m] = __builtin_amdgcn_rsqf(skv * (1.f / 512.f) + EPS); }
        GAS unsigned* kr = (GAS unsigned*)(WSP(bf16, WS_KROT) + (size_t)m * 64);
        kr[l16] = pk2(x1a * csa.x - x2a * csa.y, x1a * csa.y + x2a * csa.x); kr[16 + l16] = pk2(x1b * csb.x - x2b * csb.y, x1b * csb.y + x2b * csb.x);
        if (l16 < 8) WSP(float, WS_FOXLF)[(size_t)m * 8 + l16] = fminf(xf, 0.f) - __logf(1.0f + __expf(-fabsf(xf)));
    }
}

__device__ __forceinline__ float block_sum512(Frame& F, float v, LAS float* red) {
    v = wave_sum(v); if (F.lane == 0) red[F.wave] = v; LDS_WAIT(); __syncthreads();
    float t = 0.f;
#pragma unroll
    for (int w = 0; w < 8; ++w) t += red[w];
    __syncthreads(); return t;
}
__device__ __forceinline__ void fox_scan(Frame& F, const Ptrs& P, int item) {
    const int bh = item >> 4, seg = item & 15, b = bh >> 3, h = bh & 7, tid = F.tid;
    LAS float* red = (LAS float*)(F.lds); LAS float* wtot = red + 8; LAS float* mx = red + 16;
    const float* lf = WSP(float, WS_FOXLF) + ((size_t)b * SEQ) * 8 + h;
    float part = 0.f;
#pragma unroll
    for (int j = 0; j < 15; ++j) if (j < seg) part += lf[(size_t)(tid + 512 * j) * 8];
    const float prefix = block_sum512(F, part, red);
    const int s = seg * 512 + tid;
    const float own = lf[(size_t)s * 8];
    float incl = own;
#pragma unroll
    for (int o = 1; o < 64; o <<= 1) { const float t = __shfl_up(incl, o); if (F.lane >= o) incl += t; }
    if (F.lane == 63) wtot[F.wave] = incl;
    LDS_WAIT(); __syncthreads();
    float off = prefix;
    for (int w = 0; w < F.wave; ++w) off += wtot[w];
    const float c = (incl + off) * LOG2E;
    { bf16* qe = WSP(bf16, WS_QEXT) + ((size_t)bh * SEQ + s) * 64; bf16* ke = WSP(bf16, WS_KEXT) + ((size_t)bh * SEQ + s) * 64;
      const unsigned one = 0x3f80u;
      const unsigned c1 = f2bf(c); const float r1 = c - bf2f((unsigned short)c1); const unsigned c2 = f2bf(r1); const float r2 = r1 - bf2f((unsigned short)c2); const unsigned c3 = f2bf(r2);
      v4u q; q.x = c1 | (c2 << 16); q.y = c3 | (one << 16); q.z = one | (one << 16); q.w = 0u;
      v4u k; k.x = one | (one << 16); k.y = one | ((c1 ^ 0x8000u) << 16); k.z = (c2 ^ 0x8000u) | ((c3 ^ 0x8000u) << 16); k.w = 0u;
      *(GAS v4u*)qe = q; *(GAS v4u*)ke = k;
      WSP(float, WS_FOXC)[(size_t)bh * SEQ + s] = c; }
    const bf16* fq = WSP(bf16, WS_FOX) + ((size_t)bh * SEQ + (size_t)seg * 512) * 128; const bf16* fk = fq + (size_t)16 * SEQ * 128;
    float qm0 = 0.f, qm1 = 0.f, km = 0.f;
#pragma unroll
    for (int hb = 0; hb < 2; ++hb) { v4u qa[8], ka[8];
#pragma unroll
        for (int i = 0; i < 8; ++i) { const size_t o = (size_t)((hb * 8 + i) * 32 + (tid >> 4)) * 128 + (tid & 15) * 8; qa[i] = *(const GAS v4u*)(fq + o); ka[i] = *(const GAS v4u*)(fk + o); }
#pragma unroll
        for (int i = 0; i < 8; ++i) {
            float sq = (bflo(qa[i].x) * bflo(qa[i].x) + bfhi(qa[i].x) * bfhi(qa[i].x)) + (bflo(qa[i].y) * bflo(qa[i].y) + bfhi(qa[i].y) * bfhi(qa[i].y)) + (bflo(qa[i].z) * bflo(qa[i].z) + bfhi(qa[i].z) * bfhi(qa[i].z)) + (bflo(qa[i].w) * bflo(qa[i].w) + bfhi(qa[i].w) * bfhi(qa[i].w));
            float sk = (bflo(ka[i].x) * bflo(ka[i].x) + bfhi(ka[i].x) * bfhi(ka[i].x)) + (bflo(ka[i].y) * bflo(ka[i].y) + bfhi(ka[i].y) * bfhi(ka[i].y)) + (bflo(ka[i].z) * bflo(ka[i].z) + bfhi(ka[i].z) * bfhi(ka[i].z)) + (bflo(ka[i].w) * bflo(ka[i].w) + bfhi(ka[i].w) * bfhi(ka[i].w));
#pragma unroll
            for (int x = 1; x < 16; x <<= 1) { sq += __shfl_xor(sq, x); sk += __shfl_xor(sk, x); }
            if (hb == 0) qm0 = fmaxf(qm0, sq); else qm1 = fmaxf(qm1, sq);
            km = fmaxf(km, sk); } }
#pragma unroll
    for (int x = 16; x < 64; x <<= 1) { qm0 = fmaxf(qm0, __shfl_xor(qm0, x)); qm1 = fmaxf(qm1, __shfl_xor(qm1, x)); km = fmaxf(km, __shfl_xor(km, x)); }
    if (F.lane == 0) { mx[F.wave * 3] = qm0; mx[F.wave * 3 + 1] = qm1; mx[F.wave * 3 + 2] = km; }
    LDS_WAIT(); __syncthreads();
    if (tid < 3) { float m = 0.f; for (int w = 0; w < 8; ++w) m = fmaxf(m, mx[w * 3 + tid]);
        if (tid < 2) WSP(float, WS_FOXQM)[bh * 32 + seg * 2 + tid] = m; else WSP(float, WS_FOXKM)[bh * 16 + seg] = m; }
    __syncthreads();
}

constexpr int HL_QT = 0, HL_KT = 17408, HL_QH = 34816, HL_VT = 52224, HL_SC = 70656, HL_QTOT = 79872, HL_RS = 81920, HL_KHT = 0  ;
__device__ __forceinline__ float clampe(float x) { return __expf(fminf(x, 80.f)); }
constexpr int H1_QTOT = 40960  ;
struct H1Regs { f32x4 lf[4]; v2u kw[4], vw[4]; };
__device__ __forceinline__ void hgrn_local_load(Frame& F, const Ptrs& P, int ch, H1Regs& R) {
    const int tid = F.tid, tg = tid >> 5, cg = tid & 31;
    const int bh = ch >> 7, n = ch & 127, b = bh >> 3, h = bh & 7;
    const size_t tok0 = (size_t)b * SEQ + (size_t)n * 64; const int cb = h * 128;
    const float* logf = WSP(float, WS_LOGF) + (tok0 + 4 * tg) * 1024 + cb + 4 * cg; const bf16* proj = WSP(bf16, WS_PROJ) + (tok0 + 4 * tg) * 4096 + cb + 4 * cg;
#pragma unroll
    for (int i = 0; i < 4; ++i) { R.lf[i] = *(const GAS f32x4*)(logf + (size_t)i * 1024); R.kw[i] = *(const GAS v2u*)(proj + (size_t)i * 4096 + 1024); R.vw[i] = *(const GAS v2u*)(proj + (size_t)i * 4096 + 2048); }
}
__device__ __forceinline__ void hgrn_local(Frame& F, const Ptrs& P, int ch, H1Regs& R) {
    const int tid = F.tid, tg = tid >> 5, cg = tid & 31;
    LAS float* QTOT = (LAS float*)(F.lds + H1_QTOT);
    f32x4 lf[4]; v2u kw[4], vw[4];
#pragma unroll
    for (int i = 0; i < 4; ++i) { lf[i] = R.lf[i]; kw[i] = R.kw[i]; vw[i] = R.vw[i]; }
    lf[1] = lf[1] + lf[0]; lf[2] = lf[2] + lf[1]; lf[3] = lf[3] + lf[2];
    *(LAS f32x4*)(QTOT + tg * 128 + 4 * cg) = lf[3];
    { v2u t; t.x = (vw[0].x & 0xffffu) | (vw[1].x << 16); t.y = (vw[2].x & 0xffffu) | (vw[3].x << 16); *(LAS v2u*)(F.lds + HL_VT + (4 * cg + 0) * 144 + 8 * tg) = t;
      t.x = (vw[0].x >> 16) | (vw[1].x & 0xffff0000u); t.y = (vw[2].x >> 16) | (vw[3].x & 0xffff0000u); *(LAS v2u*)(F.lds + HL_VT + (4 * cg + 1) * 144 + 8 * tg) = t;
      t.x = (vw[0].y & 0xffffu) | (vw[1].y << 16); t.y = (vw[2].y & 0xffffu) | (vw[3].y << 16); *(LAS v2u*)(F.lds + HL_VT + (4 * cg + 2) * 144 + 8 * tg) = t;
      t.x = (vw[0].y >> 16) | (vw[1].y & 0xffff0000u); t.y = (vw[2].y >> 16) | (vw[3].y & 0xffff0000u); *(LAS v2u*)(F.lds + HL_VT + (4 * cg + 3) * 144 + 8 * tg) = t; }
    LDS_WAIT(); __syncthreads();
    f32x4 off = {0.f, 0.f, 0.f, 0.f}, bend = {0.f, 0.f, 0.f, 0.f};
#pragma unroll
    for (int g = 0; g < 16; ++g) { const f32x4 t = *(const LAS f32x4*)(QTOT + g * 128 + 4 * cg); if (g < tg) off = off + t; bend = bend + t; }
    f32x4 kh[4];
#pragma unroll
    for (int i = 0; i < 4; ++i) { const f32x4 kv = {bflo(kw[i].x), bfhi(kw[i].x), bflo(kw[i].y), bfhi(kw[i].y)};
#pragma unroll
        for (int j = 0; j < 4; ++j) kh[i][j] = kv[j] * __expf(bend[j] - (lf[i][j] + off[j])); }
#pragma unroll
    for (int j = 0; j < 4; ++j) { v2u t; t.x = pk2(kh[0][j], kh[1][j]); t.y = pk2(kh[2][j], kh[3][j]); *(LAS v2u*)(F.lds + HL_KHT + (4 * cg + j) * 144 + 8 * tg) = t; }
    if (tg == 0) { f32x4 a; a[0] = __expf(bend[0]); a[1] = __expf(bend[1]); a[2] = __expf(bend[2]); a[3] = __expf(bend[3]); *(GAS f32x4*)(WSP(float, WS_ADEC) + (size_t)ch * 128 + 4 * cg) = a; }
    LDS_WAIT(); __syncthreads();
    const int w = F.wave, r32 = F.lane & 31, hi = F.lane >> 5, mt = w >> 1;
    bf16* LT = WSP(bf16, WS_LT) + (size_t)ch * 16384;
#pragma unroll
    for (int n2 = 0; n2 < 2; ++n2) { const int nt = (w & 1) * 2 + n2; f32x16 acc = {};
#pragma unroll
        for (int ks = 0; ks < 4; ++ks) {
            const bf16x8 A = *(const LAS bf16x8*)(F.lds + HL_VT + (32 * mt + r32) * 144 + (16 * ks + 8 * hi) * 2);
            const bf16x8 B = *(const LAS bf16x8*)(F.lds + HL_KHT + (32 * nt + r32) * 144 + (16 * ks + 8 * hi) * 2);
            acc = __builtin_amdgcn_mfma_f32_32x32x16_bf16(A, B, acc, 0, 0, 0); }
#pragma unroll
        for (int r = 0; r < 16; ++r) LT[(32 * mt + att::crow(r, hi)) * 128 + 32 * nt + r32] = (bf16)f2bf(acc[r]); }
    __syncthreads();
}
__device__ __forceinline__ void hgrn_scan(Frame& F, const Ptrs& P) {
    const int gt = (F.vcu * NWAVES + F.wave) * 64 + F.lane, NT = F.G * NWAVES * 64;
    for (int e = gt; e < 16 * 128 * 64; e += NT) {
        const int bh = e >> 13, v = (e >> 6) & 127, k = (e & 63) * 2;
        const bf16* LT = WSP(bf16, WS_LT) + (size_t)bh * 128 * 16384 + v * 128 + k;
        const float* ad = WSP(float, WS_ADEC) + (size_t)bh * 128 * 128 + k;
        bf16* ST = WSP(bf16, WS_ST) + (size_t)bh * 128 * 16384 + v * 128 + k;
        float s0 = 0.f, s1 = 0.f;
        unsigned lt[16]; f32x2 a[16];
#pragma unroll
        for (int i = 0; i < 16; ++i) { lt[i] = *(const GAS unsigned*)(LT + (size_t)i * 16384); a[i] = *(const GAS f32x2*)(ad + i * 128); }
        for (int nb = 0; nb < 128; nb += 16) {
            unsigned o[16];
#pragma unroll
            for (int i = 0; i < 16; ++i) { o[i] = pk2(s0, s1); s0 = a[i].x * s0 + bflo(lt[i]); s1 = a[i].y * s1 + bfhi(lt[i]); }
            if (nb + 16 < 128) {
#pragma unroll
                for (int i = 0; i < 16; ++i) { lt[i] = *(const GAS unsigned*)(LT + (size_t)(nb + 16 + i) * 16384); a[i] = *(const GAS f32x2*)(ad + (nb + 16 + i) * 128); } }
#pragma unroll
            for (int i = 0; i < 16; ++i) *(GAS unsigned*)(ST + (size_t)(nb + i) * 16384) = o[i];
        }
    }
}
constexpr int HO_QTOT = 79872  , HO_RS = 88064  , HO_GT = 89088  ;
__device__ __forceinline__ void hgrn_out(Frame& F, const Ptrs& P, int ch, int l) {
    const int tid = F.tid, tg = tid >> 5, cg = tid & 31;
    const int bh = ch >> 7, n = ch & 127, b = bh >> 3, h = bh & 7;
    const size_t tok0 = (size_t)b * SEQ + (size_t)n * 64; const int cb = h * 128;
    const float* logf = WSP(float, WS_LOGF) + (tok0 + 4 * tg) * 1024 + cb + 4 * cg; const bf16* proj = WSP(bf16, WS_PROJ) + (tok0 + 4 * tg) * 4096 + cb + 4 * cg;
    LAS float* QTOT = (LAS float*)(F.lds + HO_QTOT); LAS float* RS = (LAS float*)(F.lds + HO_RS);
    const int w = F.wave, r32 = F.lane & 31, hi = F.lane >> 5, mt = w >> 2, nt = w & 3;
    f32x4 lf[4]; v2u qw[4], kw[4], vw[4], gw[4]; bf16x8 stf[8];
#pragma unroll
    for (int i = 0; i < 4; ++i) { lf[i] = *(const GAS f32x4*)(logf + (size_t)i * 1024); qw[i] = *(const GAS v2u*)(proj + (size_t)i * 4096); kw[i] = *(const GAS v2u*)(proj + (size_t)i * 4096 + 1024);
        vw[i] = *(const GAS v2u*)(proj + (size_t)i * 4096 + 2048); }
#pragma unroll
    for (int i = 0; i < 4; ++i) gw[i] = *(const GAS v2u*)(proj + (size_t)i * 4096 + 3072);
    { const bf16* ST = WSP(bf16, WS_ST) + (size_t)ch * 16384 + (32 * nt + r32) * 128 + 8 * hi;
#pragma unroll
      for (int ks = 0; ks < 8; ++ks) stf[ks] = *(const GAS bf16x8*)(ST + 16 * ks); }
    lf[1] = lf[1] + lf[0]; lf[2] = lf[2] + lf[1]; lf[3] = lf[3] + lf[2];
    *(LAS f32x4*)(QTOT + tg * 128 + 4 * cg) = lf[3];
#pragma unroll
    for (int i = 0; i < 4; ++i) *(LAS v2u*)(F.lds + HO_GT + (4 * tg + i) * 272 + 8 * cg) = gw[i];
    { v2u t; t.x = (vw[0].x & 0xffffu) | (vw[1].x << 16); t.y = (vw[2].x & 0xffffu) | (vw[3].x << 16); *(LAS v2u*)(F.lds + HL_VT + (4 * cg + 0) * 144 + 8 * tg) = t;
      t.x = (vw[0].x >> 16) | (vw[1].x & 0xffff0000u); t.y = (vw[2].x >> 16) | (vw[3].x & 0xffff0000u); *(LAS v2u*)(F.lds + HL_VT + (4 * cg + 1) * 144 + 8 * tg) = t;
      t.x = (vw[0].y & 0xffffu) | (vw[1].y << 16); t.y = (vw[2].y & 0xffffu) | (vw[3].y << 16); *(LAS v2u*)(F.lds + HL_VT + (4 * cg + 2) * 144 + 8 * tg) = t;
      t.x = (vw[0].y >> 16) | (vw[1].y & 0xffff0000u); t.y = (vw[2].y >> 16) | (vw[3].y & 0xffff0000u); *(LAS v2u*)(F.lds + HL_VT + (4 * cg + 3) * 144 + 8 * tg) = t; }
    LDS_WAIT(); __syncthreads();
    f32x4 off = {0.f, 0.f, 0.f, 0.f}, rref = {0.f, 0.f, 0.f, 0.f};
#pragma unroll
    for (int g = 0; g < 16; ++g) { const f32x4 t = *(const LAS f32x4*)(QTOT + g * 128 + 4 * cg); if (g < tg) off = off + t; if (g < 8) rref = rref + t; }
#pragma unroll
    for (int i = 0; i < 4; ++i) { const f32x4 bb = lf[i] + off;
        const f32x4 qv = {bflo(qw[i].x), bfhi(qw[i].x), bflo(qw[i].y), bfhi(qw[i].y)}, kv = {bflo(kw[i].x), bfhi(kw[i].x), bflo(kw[i].y), bfhi(kw[i].y)};
        f32x4 qt, kt, qh;
#pragma unroll
        for (int j = 0; j < 4; ++j) { qt[j] = qv[j] * clampe(bb[j] - rref[j]); kt[j] = kv[j] * clampe(rref[j] - bb[j]); qh[j] = qv[j] * __expf(bb[j]); }
        v2u a; a.x = pk2(qt[0], qt[1]); a.y = pk2(qt[2], qt[3]); *(LAS v2u*)(F.lds + HL_QT + (4 * tg + i) * 272 + 8 * cg) = a;
        a.x = pk2(kt[0], kt[1]); a.y = pk2(kt[2], kt[3]); *(LAS v2u*)(F.lds + HL_KT + (4 * tg + i) * 272 + 8 * cg) = a;
        a.x = pk2(qh[0], qh[1]); a.y = pk2(qh[2], qh[3]); *(LAS v2u*)(F.lds + HL_QH + (4 * tg + i) * 272 + 8 * cg) = a; }
    LDS_WAIT(); __syncthreads();
    if (w < 4) { const int mt2 = w >> 1, nt2 = w & 1; f32x16 acc = {};
#pragma unroll
        for (int ks = 0; ks < 8; ++ks) {
            const bf16x8 A = *(const LAS bf16x8*)(F.lds + HL_QT + (32 * mt2 + r32) * 272 + (16 * ks + 8 * hi) * 2);
            const bf16x8 B = *(const LAS bf16x8*)(F.lds + HL_KT + (32 * nt2 + r32) * 272 + (16 * ks + 8 * hi) * 2);
            acc = __builtin_amdgcn_mfma_f32_32x32x16_bf16(A, B, acc, 0, 0, 0); }
#pragma unroll
        for (int r = 0; r < 16; ++r) { const int t = 32 * mt2 + att::crow(r, hi), s = 32 * nt2 + r32;
            *(LAS unsigned short*)(F.lds + HL_SC + t * 144 + s * 2) = (unsigned short)f2bf(s <= t ? acc[r] : 0.f); } }
    LDS_WAIT(); __syncthreads();
    f32x16 acc = {};
#pragma unroll
    for (int ks = 0; ks < 4; ++ks) {
        const bf16x8 A = *(const LAS bf16x8*)(F.lds + HL_SC + (32 * mt + r32) * 144 + (16 * ks + 8 * hi) * 2);
        const bf16x8 B = *(const LAS bf16x8*)(F.lds + HL_VT + (32 * nt + r32) * 144 + (16 * ks + 8 * hi) * 2);
        acc = __builtin_amdgcn_mfma_f32_32x32x16_bf16(A, B, acc, 0, 0, 0); }
#pragma unroll
    for (int ks = 0; ks < 8; ++ks) {
        const bf16x8 A = *(const LAS bf16x8*)(F.lds + HL_QH + (32 * mt + r32) * 272 + (16 * ks + 8 * hi) * 2);
        acc = __builtin_amdgcn_mfma_f32_32x32x16_bf16(A, stf[ks], acc, 0, 0, 0); }
#pragma unroll
    for (int r = 0; r < 16; ++r) { float ss = acc[r] * acc[r];
        ss += __shfl_xor(ss, 1); ss += __shfl_xor(ss, 2); ss += __shfl_xor(ss, 4); ss += __shfl_xor(ss, 8); ss += __shfl_xor(ss, 16);
        if (r32 == 0) RS[nt * 64 + 32 * mt + att::crow(r, hi)] = ss; }
    LDS_WAIT(); __syncthreads();
    const int vl = 32 * nt + r32; const float ga = P.inp(10)[(size_t)l * 4096 + cb + vl];
    bf16* mix = WSP(bf16, WS_MIX);
#pragma unroll
    for (int r = 0; r < 16; ++r) { const int t = 32 * mt + att::crow(r, hi);
        const float tot = (RS[t] + RS[64 + t]) + (RS[128 + t] + RS[192 + t]);
        const float rstd = __builtin_amdgcn_rsqf(tot * (1.f / 128.f) + EPS);
        const float g = bf2f(*(const LAS unsigned short*)(F.lds + HO_GT + t * 272 + vl * 2));
        const float o = acc[r] * rstd * ga * (g * __builtin_amdgcn_rcpf(1.0f + __expf(-g)));
        const float on = __shfl_xor(o, 1);
        if ((r32 & 1) == 0) *(GAS unsigned*)(mix + (tok0 + t) * 4096 + cb + vl) = pk2(o, on); }
    __syncthreads();
}
constexpr int ATT_ITEMS = 768;
__device__ __forceinline__ att::BlockRef mix_block(const Ptrs& P, int l, int j, int pass) {
    att::BlockRef r;
    const int x = j & 15, qb = pass ? 31 - x : x;
    if (j < 512) { const int bh = j >> 4, b = bh >> 4, h = bh & 15; const size_t q0 = (size_t)bh * SEQ + (size_t)qb * 256;
        r.Q = WSP(bf16, WS_QN) + q0 * 128; r.QX = WSP(bf16, WS_QR) + q0 * 64;
        r.K = WSP(bf16, WS_KN) + (size_t)bh * SEQ * 128; r.V = WSP(bf16, WS_VC) + (size_t)bh * SEQ * 128; r.KX = WSP(bf16, WS_KROT) + (size_t)b * SEQ * 64;
        r.O = WSP(bf16, WS_MIX) + ((size_t)b * SEQ + (size_t)qb * 256) * 4096 + 2048 + h * 128; r.G = P.inp(10) + (size_t)l * 4096 + 2048 + h * 128; }
    else { const int bh = (j - 512) >> 4, b = bh >> 3, h = bh & 7; const size_t q0 = (size_t)bh * SEQ + (size_t)qb * 256;
        r.Q = WSP(bf16, WS_FOX) + q0 * 128; r.QX = WSP(bf16, WS_QEXT) + q0 * 64;
        r.K = WSP(bf16, WS_FOX) + ((size_t)(16 + bh) * SEQ) * 128; r.V = WSP(bf16, WS_FOX) + ((size_t)(32 + bh) * SEQ) * 128; r.KX = WSP(bf16, WS_KEXT) + (size_t)bh * SEQ * 64;
        r.O = WSP(bf16, WS_MIX) + ((size_t)b * SEQ + (size_t)qb * 256) * 4096 + 1024 + h * 128; r.G = P.inp(10) + (size_t)l * 4096 + 1024 + h * 128; }
    r.P0 = qb * 256; r.jlo = 0;
    if (j >= 512) {
        const int bh = (j - 512) >> 4; const float* C = WSP(float, WS_FOXC) + (size_t)bh * SEQ;
        float km = 0.f;
        for (int sgi = 0; sgi < 16; ++sgi) km = fmaxf(km, WSP(float, WS_FOXKM)[bh * 16 + sgi]);
        const float bound = 2.0f * sqrtf(WSP(float, WS_FOXQM)[bh * 32 + qb] * km) * 1.01f + 100.0f;
        const float ct0 = C[qb * 256];
        const int nt = qb * 4;
        int lane_; asm volatile("v_mbcnt_lo_u32_b32 %0, -1, 0\n\tv_mbcnt_hi_u32_b32 %0, -1, %0" : "=v"(lane_));
        bool keep0 = true, keep1 = true;
        if (lane_ < nt) keep0 = (ct0 - C[64 * lane_ + 63]) >= -bound;
        if (lane_ + 64 < nt) keep1 = (ct0 - C[64 * (lane_ + 64) + 63]) >= -bound;
        const unsigned long long m0 = __ballot(keep0), m1 = __ballot(keep1);
        int jl = m0 ? __builtin_ctzll(m0) : (m1 ? 64 + __builtin_ctzll(m1) : nt);
        r.jlo = __builtin_amdgcn_readfirstlane(jl < nt ? jl : nt);
    }
    return r;
}
__device__ __forceinline__ void mix_attention(Frame& F, const Ptrs& P, int l) {
    const int nit = (ATT_ITEMS - F.vcu + F.G - 1) / F.G;
    if (nit <= 0) return;
    const int nblk = 2 * nit;
    att::Seam<true> S;
    att::BlockRef cur = mix_block(P, l, F.vcu, 0);
    att::attn_prime<true>(cur, 1 << 30, F.ldsg, S, fresh_tid(F.wave));
    for (int k = 0; k < nblk; ++k) {
        const int kn = (k + 1 < nblk) ? k + 1 : k;
        const att::BlockRef nxt = mix_block(P, l, F.vcu + (kn >> 1) * F.G, kn & 1);
        att::attn_block<true, true, 4096>(cur, nxt, SEQ, 1 << 30, F.ldsg, S, fresh_tid(F.wave));
        cur = nxt;
    }
}
__device__ __forceinline__ att::BlockRef mem_block(const Ptrs& P, int l, int j) {
    att::BlockRef r; const int bh = j >> 5, qb = j & 31, b = bh >> 2, h = bh & 3;
    r.Q = WSP(bf16, WS_QMEM) + ((size_t)bh * SEQ + (size_t)qb * 256) * 128; r.QX = r.Q;
    r.K = WSP(bf16, WS_KVMEM) + ((size_t)l * 2 * 8 + bh) * 256 * 128; r.V = r.K + (size_t)8 * 256 * 128; r.KX = r.K;
    r.O = WSP(bf16, WS_OMEM) + ((size_t)b * SEQ + (size_t)qb * 256) * 512 + h * 128; r.G = nullptr; r.P0 = MEMT; r.jlo = 0;
    return r;
}
__device__ __forceinline__ void mem_attention(Frame& F, const Ptrs& P, int l) {
    const int nblk = (256 - F.vcu + F.G - 1) / F.G;
    if (nblk <= 0) return;
    att::Seam<false> S;
    att::BlockRef cur = mem_block(P, l, F.vcu);
    att::attn_prime<false>(cur, 1 << 30, F.ldsg, S, fresh_tid(F.wave));
    for (int k = 0; k < nblk; ++k) {
        const int kn = (k + 1 < nblk) ? k + 1 : k;
        const att::BlockRef nxt = mem_block(P, l, F.vcu + kn * F.G);
        att::attn_block<false, false, 512>(cur, nxt, MEMT, 1 << 30, F.ldsg, S, fresh_tid(F.wave));
        cur = nxt;
    }
}

constexpr int NPH = 13;
constexpr int NPHASES = 1 + DEPTH * NPH;
__global__ void __launch_bounds__(NWAVES * 64, 2) trunk_fwd(Args args) {
    extern __shared__ __attribute__((aligned(16))) unsigned char lds[];
    const int wave_s = __builtin_amdgcn_readfirstlane(threadIdx.x >> 6);
    for (int u = threadIdx.x; u < (LDS_BYTES - LDSCTL_OFF) / 4; u += NWAVES * 64) ((LAS unsigned*)((LAS unsigned char*)lds + LDSCTL_OFF))[u] = 0u;
    __syncthreads();
    XcdBarrier bar = xcd_barrier_post((unsigned*)(args.ws + WS_CTL) + CW_BAR, (volatile LAS unsigned*)((LAS unsigned char*)lds + MISC_OFF) + 8);
#define PH_BEGIN() Frame F; { int ln_; asm volatile("v_mbcnt_lo_u32_b32 %0, -1, 0\n\tv_mbcnt_hi_u32_b32 %0, -1, %0" : "=v"(ln_)); F.tid = wave_s * 64 + ln_; } F.lds = (LAS unsigned char*)lds; F.ldsg = (char*)lds; F.MISC = (volatile LAS unsigned*)(F.lds + MISC_OFF); F.lane = F.tid & 63; F.wave = __builtin_amdgcn_readfirstlane(F.tid >> 6); \
    F.G = gridDim.x; { int bx = blockIdx.x; asm volatile("" : "+s"(bx)); F.vcu = (F.G % 8 == 0) ? (bx % 8) * (F.G / 8) + bx / 8 : bx; F.bx = bx; } \
    const CArgs* ap_ = (const CArgs*)__builtin_amdgcn_kernarg_segment_ptr(); asm volatile("" : "+s"(ap_)); const Ptrs P{ap_, ap_->out, ap_->ws}; LAS unsigned char* ring = F.lds;
    const int lo = args.ph_lo, hi = args.ph_hi;
#ifndef PH_MASK
#define PH_MASK 0xFFFFFFFFu
#endif
#define RUN(g) (lo <= (g) && (g) < hi)
#define EN(p) ((PH_MASK >> (p)) & 1u)
#ifndef DBL_MASK
#define DBL_MASK 0u
#endif
#define REPS(p) (((DBL_MASK >> (p)) & 1u) ? 2 : 1)
#ifdef PROBE_ID
    unsigned long long pr_acc = 0ull, pr_t0 = 0ull;
#define PR_BEGIN(id) do { if ((id) == PROBE_ID) pr_t0 = __builtin_amdgcn_s_memrealtime(); } while (0)
#define PR_END(id) do { if ((id) == PROBE_ID) pr_acc += __builtin_amdgcn_s_memrealtime() - pr_t0; } while (0)
#else
#define PR_BEGIN(id) do {} while (0)
#define PR_END(id) do {} while (0)
#endif
#define PHASE_END(g) do { if ((g) + 1 < hi) { PH_BEGIN(); xcd_barrier_steal(bar, F, P); } } while (0)

    if (EN(0) && RUN(0)) { PR_BEGIN(0); for (int rep_ = 0; rep_ < REPS(0); ++rep_) { PH_BEGIN(); p0_prologue(F, P); __syncthreads(); } PHASE_END(0); PR_END(0); }

    const int F0G = gridDim.x;
    for (int l = 0; l < DEPTH; ++l) {
        const int g0 = 1 + l * NPH;
        static_assert(pg8::WGM == 8 && pg8::NXCD == 8 && NIN == 8704 && M == 16384, "the cut after 8 rounds relies on StaticOrder dealing column tiles 32, 33 (all 64 row panels) in round 8 of a 256-workgroup grid");
        const int nfull = (F0G == 256) ? (64 * (NIN / 256)) / 256 : (1 << 20);
        if (EN(1) && RUN(g0 + 0)) { PR_BEGIN(1); for (int rep_ = 0; rep_ < REPS(1); ++rep_) { PH_BEGIN();
            { pg8::Gemm g{WSP(bf16, WS_HN), WLAYER(bf16, l, W_IN), M, NIN, DM}; pg8::RoundOrder S; S.s.init(M, NIN, F.G, F.bx); S.lo = 0; S.hi = nfull;
              pg8::EpiProj E{WSP(bf16, WS_PROJ), WSP(bf16, WS_FOX), WSP(float, WS_LOGF), WSP(float, WS_PROJX), WSP(bf16, WS_CQN), WSP(bf16, WS_CKVN), WSP(float, WS_CSS), WSP(float, WS_LB) + l * 1024, QSCALE_128, WSP(float, WS_HSS)};
              pg8::gemm_phase<pg8::EpiProj, pg8::RoundOrder, true, true>(ring, g, S, E, F.tid); }
            __syncthreads(); }
            PHASE_END(g0 + 0); PR_END(1);
        }
        if (EN(2) && RUN(g0 + 1)) { PR_BEGIN(2); for (int rep_ = 0; rep_ < REPS(2); ++rep_) { PH_BEGIN();
            PR_BEGIN(22); { pg8::Gemm g{WSP(bf16, WS_HN), WLAYER(bf16, l, W_IN), M, NIN, DM}; pg8::RoundOrder S; S.s.init(M, NIN, F.G, F.bx); S.lo = nfull; S.hi = 1 << 30;
              pg8::EpiProj E{WSP(bf16, WS_PROJ), WSP(bf16, WS_FOX), WSP(float, WS_LOGF), WSP(float, WS_PROJX), WSP(bf16, WS_CQN), WSP(bf16, WS_CKVN), WSP(float, WS_CSS), WSP(float, WS_LB) + l * 1024, QSCALE_128, WSP(float, WS_HSS)};
              pg8::gemm_phase<pg8::EpiProj, pg8::RoundOrder, true, true>(ring, g, S, E, F.tid); } PR_END(22);
            if (l == 0) {
                for (int ll = 0; ll < DEPTH; ++ll) {
                    pg8::Gemm g{WSP(bf16, WS_MEMN) + (size_t)ll * 512 * DM, WLAYER(bf16, ll, W_MKV), BATCH * MEMT, 1024, DM}; pg8::StaticOrder S;
                    S.init(BATCH * MEMT, 1024, F.G, (int)((F.bx + F.G - (F.G / 2 + 8 * ll) % F.G) % F.G));
                    pg8::EpiKVmem E{WSP(bf16, WS_KVMEM) + (size_t)ll * 2 * 8 * 256 * 128, WSP(bf16, WS_KVMEM) + ((size_t)ll * 2 + 1) * 8 * 256 * 128};
                    pg8::gemm_phase<pg8::EpiKVmem, pg8::StaticOrder, true, true>(ring, g, S, E, F.tid); }
            }
            __syncthreads();
            PR_BEGIN(23); { gu32* qctr = (gu32*)(P.ws + WS_CTL) + CW_Q + (l * 2 + rep_) * 64; volatile LAS unsigned* slot = F.MISC + 4;
              for (;;) {
                  if (F.tid == 0) *slot = __hip_atomic_fetch_add(qctr, 4u, RLX_AGENT);
                  LDS_WAIT(); __syncthreads();
                  const int it0 = (int)*slot;
                  __syncthreads();
                  if (it0 >= 256 + 2048) break;
                  if (it0 < 256) { for (int it = it0; it < it0 + 4; ++it) p2_rows(F, P, l, it); }
                  else { const int c0_ = it0 - 256; H1Regs R0, R1;
                      hgrn_local_load(F, P, c0_, R0); hgrn_local_load(F, P, c0_ + 1, R1); hgrn_local(F, P, c0_, R0);
                      hgrn_local_load(F, P, c0_ + 2, R0); hgrn_local(F, P, c0_ + 1, R1);
                      hgrn_local_load(F, P, c0_ + 3, R1); hgrn_local(F, P, c0_ + 2, R0); hgrn_local(F, P, c0_ + 3, R1); }
              } } PR_END(23);
            __syncthreads(); }
            PHASE_END(g0 + 1); PR_END(2);
        }
        if (EN(3) && RUN(g0 + 2)) { PR_BEGIN(3); for (int rep_ = 0; rep_ < REPS(3); ++rep_) { PH_BEGIN();
#ifndef NO_SCANS
            PR_BEGIN(30); PR_BEGIN(33); for (int it = F.vcu; it < 256; it += F.G) fox_scan(F, P, it); PR_END(33);
            PR_BEGIN(34); hgrn_scan(F, P); PR_END(34);
            __syncthreads(); PR_END(30);
#endif
#ifndef NO_QFULL
            PR_BEGIN(31); { pg8::Gemm g{WSP(bf16, WS_CQN), WLAYER(bf16, l, W_UQ), M, 3072, 768}; pg8::StaticOrder S; S.init(M, 3072, F.G, F.bx);
              pg8::EpiQfull E{WSP(bf16, WS_QN), WSP(bf16, WS_QR), WSP(float, WS_ROPE), QSCALE_MLA, WSP(float, WS_RQ)};
              pg8::gemm_phase<pg8::EpiQfull, pg8::StaticOrder, true, true>(ring, g, S, E, F.tid); } PR_END(31);
#endif
            PR_BEGIN(32); { pg8::Gemm g{WSP(bf16, WS_CKVN), WLAYER(bf16, l, W_UKV), M, 4096, 512}; pg8::StaticOrder S; S.init(M, 4096, F.G, F.bx);
              pg8::EpiKV E{WSP(bf16, WS_KN), WSP(bf16, WS_VC), WSP(float, WS_RKV)};
              pg8::gemm_phase<pg8::EpiKV, pg8::StaticOrder, true, true>(ring, g, S, E, F.tid); } PR_END(32);
            __syncthreads(); }
            PHASE_END(g0 + 2); PR_END(3);
        }
        if (EN(4) && RUN(g0 + 3)) { PR_BEGIN(4); for (int rep_ = 0; rep_ < REPS(4); ++rep_) { PH_BEGIN();
#ifndef NO_ATT
            PR_BEGIN(40); mix_attention(F, P, l);
            __syncthreads(); PR_END(40);
#endif
#ifndef NO_HOUT
            PR_BEGIN(41); { PH_BEGIN(); for (int ch = F.vcu; ch < 2048; ch += F.G) hgrn_out(F, P, ch, l); } PR_END(41);
#endif
            __syncthreads(); }
            PHASE_END(g0 + 3); PR_END(4);
        }
        if (EN(5) && RUN(g0 + 4)) { PR_BEGIN(5); for (int rep_ = 0; rep_ < REPS(5); ++rep_) { PH_BEGIN();
            pg8::Gemm g{WSP(bf16, WS_MIX), WLAYER(bf16, l, W_O), M, DM, DM}; pg8::StaticOrder S; S.init(M, DM, F.G, F.bx);
            pg8::EpiY E{WSP(bf16, WS_Y), WSP(float, WS_YSS)};
            pg8::gemm_phase<pg8::EpiY, pg8::StaticOrder, true, true>(ring, g, S, E, F.tid);
            __syncthreads(); }
            PHASE_END(g0 + 4); PR_END(5);
        }
        if (EN(6) && RUN(g0 + 5)) { PR_BEGIN(6); PH_BEGIN();
            const int gw = F.vcu * NWAVES + F.wave, NGW = F.G * NWAVES;
            if (l == 0) { for (int m = gw; m < M; m += NGW) norm_step<true, false>(F.lane, P.inp(0) + (size_t)m * DM, WSP(bf16, WS_HN) + (size_t)m * DM, WSP(bf16, WS_Y) + (size_t)m * DM, WSP(float, WS_YSS) + (size_t)m * 64, P.inp(20) + (size_t)l * DM, nullptr, WSP(float, WS_HSS) + m); }
            else { norm_rows<false, false>(F.lane, gw, NGW, M, nullptr, WSP(bf16, WS_HN), WSP(bf16, WS_Y), WSP(float, WS_YSS), P.inp(20) + (size_t)l * DM, nullptr, WSP(float, WS_HSS)); }
            PHASE_END(g0 + 5); PR_END(6);
        }
        if (EN(7) && RUN(g0 + 6)) { PR_BEGIN(7); for (int rep_ = 0; rep_ < REPS(7); ++rep_) { PH_BEGIN();
            pg8::Gemm g{WSP(bf16, WS_HN), WLAYER(bf16, l, W_MQ), M, 512, DM}; pg8::StaticOrder S; S.init(M, 512, F.G, F.bx);
            pg8::EpiQmem E{WSP(bf16, WS_QMEM), QSCALE_128, WSP(float, WS_HSS)};
            pg8::gemm_phase<pg8::EpiQmem, pg8::StaticOrder, true, true>(ring, g, S, E, F.tid);
            if (F.G == 256 && F.bx >= 128) steal_upto(F, P, Q8_TOTAL, 5);
            __syncthreads(); }
            PHASE_END(g0 + 6); PR_END(7);
        }
        if (EN(8) && RUN(g0 + 7)) { PR_BEGIN(7); for (int rep_ = 0; rep_ < REPS(8); ++rep_) { PH_BEGIN(); mem_attention(F, P, l); __syncthreads(); } PHASE_END(g0 + 7); PR_END(7); }
        if (EN(9) && RUN(g0 + 8)) { PR_BEGIN(7); for (int rep_ = 0; rep_ < REPS(9); ++rep_) { PH_BEGIN();
            pg8::Gemm g{WSP(bf16, WS_OMEM), WLAYER(bf16, l, W_MO), M, DM, 512}; pg8::StaticOrder S; S.init(M, DM, F.G, F.bx);
            pg8::EpiY E{WSP(bf16, WS_Y), WSP(float, WS_YSS)};
            pg8::gemm_phase<pg8::EpiY, pg8::StaticOrder, true, true>(ring, g, S, E, F.tid);
            __syncthreads(); }
            PHASE_END(g0 + 8); PR_END(7);
        }
        if (EN(10) && RUN(g0 + 9)) { PR_BEGIN(6); PH_BEGIN();
            const int gw = F.vcu * NWAVES + F.wave, NGW = F.G * NWAVES;
            norm_rows<false, false>(F.lane, gw, NGW, M, nullptr, WSP(bf16, WS_HN), WSP(bf16, WS_Y), WSP(float, WS_YSS), P.inp(22) + (size_t)l * DM, nullptr, WSP(float, WS_HSS));
            PHASE_END(g0 + 9); PR_END(6);
        }
        if (EN(11) && RUN(g0 + 10)) { PR_BEGIN(11); for (int rep_ = 0; rep_ < REPS(11); ++rep_) { PH_BEGIN();
            pg8::Gemm g{WSP(bf16, WS_HN), WLAYER(bf16, l, W_FF1), M, DFF, DM}; pg8::StaticOrder S; S.init(M, DFF, F.G, F.bx);
            pg8::EpiRelu2 E{WSP(bf16, WS_HID), DFF, WSP(float, WS_HSS)};
            pg8::gemm_phase<pg8::EpiRelu2, pg8::StaticOrder, true, true>(ring, g, S, E, F.tid);
            __syncthreads(); }
            PHASE_END(g0 + 10); PR_END(11);
        }
        if (EN(12) && RUN(g0 + 11)) { PR_BEGIN(12); for (int rep_ = 0; rep_ < REPS(12); ++rep_) { PH_BEGIN();
            pg8::Gemm g{WSP(bf16, WS_HID), WLAYER(bf16, l, W_FF2), M, DM, DFF}; pg8::StaticOrder S; S.init(M, DM, F.G, F.bx);
            pg8::EpiY E{WSP(bf16, WS_Y), WSP(float, WS_YSS)};
            pg8::gemm_phase<pg8::EpiY, pg8::StaticOrder, true, true>(ring, g, S, E, F.tid);
            __syncthreads(); }
            PHASE_END(g0 + 11); PR_END(12);
        }
        if (EN(13) && RUN(g0 + 12)) { PR_BEGIN(6); PH_BEGIN();
            if (l + 1 < DEPTH) steal_upto(F, P, (l + 1) * Q8_LAYER, 1 << 30);
            const int gw = F.vcu * NWAVES + F.wave, NGW = F.G * NWAVES;
            if (l + 1 < DEPTH) { norm_rows<false, false>(F.lane, gw, NGW, M, nullptr, WSP(bf16, WS_HN), WSP(bf16, WS_Y), WSP(float, WS_YSS), P.inp(24) + (size_t)l * DM, nullptr, WSP(float, WS_HSS)); }
            else { for (int m = gw; m < M; m += NGW) norm_step<false, true>(F.lane, nullptr, WSP(bf16, WS_HN) + (size_t)m * DM, WSP(bf16, WS_Y) + (size_t)m * DM, WSP(float, WS_YSS) + (size_t)m * 64, P.inp(24) + (size_t)l * DM, P.out + (size_t)m * DM, nullptr); }
            PHASE_END(g0 + 12); PR_END(6);
        }
    }
#ifdef PROBE_ID
    if (blockIdx.x == 0) { const unsigned long long t0_ = __builtin_amdgcn_s_memrealtime(), want_ = (unsigned long long)(PROBE_AMP) * pr_acc; while (__builtin_amdgcn_s_memrealtime() - t0_ < want_) __builtin_amdgcn_s_sleep(32); }
#endif
#undef RUN
#undef PHASE_END
}

#ifndef MK_PER_PHASE
#define MK_PER_PHASE 0
#endif
extern "C" void kernel_launch(void* const* d_in, const int* in_sizes, int n_in, void* d_out, int out_size, void* d_ws, size_t ws_size, hipStream_t stream) {
    static int grid = 0;
    if (grid == 0) {
        if (n_in != 25 || in_sizes[0] != M * DM || out_size != M * DM || ws_size < WS_END) { fprintf(stderr, "kernel_launch: unexpected shapes (n_in %d, in0 %d, out %d, ws %zu; need ws >= %zu); nothing launched\n", n_in, n_in > 0 ? in_sizes[0] : -1, out_size, ws_size, (size_t)WS_END); grid = -1; return; }
        int dev = 0, cus = 0, per_cu = 0;
        if (hipGetDevice(&dev) != hipSuccess || hipDeviceGetAttribute(&cus, hipDeviceAttributeMultiprocessorCount, dev) != hipSuccess) { fprintf(stderr, "kernel_launch: device query failed\n"); grid = -1; return; }
        if (hipFuncSetAttribute((const void*)trunk_fwd, hipFuncAttributeMaxDynamicSharedMemorySize, LDS_BYTES) != hipSuccess) { fprintf(stderr, "kernel_launch: hipFuncSetAttribute failed\n"); grid = -1; return; }
        if (hipOccupancyMaxActiveBlocksPerMultiprocessor(&per_cu, (const void*)trunk_fwd, NWAVES * 64, LDS_BYTES) != hipSuccess || per_cu < 1)
            fprintf(stderr, "kernel_launch: note: occupancy query reports %d workgroups per CU\n", per_cu);
        (void)hipGetLastError();
        grid = cus;
    }
    if (grid < 0) return;
    if (hipMemsetAsync((char*)d_ws + WS_CTL, 0, CTL_ZERO_BYTES, stream) != hipSuccess) { fprintf(stderr, "kernel_launch: memset failed\n"); return; }
    Args a{};
    for (int i = 0; i < 25; ++i) a.in[i] = (const float*)d_in[i];
    a.out = (float*)d_out; a.ws = (unsigned char*)d_ws;
#if MK_PER_PHASE
    for (int p = 0; p < NPHASES; ++p) { a.ph_lo = p; a.ph_hi = p + 1; hipLaunchKernelGGL(trunk_fwd, dim3(grid), dim3(NWAVES * 64), LDS_BYTES, stream, a); }
#else
    a.ph_lo = 0; a.ph_hi = NPHASES;
    hipLaunchKernelGGL(trunk_fwd, dim3(grid), dim3(NWAVES * 64), LDS_BYTES, stream, a);
#endif
    const hipError_t le = hipPeekAtLastError();
    if (le != hipSuccess) fprintf(stderr, "kernel_launch: launch failed: %s\n", hipGetErrorName(le));
}
```

```cpp
#define CV_SKD 8
#define CVB8 5440
#include <hip/hip_runtime.h>
#include <cstdio>
#include <cstdint>
namespace pg8 {
#define PG8_LAS __attribute__((address_space(3)))
typedef unsigned short bf16_t;
typedef short bf16x8 __attribute__((ext_vector_type(8)));
typedef float f32x4 __attribute__((ext_vector_type(4)));
typedef unsigned u32x4 __attribute__((ext_vector_type(4)));
constexpr int BM = 256, BK = 64, HALF = 128, HTB = HALF * BK * 2  , STAGE_BYTES = 8 * HTB, NXCD = 8, WGM = 8;

__host__ __device__ __forceinline__ int lds_byte(int r, int c) { const int st = (r >> 4) * 2 + (c >> 5), rr = r & 15, cc = c & 31, ob = rr * 64 + cc * 2; return st * 1024 + (ob ^ (((ob >> 9) & 1) << 5)); }
__host__ __device__ __forceinline__ void stage_rc(int b, int& R, int& C) { const int st = b / 1024, sb = b % 1024, swz = sb ^ (((sb >> 9) & 1) << 5); R = (st >> 1) * 16 + swz / 64; C = (st & 1) * 32 + (swz % 64) / 2; }
__host__ __device__ __forceinline__ int perm32(int rho) { const int n = rho >> 4, i = rho & 15; return 8 * (i >> 2) + 4 * n + (i & 3); }

struct Unit { int pm, pn, ko; };
struct Gemm { const bf16_t* A; const bf16_t* Bt; int M, N, K; int ld; };

struct StaticOrder {
    int nM, nN, nwg, G, c;
    __host__ __device__ void init(int M, int N, int G_, int c_) { nM = M / BM; nN = N / BM; nwg = nM * nN; G = G_; c = c_; }
    __host__ __device__ bool next(int i, Unit& u) const {
        const long L = (long)i * G + c; if (L >= nwg) return false;
        int wgid = (int)L; { const int q = nwg / NXCD, r = nwg % NXCD, xcd = wgid % NXCD, off = wgid / NXCD; wgid = (xcd < r ? xcd * (q + 1) : r * (q + 1) + (xcd - r) * q) + off; }
        const int nig = WGM * nN, gid = wgid / nig, fm = gid * WGM, gsz = (nM - fm) < WGM ? (nM - fm) : WGM;
        u.pm = fm + ((wgid % nig) % gsz); u.pn = (wgid % nig) / gsz; u.ko = 0; return true;
    }
    __device__ __forceinline__ void a_ready(const Unit&) const {}
    __device__ __forceinline__ void done(const Unit&) const {}
};

struct HalfKOrder {
    StaticOrder s; int round, c, khalf;
    __device__ __forceinline__ bool next(int i, Unit& u) const { if (i > 0 || !s.next(round, u)) return false; u.ko = (c >> 7) * khalf; return true; }
    __device__ __forceinline__ void a_ready(const Unit&) const {}
    __device__ __forceinline__ void done(const Unit&) const {}
};
struct RoundOrder {
    StaticOrder s; int lo, hi;
    __device__ __forceinline__ bool next(int i, Unit& u) const { return (i + lo < hi) && s.next(i + lo, u); }
    __device__ __forceinline__ void a_ready(const Unit&) const {}
    __device__ __forceinline__ void done(const Unit&) const {}
};
__device__ __forceinline__ unsigned cvt_pk_bf16(float lo, float hi) { unsigned r; asm volatile("v_cvt_pk_bf16_f32 %0, %1, %2" : "=v"(r) : "v"(lo), "v"(hi)); return r; }
typedef float f32x2 __attribute__((ext_vector_type(2)));
__device__ __forceinline__ u32x4 pack8_bf16(const f32x4& v0, const f32x4& v1) { u32x4 w; w.x = cvt_pk_bf16(v0[0], v0[1]); w.y = cvt_pk_bf16(v0[2], v0[3]); w.z = cvt_pk_bf16(v1[0], v1[1]); w.w = cvt_pk_bf16(v1[2], v1[3]); return w; }

struct EpiBf16S {
    static constexpr bool PERM = true, AFTER_DRAIN = false;
    bf16_t* O; int ldc; float scale;
    __device__ __forceinline__ void operator()(const f32x4 (&acc)[2][2][4][2], const Unit& u, int wr, int wc, int fr, int fq) const {
        const int row0 = u.pm * BM + wr * 64 + fr, col0 = u.pn * BM + wc * 32 + 8 * fq;
#pragma unroll
        for (int ai = 0; ai < 2; ++ai)
#pragma unroll
            for (int m = 0; m < 4; ++m) { bf16_t* rowp = O + (size_t)(row0 + ai * HALF + m * 16) * ldc + col0;
#pragma unroll
                for (int bj = 0; bj < 2; ++bj) *(u32x4*)(rowp + bj * HALF) = pack8_bf16(acc[ai][bj][m][0] * scale, acc[ai][bj][m][1] * scale); }
    }
};
struct EpiRelu2 {
    static constexpr bool PERM = true, AFTER_DRAIN = false;
    bf16_t* O; int ldc; const float* rs;
    __device__ __forceinline__ void operator()(const f32x4 (&acc)[2][2][4][2], const Unit& u, int wr, int wc, int fr, int fq) const {
        const int row0 = u.pm * BM + wr * 64 + fr, col0 = u.pn * BM + wc * 32 + 8 * fq;
        const f32x4 z4 = {0.f, 0.f, 0.f, 0.f};
        float rv[2][4];
#pragma unroll
        for (int ai = 0; ai < 2; ++ai)
#pragma unroll
            for (int m = 0; m < 4; ++m) rv[ai][m] = rs[row0 + ai * HALF + m * 16];
#pragma unroll
        for (int ai = 0; ai < 2; ++ai)
#pragma unroll
            for (int m = 0; m < 4; ++m) { bf16_t* rowp = O + (size_t)(row0 + ai * HALF + m * 16) * ldc + col0; const float r2 = rv[ai][m] * rv[ai][m];
#pragma unroll
                for (int bj = 0; bj < 2; ++bj) { f32x4 a = __builtin_elementwise_max(acc[ai][bj][m][0], z4), b = __builtin_elementwise_max(acc[ai][bj][m][1], z4);
                    *(u32x4*)(rowp + bj * HALF) = pack8_bf16(a * a * r2, b * b * r2); } }
    }
};
struct EpiY {
    static constexpr bool PERM = true, AFTER_DRAIN = false;
    bf16_t* Y; float* yss;
    __device__ __forceinline__ void operator()(const f32x4 (&acc)[2][2][4][2], const Unit& u, int wr, int wc, int fr, int fq) const {
        const int row0 = u.pm * BM + wr * 64 + fr, col0 = u.pn * BM + wc * 32 + 8 * fq;
#pragma unroll
        for (int ai = 0; ai < 2; ++ai)
#pragma unroll
            for (int m = 0; m < 4; ++m) { const size_t r = (size_t)(row0 + ai * HALF + m * 16); bf16_t* rowp = Y + r * 4096 + col0; float s = 0.f;
#pragma unroll
                for (int bj = 0; bj < 2; ++bj) { const f32x4 a = acc[ai][bj][m][0], c = acc[ai][bj][m][1];
                    s += (a[0] * a[0] + a[1] * a[1]) + (a[2] * a[2] + a[3] * a[3]) + (c[0] * c[0] + c[1] * c[1]) + (c[2] * c[2] + c[3] * c[3]);
                    *(u32x4*)(rowp + bj * HALF) = pack8_bf16(a, c); }
                s += __shfl_xor(s, 16); s += __shfl_xor(s, 32);
                if (fq == 0) yss[r * 64 + u.pn * 4 + wc] = s; }
    }
};
template <int RS> __device__ __forceinline__ void store_hm(const f32x4 (&acc)[2][2][4][2], int bj, bf16_t* dst, float sc) {
#pragma unroll
    for (int ai = 0; ai < 2; ++ai)
#pragma unroll
        for (int m = 0; m < 4; ++m) *(u32x4*)(dst + (size_t)(ai * HALF + m * 16) * RS) = pack8_bf16(acc[ai][bj][m][0] * sc, acc[ai][bj][m][1] * sc);
}
struct EpiProj {
    static constexpr bool PERM = true, AFTER_DRAIN = false;
    bf16_t* proj; bf16_t* fox; float* logf; float* projx; bf16_t* cqb; bf16_t* ckvb; float* css; const float* lb; float fqscale; const float* rs;
    __device__ __forceinline__ void operator()(const f32x4 (&acc)[2][2][4][2], const Unit& u, int wr, int wc, int fr, int fq) const {
        const int row0 = u.pm * BM + wr * 64 + fr, cl = wc * 32 + 8 * fq;
#define RVLOAD() float rv[2][4]; _Pragma("unroll") for (int ai = 0; ai < 2; ++ai) _Pragma("unroll") for (int m = 0; m < 4; ++m) rv[ai][m] = rs[row0 + ai * HALF + m * 16]
#define RV(ai, m) rv[ai][m]
        if (u.pn == 31) {
            RVLOAD();
#pragma unroll
            for (int ai = 0; ai < 2; ++ai)
#pragma unroll
                for (int m = 0; m < 4; ++m) { float* rowp = projx + (size_t)(row0 + ai * HALF + m * 16) * 256 + cl; const float rvv = RV(ai, m);
#pragma unroll
                    for (int bj = 0; bj < 2; ++bj) { *(f32x4*)(rowp + bj * HALF) = acc[ai][bj][m][0] * rvv; *(f32x4*)(rowp + bj * HALF + 4) = acc[ai][bj][m][1] * rvv; } }
        } else if (u.pn >= 26 && u.pn < 31) {
            RVLOAD(); const bool isq = u.pn < 29; bf16_t* dst = isq ? cqb + (u.pn - 26) * BM : ckvb + (u.pn - 29) * BM; const int ld = isq ? 768 : 512;
#pragma unroll
            for (int ai = 0; ai < 2; ++ai)
#pragma unroll
                for (int m = 0; m < 4; ++m) { const size_t r = (size_t)(row0 + ai * HALF + m * 16); const float rvv = RV(ai, m); float s = 0.f;
#pragma unroll
                    for (int bj = 0; bj < 2; ++bj) { const f32x4 a = acc[ai][bj][m][0] * rvv, c = acc[ai][bj][m][1] * rvv;
                        s += (a[0] * a[0] + a[1] * a[1]) + (a[2] * a[2] + a[3] * a[3]) + (c[0] * c[0] + c[1] * c[1]) + (c[2] * c[2] + c[3] * c[3]);
                        *(u32x4*)(dst + r * ld + cl + bj * HALF) = pack8_bf16(a, c); }
                    s += __shfl_xor(s, 16); s += __shfl_xor(s, 32);
                    if (fq == 0) css[r * 20 + (u.pn - 26) * 4 + wc] = s; }
        } else if (u.pn >= 14 && u.pn < 26) {
            const int part = (u.pn - 14) >> 2, hp = (u.pn - 14) & 3, b = u.pm >> 5, s0 = (u.pm & 31) * BM + wr * 64 + fr;
            const float sc = part == 0 ? fqscale : 1.0f; RVLOAD();
#pragma unroll
            for (int bj = 0; bj < 2; ++bj) { bf16_t* dst = fox + ((size_t)(part * 16 + b * 8 + 2 * hp + bj) * 8192 + s0) * 128 + cl;
#pragma unroll
                for (int ai = 0; ai < 2; ++ai)
#pragma unroll
                    for (int m = 0; m < 4; ++m) { const float f = sc * RV(ai, m); *(u32x4*)(dst + (size_t)(ai * HALF + m * 16) * 128) = pack8_bf16(acc[ai][bj][m][0] * f, acc[ai][bj][m][1] * f); } }
        } else if (u.pn >= 4 && u.pn < 8) {
            const int c0 = (u.pn - 4) * BM + cl;
            f32x4 lbv[2][2];
#pragma unroll
            for (int bj = 0; bj < 2; ++bj) { lbv[bj][0] = *(const f32x4*)(lb + c0 + bj * HALF); lbv[bj][1] = *(const f32x4*)(lb + c0 + bj * HALF + 4); }
#pragma unroll
            for (int ai = 0; ai < 2; ++ai)
#pragma unroll
                for (int m = 0; m < 4; ++m) { const size_t r = (size_t)(row0 + ai * HALF + m * 16); const float rvv = rs[r];
#pragma unroll
                    for (int bj = 0; bj < 2; ++bj) { f32x4 lf[2], ka[2];
#pragma unroll
                        for (int n = 0; n < 2; ++n)
#pragma unroll
                            for (int j = 0; j < 4; ++j) { const float z = acc[ai][bj][m][n][j] * rvv, L = lbv[bj][n][j];
                                const float t = __expf(-fabsf(z)), rr = __builtin_amdgcn_rcpf(1.0f + t), sm = t * rr;
                                const float s = z >= 0.f ? rr : sm, sn = z >= 0.f ? sm : rr;
                                const float f = L + (1.0f - L) * s;
                                lf[n][j] = __logf(fmaxf(f, 1e-30f)); ka[n][j] = (1.0f - L) * sn; }
                        *(f32x4*)(logf + r * 1024 + c0 + bj * HALF) = lf[0]; *(f32x4*)(logf + r * 1024 + c0 + bj * HALF + 4) = lf[1];
                        *(u32x4*)(proj + r * 4096 + 1024 + c0 + bj * HALF) = pack8_bf16(ka[0], ka[1]); } }
        } else {
            const int c0 = (u.pn < 14 ? u.pn * BM : 3584 + (u.pn - 32) * BM) + cl; RVLOAD();
#pragma unroll
            for (int ai = 0; ai < 2; ++ai)
#pragma unroll
                for (int m = 0; m < 4; ++m) { bf16_t* rowp = proj + (size_t)(row0 + ai * HALF + m * 16) * 4096 + c0; const float rvv = RV(ai, m);
#pragma unroll
                    for (int bj = 0; bj < 2; ++bj) *(u32x4*)(rowp + bj * HALF) = pack8_bf16(acc[ai][bj][m][0] * rvv, acc[ai][bj][m][1] * rvv); }
        }
    }
};
#undef RV
#undef RVLOAD
struct EpiQfull {
    static constexpr bool PERM = true, AFTER_DRAIN = false;
    bf16_t* qn; bf16_t* qr; const float* rope; float qscale; const float* rq;
    __device__ __forceinline__ void operator()(const f32x4 (&acc)[2][2][4][2], const Unit& u, int wr, int wc, int fr, int fq) const {
        const int row0 = u.pm * BM + wr * 64 + fr, cl = wc * 32 + 8 * fq, b = u.pm >> 5, s0 = (u.pm & 31) * BM + wr * 64 + fr;
        float rv[2][4];
#pragma unroll
        for (int ai = 0; ai < 2; ++ai)
#pragma unroll
            for (int m = 0; m < 4; ++m) rv[ai][m] = qscale * rq[row0 + ai * HALF + m * 16];
        if (u.pn < 8) {
#pragma unroll
            for (int bj = 0; bj < 2; ++bj) { bf16_t* dst = qn + ((size_t)(b * 16 + 2 * u.pn + bj) * 8192 + s0) * 128 + cl;
#pragma unroll
                for (int ai = 0; ai < 2; ++ai)
#pragma unroll
                    for (int m = 0; m < 4; ++m) { const float f = rv[ai][m]; *(u32x4*)(dst + (size_t)(ai * HALF + m * 16) * 128) = pack8_bf16(acc[ai][bj][m][0] * f, acc[ai][bj][m][1] * f); } }
        } else {
            const int i0 = (cl & 63) >> 1;
#pragma unroll
            for (int ai = 0; ai < 2; ++ai) {
                f32x4 cs[4][2];
#pragma unroll
                for (int m = 0; m < 4; ++m) { const size_t r = (size_t)(row0 + ai * HALF + m * 16); cs[m][0] = *(const f32x4*)(rope + (r * 32 + i0) * 2); cs[m][1] = *(const f32x4*)(rope + (r * 32 + i0) * 2 + 4); }
#pragma unroll
                for (int m = 0; m < 4; ++m) { const int s = s0 + ai * HALF + m * 16; const float qs = rv[ai][m]; const f32x4 cs0 = cs[m][0], cs1 = cs[m][1];
#pragma unroll
                    for (int bj = 0; bj < 2; ++bj) { const int head = 4 * (u.pn - 8) + 2 * bj + (cl >> 6);
                        const f32x4 a = acc[ai][bj][m][0], bq = acc[ai][bj][m][1];
                        f32x4 oa, ob;
                        oa[0] = (a[0] * cs0[0] - a[1] * cs0[1]) * qs; oa[1] = (a[0] * cs0[1] + a[1] * cs0[0]) * qs;
                        oa[2] = (a[2] * cs0[2] - a[3] * cs0[3]) * qs; oa[3] = (a[2] * cs0[3] + a[3] * cs0[2]) * qs;
                        ob[0] = (bq[0] * cs1[0] - bq[1] * cs1[1]) * qs; ob[1] = (bq[0] * cs1[1] + bq[1] * cs1[0]) * qs;
                        ob[2] = (bq[2] * cs1[2] - bq[3] * cs1[3]) * qs; ob[3] = (bq[2] * cs1[3] + bq[3] * cs1[2]) * qs;
                        *(u32x4*)(qr + ((size_t)(b * 16 + head) * 8192 + s) * 64 + (cl & 63)) = pack8_bf16(oa, ob); } }
                asm volatile("" ::: "memory"); }
        }
    }
};
struct EpiKV {
    static constexpr bool PERM = true, AFTER_DRAIN = false;
    bf16_t* kn; bf16_t* vc; const float* rkv;
    __device__ __forceinline__ void operator()(const f32x4 (&acc)[2][2][4][2], const Unit& u, int wr, int wc, int fr, int fq) const {
        const int cl = wc * 32 + 8 * fq, b = u.pm >> 5, s0 = (u.pm & 31) * BM + wr * 64 + fr;
        const size_t off = ((size_t)(b * 16 + u.pn) * 8192 + s0) * 128 + cl;
        float rv[2][4];
#pragma unroll
        for (int ai = 0; ai < 2; ++ai)
#pragma unroll
            for (int m = 0; m < 4; ++m) rv[ai][m] = rkv[u.pm * BM + wr * 64 + fr + ai * HALF + m * 16];
#pragma unroll
        for (int ai = 0; ai < 2; ++ai)
#pragma unroll
            for (int m = 0; m < 4; ++m) { const float f = rv[ai][m]; const size_t o2 = off + (size_t)(ai * HALF + m * 16) * 128;
                *(u32x4*)(kn + o2) = pack8_bf16(acc[ai][0][m][0] * f, acc[ai][0][m][1] * f); *(u32x4*)(vc + o2) = pack8_bf16(acc[ai][1][m][0] * f, acc[ai][1][m][1] * f); }
    }
};
struct EpiQmem {
    static constexpr bool PERM = true, AFTER_DRAIN = false;
    bf16_t* qm; float scale; const float* rs;
    __device__ __forceinline__ void operator()(const f32x4 (&acc)[2][2][4][2], const Unit& u, int wr, int wc, int fr, int fq) const {
        const int cl = wc * 32 + 8 * fq, b = u.pm >> 5, s0 = (u.pm & 31) * BM + wr * 64 + fr;
        float rv[2][4];
#pragma unroll
        for (int ai = 0; ai < 2; ++ai)
#pragma unroll
            for (int m = 0; m < 4; ++m) rv[ai][m] = scale * rs[u.pm * BM + wr * 64 + fr + ai * HALF + m * 16];
#pragma unroll
        for (int bj = 0; bj < 2; ++bj) { bf16_t* dst = qm + ((size_t)(b * 4 + 2 * u.pn + bj) * 8192 + s0) * 128 + cl;
#pragma unroll
            for (int ai = 0; ai < 2; ++ai)
#pragma unroll
                for (int m = 0; m < 4; ++m) { const float f = rv[ai][m]; *(u32x4*)(dst + (size_t)(ai * HALF + m * 16) * 128) = pack8_bf16(acc[ai][bj][m][0] * f, acc[ai][bj][m][1] * f); } }
    }
};
struct EpiKVmem {
    static constexpr bool PERM = true, AFTER_DRAIN = false;
    bf16_t* km; bf16_t* vm;
    __device__ __forceinline__ void operator()(const f32x4 (&acc)[2][2][4][2], const Unit& u, int wr, int wc, int fr, int fq) const {
        const int cl = wc * 32 + 8 * fq, b = u.pm, s0 = wr * 64 + fr;
        bf16_t* base = u.pn < 2 ? km : vm; const int hp = u.pn & 1;
#pragma unroll
        for (int bj = 0; bj < 2; ++bj) store_hm<128>(acc, bj, base + ((size_t)(b * 4 + 2 * hp + bj) * 256 + s0) * 128 + cl, 1.0f);
    }
};
template <class Epi, class Sched, bool ALIGN_EPI = false, bool SP2 = false>
__device__ __forceinline__ void gemm_phase(PG8_LAS unsigned char* lds, const Gemm g, const Sched& S, const Epi& E, int tid_in) {
    int tid_ = tid_in; asm volatile("" : "+v"(tid_));
    const int tid = tid_, wid = __builtin_amdgcn_readfirstlane(tid >> 6), lane = tid & 63, wr = wid >> 2, wc = wid & 3, fr = lane & 15, fq = lane >> 4;
    const int K = g.ld ? g.ld : g.K  , nt = g.K / BK;
    unsigned voffA[2], voffB[2];
#pragma unroll
    for (int i = 0; i < 2; ++i) { int R, C; stage_rc(tid * 16 + i * 8192, R, C); const int Rb = Epi::PERM ? ((R & ~31) + perm32(R & 31)) : R;
        voffA[i] = (unsigned)(R * K + C) * 2u; voffB[i] = (unsigned)(Rb * K + C) * 2u; }
    const size_t kstep = (size_t)(BK * 2);
    const size_t hstep = (size_t)HALF * K * 2;
    const size_t tstep = 2 * hstep;
    const unsigned ldsw = (unsigned)wid * 1024u;
    const int aoff = lds_byte(wr * 64 + fr, fq * 8), boff = lds_byte(wc * 32 + fr, fq * 8);
#define PG8_SA(b, h) (((b) * 2 + (h)) * HTB)
#define PG8_SB(b, h) ((4 + (b) * 2 + (h)) * HTB)
#define PG8_STAGE(bufoff, gbase, voff) do { _Pragma("unroll") for (int _i = 0; _i < 2; ++_i) \
        __builtin_amdgcn_global_load_lds((const unsigned*)((const char*)(gbase) + (voff)[_i]), (PG8_LAS unsigned*)(lds + (bufoff) + ldsw + _i * 8192), 16, 0, 0); } while (0)
#define PG8_LDA(dst, b, h) do { _Pragma("unroll") for (int m = 0; m < 4; ++m) _Pragma("unroll") for (int k = 0; k < 2; ++k) dst[m][k] = *(const PG8_LAS bf16x8*)(lds + PG8_SA(b, h) + aoff + m * 2048 + k * 1024); } while (0)
#define PG8_LDB(dst, b, h) do { _Pragma("unroll") for (int n = 0; n < 2; ++n) _Pragma("unroll") for (int k = 0; k < 2; ++k) dst[n][k] = *(const PG8_LAS bf16x8*)(lds + PG8_SB(b, h) + boff + n * 2048 + k * 1024); } while (0)
#define PG8_MMA(ai, bj, At, Bt) do { __builtin_amdgcn_s_setprio(1); _Pragma("unroll") for (int m = 0; m < 4; ++m) _Pragma("unroll") for (int n = 0; n < 2; ++n) _Pragma("unroll") for (int k = 0; k < 2; ++k) \
        acc[ai][bj][m][n] = __builtin_amdgcn_mfma_f32_16x16x32_bf16(Bt[n][k], At[m][k], acc[ai][bj][m][n], 0, 0, 0); __builtin_amdgcn_s_setprio(0); } while (0)
#define PG8_WAIT_V(n) asm volatile("s_waitcnt vmcnt(" #n ")" ::: "memory")
#define PG8_WAIT_L(n) asm volatile("s_waitcnt lgkmcnt(" #n ")" ::: "memory")
#define PG8_BAR __builtin_amdgcn_s_barrier()
#define PG8_SCHED __builtin_amdgcn_sched_barrier(0)
    Unit cur, nxt; int ui = 0;
    if (!S.next(0, cur)) return;
    f32x4 acc[2][2][4][2];
#pragma unroll
    for (int a = 0; a < 2; ++a)
#pragma unroll
        for (int b = 0; b < 2; ++b)
#pragma unroll
            for (int m = 0; m < 4; ++m)
#pragma unroll
                for (int n = 0; n < 2; ++n) acc[a][b][m][n] = (f32x4){0.f, 0.f, 0.f, 0.f};
    bf16x8 At[4][2], B0[2][2], B1[2][2];
    const char* cA = (const char*)g.A + (size_t)cur.pm * tstep + (size_t)cur.ko * 2; const char* cB = (const char*)g.Bt + (size_t)cur.pn * tstep + (size_t)cur.ko * 2;
    S.a_ready(cur);
    if constexpr (SP2) {
        PG8_STAGE(PG8_SB(0, 0), cB, voffB); PG8_STAGE(PG8_SB(0, 1), cB + hstep, voffB); PG8_STAGE(PG8_SA(0, 0), cA, voffA); PG8_STAGE(PG8_SA(0, 1), cA + hstep, voffA);
        if (wr == 1) PG8_BAR;
        PG8_WAIT_V(2); PG8_BAR;
        PG8_STAGE(PG8_SB(1, 0), cB + kstep, voffB); PG8_STAGE(PG8_SA(1, 0), cA + kstep, voffA); PG8_STAGE(PG8_SB(1, 1), cB + hstep + kstep, voffB);
        PG8_WAIT_V(6); PG8_BAR;
    } else {
        PG8_STAGE(PG8_SB(0, 0), cB, voffB); PG8_STAGE(PG8_SA(0, 0), cA, voffA); PG8_STAGE(PG8_SB(0, 1), cB + hstep, voffB); PG8_STAGE(PG8_SA(0, 1), cA + hstep, voffA);
        if (wr == 1) PG8_BAR;
        PG8_WAIT_V(4); PG8_BAR;
        PG8_STAGE(PG8_SB(1, 0), cB + kstep, voffB); PG8_STAGE(PG8_SA(1, 0), cA + kstep, voffA); PG8_STAGE(PG8_SB(1, 1), cB + hstep + kstep, voffB);
        PG8_WAIT_V(6); PG8_BAR;
    }
    for (;;) {
        const bool has_next = S.next(ui + 1, nxt);
        const char* nA = has_next ? (const char*)g.A + (size_t)nxt.pm * tstep + (size_t)nxt.ko * 2 : cA; const char* nB = has_next ? (const char*)g.Bt + (size_t)nxt.pn * tstep + (size_t)nxt.ko * 2 : cB;
        for (int t = 0; t < nt; t += 2) {
            const bool last = (t == nt - 2);
            const char* a1 = cA + (size_t)(t + 1) * kstep;
            const char* a2 = last ? nA : cA + (size_t)(t + 2) * kstep; const char* b2 = last ? nB : cB + (size_t)(t + 2) * kstep;
            const char* a3 = a2 + kstep; const char* b3 = b2 + kstep;
            if (last && has_next) S.a_ready(nxt);
            if constexpr (SP2) {
            PG8_LDB(B0, 0, 0); PG8_LDB(B1, 0, 1); PG8_SCHED; PG8_LDA(At, 0, 0); PG8_STAGE(PG8_SA(1, 1), a1 + hstep, voffA);
            PG8_WAIT_V(8); PG8_WAIT_L(0); PG8_BAR; PG8_MMA(0, 0, At, B0); PG8_MMA(0, 1, At, B1); PG8_BAR; PG8_SCHED;
            PG8_LDA(At, 0, 1); PG8_STAGE(PG8_SB(0, 0), b2, voffB); PG8_STAGE(PG8_SB(0, 1), b2 + hstep, voffB); PG8_STAGE(PG8_SA(0, 0), a2, voffA);
            PG8_WAIT_V(8); PG8_WAIT_L(0); PG8_BAR; PG8_MMA(1, 0, At, B0); PG8_MMA(1, 1, At, B1); PG8_BAR; PG8_SCHED;
            PG8_LDB(B0, 1, 0); PG8_LDB(B1, 1, 1); PG8_SCHED; PG8_LDA(At, 1, 0); PG8_STAGE(PG8_SA(0, 1), a2 + hstep, voffA);
            PG8_WAIT_V(8); PG8_WAIT_L(0); PG8_BAR; PG8_MMA(0, 0, At, B0); PG8_MMA(0, 1, At, B1); PG8_BAR; PG8_SCHED;
            PG8_LDA(At, 1, 1); PG8_STAGE(PG8_SB(1, 0), b3, voffB); PG8_STAGE(PG8_SB(1, 1), b3 + hstep, voffB); PG8_STAGE(PG8_SA(1, 0), a3, voffA);
            PG8_WAIT_V(8); PG8_WAIT_L(0); PG8_BAR; PG8_MMA(1, 0, At, B0); PG8_MMA(1, 1, At, B1); PG8_BAR; PG8_SCHED;
            } else {
            PG8_LDB(B0, 0, 0); PG8_SCHED; PG8_LDA(At, 0, 0); PG8_STAGE(PG8_SA(1, 1), a1 + hstep, voffA);
            PG8_WAIT_L(8); PG8_BAR; PG8_WAIT_L(0); PG8_MMA(0, 0, At, B0); PG8_BAR; PG8_SCHED;
            PG8_LDB(B1, 0, 1); PG8_STAGE(PG8_SB(0, 0), b2, voffB);
            PG8_BAR; PG8_WAIT_L(0); PG8_MMA(0, 1, At, B1); PG8_BAR;
            PG8_LDA(At, 0, 1); PG8_STAGE(PG8_SA(0, 0), a2, voffA);
            PG8_BAR; PG8_WAIT_L(0); PG8_MMA(1, 0, At, B0); PG8_BAR; PG8_SCHED;
            PG8_STAGE(PG8_SB(0, 1), b2 + hstep, voffB);
            PG8_WAIT_V(6); PG8_BAR; PG8_MMA(1, 1, At, B1); PG8_BAR;
            PG8_LDB(B0, 1, 0); PG8_SCHED; PG8_LDA(At, 1, 0); PG8_STAGE(PG8_SA(0, 1), a2 + hstep, voffA);
            PG8_WAIT_L(8); PG8_BAR; PG8_WAIT_L(0); PG8_MMA(0, 0, At, B0); PG8_BAR; PG8_SCHED;
            PG8_LDB(B1, 1, 1); PG8_STAGE(PG8_SB(1, 0), b3, voffB);
            PG8_BAR; PG8_WAIT_L(0); PG8_MMA(0, 1, At, B1); PG8_BAR;
            PG8_LDA(At, 1, 1); PG8_STAGE(PG8_SA(1, 0), a3, voffA);
            PG8_BAR; PG8_WAIT_L(0); PG8_MMA(1, 0, At, B0); PG8_BAR; PG8_SCHED;
            PG8_STAGE(PG8_SB(1, 1), b3 + hstep, voffB);
            PG8_WAIT_V(6); PG8_BAR; PG8_MMA(1, 1, At, B1); PG8_BAR;
            }
        }
        if constexpr (ALIGN_EPI) { if (wr == 0) PG8_BAR; }
        if constexpr (!Epi::AFTER_DRAIN) { E(acc, cur, wr, wc, fr, fq); S.done(cur); }
        if (!has_next) break;
#pragma unroll
        for (int a = 0; a < 2; ++a)
#pragma unroll
            for (int b = 0; b < 2; ++b)
#pragma unroll
                for (int m = 0; m < 4; ++m)
#pragma unroll
                    for (int n = 0; n < 2; ++n) acc[a][b][m][n] = (f32x4){0.f, 0.f, 0.f, 0.f};
        cur = nxt; cA = nA; cB = nB; ++ui;
        if constexpr (ALIGN_EPI) { if (wr == 1) PG8_BAR; }
    }
    PG8_WAIT_V(0);
    if constexpr (!ALIGN_EPI) { if (wr == 0) PG8_BAR; }
    PG8_BAR;
    if constexpr (Epi::AFTER_DRAIN) { E.fused(acc, cur, wr, wc, fr, fq, lds, wid, lane); S.done(cur); }
#undef PG8_SA
#undef PG8_SB
#undef PG8_STAGE
#undef PG8_LDA
#undef PG8_LDB
#undef PG8_MMA
#undef PG8_WAIT_V
#undef PG8_WAIT_L
#undef PG8_BAR
#undef PG8_SCHED
}
}
namespace att {
typedef unsigned short bf16;
typedef short bf16x8 __attribute__((ext_vector_type(8)));
typedef short s16x4 __attribute__((ext_vector_type(4)));
typedef float f32x16 __attribute__((ext_vector_type(16)));
typedef float f32x4 __attribute__((ext_vector_type(4)));
typedef unsigned u32x4 __attribute__((ext_vector_type(4)));
constexpr int NW = 8, QBLK = 32, KVBLK = 64, QB = NW * QBLK, D = 128;
constexpr int SHM_V = KVBLK * D * 2, SHM_K = KVBLK * D * 2, XROW = 144, SHM_X = KVBLK * XROW;
constexpr int OFF_V = 0, OFF_K = 2 * SHM_V, OFF_X = OFF_K + 2 * SHM_K, OFF_WS = OFF_X + 2 * SHM_X, OFF_QX = OFF_WS + NW * 64 * 4;
constexpr int QL = 5;
constexpr int QXW = (4 + QL) * 1024, ATT_LDS_BYTES = OFF_QX + NW * QXW;
constexpr float THR = 11.5f;
constexpr float RMS_EPS = 1e-6f;

#define KSWZ(row, colB) ((row) * 256 + ((colB) ^ (((row) & 7) << 4)))
#define SBAR() __builtin_amdgcn_sched_barrier(0)
__device__ __forceinline__ int v_st(int k, int c) { const int kk = (k & ~0xC) | ((k & 4) << 1) | ((k & 8) >> 1); return ((kk >> 3) * 4 + (c >> 5)) * 512 + ((kk & 7) * 32 + (c & 31)) * 2; }
__device__ __forceinline__ int v_rd_base(int lane) { return ((lane & 3) << 3) | (((lane >> 2) & 3) << 6) | (((lane >> 4) & 1) << 5) | (((lane >> 5) & 1) << 8); }
constexpr int v_rd_off(int d0, int ks, int half) { return d0 * 512 + ks * 4096 + half * 2048; }
__device__ __forceinline__ int crow(int r, int hi) { return (r & 3) + 8 * (r >> 2) + 4 * hi; }
__device__ __forceinline__ unsigned cvtpk(float lo, float hi) { unsigned r; asm volatile("v_cvt_pk_bf16_f32 %0, %1, %2" : "=v"(r) : "v"(lo), "v"(hi)); return r; }
__device__ __forceinline__ bf16x8 load8(const bf16* p) { return *reinterpret_cast<const bf16x8*>(p); }
__device__ __forceinline__ void mask_tile(f32x16& p0, f32x16& p1, int dq, unsigned W) {
    const float NEG = -__builtin_inff();
#pragma unroll
    for (int r = 0; r < 16; ++r) {
        const int c = (r & 3) + 8 * (r >> 2);
        if ((unsigned)(dq - c) >= W) p0[r] = NEG;
        if ((unsigned)(dq - c - 32) >= W) p1[r] = NEG;
    }
}
__device__ __forceinline__ void partialSM(f32x16& p0, f32x16& p1, float& m_reg, float& mn, float& alpha) {
    float pmax = p0[0]; for (int r = 1; r < 16; ++r) pmax = fmaxf(pmax, p0[r]); for (int r = 0; r < 16; ++r) pmax = fmaxf(pmax, p1[r]);
    { auto rr = __builtin_amdgcn_permlane32_swap(__float_as_uint(pmax), __float_as_uint(pmax), false, false);
      pmax = fmaxf(__uint_as_float(rr[0]), __uint_as_float(rr[1])); }
    if (__builtin_expect(__all((pmax - m_reg) <= THR), 1)) { mn = m_reg; alpha = 1.f; }
    else { mn = fmaxf(m_reg, pmax); alpha = __builtin_amdgcn_exp2f(m_reg - mn); m_reg = mn; }
    for (int r = 0; r < 16; ++r) p0[r] = p0[r] - mn; for (int r = 0; r < 16; ++r) p1[r] = p1[r] - mn;
    for (int r = 0; r < 16; ++r) p0[r] = __builtin_amdgcn_exp2f(p0[r]);
}
__device__ __forceinline__ void finishSM(f32x16& p0, f32x16& p1, float alpha, float& l_reg, bf16x8& pa0, bf16x8& pa1, bf16x8& pa2, bf16x8& pa3) {
    for (int r = 0; r < 16; ++r) p1[r] = __builtin_amdgcn_exp2f(p1[r]);
    float ps = 0; for (int r = 0; r < 16; ++r) ps += p0[r]; for (int r = 0; r < 16; ++r) ps += p1[r];
    { auto rr = __builtin_amdgcn_permlane32_swap(__float_as_uint(ps), __float_as_uint(ps), false, false);
      ps = __uint_as_float(rr[0]) + __uint_as_float(rr[1]); }
    l_reg = l_reg * alpha + ps;
#define PK4(P, B_, OUT) do { unsigned a0 = cvtpk(P[B_+0], P[B_+1]), a1 = cvtpk(P[B_+2], P[B_+3]);                          \
        unsigned b0 = cvtpk(P[B_+4], P[B_+5]), b1 = cvtpk(P[B_+6], P[B_+7]);                                             \
        auto r0 = __builtin_amdgcn_permlane32_swap(a0, b0, false, false); auto r1 = __builtin_amdgcn_permlane32_swap(a1, b1, false, false); \
        u32x4 w = {r0[0], r1[0], r0[1], r1[1]}; OUT = *reinterpret_cast<bf16x8*>(&w); } while (0)
    PK4(p0, 0, pa0); PK4(p0, 8, pa1); PK4(p1, 0, pa2); PK4(p1, 8, pa3);
#undef PK4
}
template <int KB, bool EXT>
__device__ __forceinline__ void qkt(f32x16& p0, f32x16& p1, const char* K_lds, const char* X_lds, int r32, int hi, const bf16x8* qr, const char* qxl) {
    p0 = f32x16{}; p1 = f32x16{};
    const char* kb[4];
#pragma unroll
    for (int dd = 0; dd < 4; ++dd) kb[dd] = K_lds + KB * SHM_K + KSWZ(r32, (dd * 16 + hi * 8) * 2);
#pragma unroll
    for (int d0 = 0; d0 < 8; ++d0) { const char* a = kb[d0 & 3] + (d0 >> 2) * 128;
        bf16x8 b0 = *reinterpret_cast<const bf16x8*>(a);
        bf16x8 b1 = *reinterpret_cast<const bf16x8*>(a + 32 * 256);
        bf16x8 qf; if (EXT && d0 >= 8 - QL) qf = *reinterpret_cast<const bf16x8*>(qxl + (4 + d0 - (8 - QL)) * 1024); else qf = qr[d0];
        p0 = __builtin_amdgcn_mfma_f32_32x32x16_bf16(b0, qf, p0, 0, 0, 0);
        p1 = __builtin_amdgcn_mfma_f32_32x32x16_bf16(b1, qf, p1, 0, 0, 0); }
    if constexpr (EXT) { const char* xb = X_lds + KB * SHM_X + r32 * XROW + hi * 16;
#pragma unroll
        for (int dd = 0; dd < 4; ++dd) {
            bf16x8 b0 = *reinterpret_cast<const bf16x8*>(xb + dd * 32);
            bf16x8 b1 = *reinterpret_cast<const bf16x8*>(xb + dd * 32 + 32 * XROW);
            const bf16x8 qf = *reinterpret_cast<const bf16x8*>(qxl + dd * 1024);
            p0 = __builtin_amdgcn_mfma_f32_32x32x16_bf16(b0, qf, p0, 0, 0, 0);
            p1 = __builtin_amdgcn_mfma_f32_32x32x16_bf16(b1, qf, p1, 0, 0, 0); } }
}
template <int VB>
__device__ __forceinline__ void pv_tile(f32x16* o, int vb0, bf16x8 pa0, bf16x8 pa1, bf16x8 pa2, bf16x8 pa3) {
#define TRRD(dst, off) asm volatile("ds_read_b64_tr_b16 %0, %1 offset:%2" : "=&v"(dst) : "v"(vb0), "i"(off) : "memory")
#define PV_D0(d0) do { s16x4 l0, l1, l2, l3, h0, h1, h2, h3; constexpr int b_ = VB * SHM_V + v_rd_off(d0, 0, 0);     \
        TRRD(l0, b_); TRRD(h0, b_ + 2048); TRRD(l1, b_ + 4096); TRRD(h1, b_ + 6144); TRRD(l2, b_ + 8192); TRRD(h2, b_ + 10240); TRRD(l3, b_ + 12288); TRRD(h3, b_ + 14336); \
        asm volatile("s_waitcnt lgkmcnt(0)" ::: "memory"); SBAR();   \
        o[d0] = __builtin_amdgcn_mfma_f32_32x32x16_bf16(pa0, (bf16x8){l0[0], l0[1], l0[2], l0[3], h0[0], h0[1], h0[2], h0[3]}, o[d0], 0, 0, 0);   \
        o[d0] = __builtin_amdgcn_mfma_f32_32x32x16_bf16(pa1, (bf16x8){l1[0], l1[1], l1[2], l1[3], h1[0], h1[1], h1[2], h1[3]}, o[d0], 0, 0, 0);   \
        o[d0] = __builtin_amdgcn_mfma_f32_32x32x16_bf16(pa2, (bf16x8){l2[0], l2[1], l2[2], l2[3], h2[0], h2[1], h2[2], h2[3]}, o[d0], 0, 0, 0);   \
        o[d0] = __builtin_amdgcn_mfma_f32_32x32x16_bf16(pa3, (bf16x8){l3[0], l3[1], l3[2], l3[3], h3[0], h3[1], h3[2], h3[3]}, o[d0], 0, 0, 0); } while (0)
    PV_D0(0); PV_D0(1); PV_D0(2); PV_D0(3);
#undef PV_D0
#undef TRRD
}

struct BlockRef { const bf16* Q; const bf16* K; const bf16* V; const bf16* QX; const bf16* KX; bf16* O; const float* G; int P0; int jlo; };
template <bool EXT> struct Seam { bf16x8 qr[8]; bf16x8 st_v0, st_v1, st_k0, st_k1, st_x; };
__device__ __forceinline__ int swa_jlo(int P0, int W) { const int lowk = P0 - W + 1; return lowk > 0 ? lowk / KVBLK : 0; }
#define VMW() asm volatile("s_waitcnt vmcnt(0)" ::: "memory")
#define VMWN(n) asm volatile("s_waitcnt vmcnt(%0)" :: "i"(n) : "memory")
#define SLOAD_H(R, k0) do { S.st_v0 = load8((R).V + (size_t)((k0) + sr) * D + sc); S.st_v1 = load8((R).V + (size_t)((k0) + 32 + sr) * D + sc);              \
                            S.st_k0 = load8((R).K + (size_t)((k0) + sr) * D + sc); S.st_k1 = load8((R).K + (size_t)((k0) + 32 + sr) * D + sc);              \
                            if constexpr (EXT) S.st_x = load8((R).KX + (size_t)((k0) + xr) * 64 + xc * 8); } while (0)
#define SWRITE_HK(bf) do { *(bf16x8*)(K_lds + (bf) * SHM_K + kws) = S.st_k0; *(bf16x8*)(K_lds + (bf) * SHM_K + kws + 32 * 256) = S.st_k1; \
                           if constexpr (EXT) *(bf16x8*)(X_lds + (bf) * SHM_X + xws) = S.st_x; } while (0)
#define SWRITE_HV(bf) do { *(bf16x8*)(V_lds + (bf) * SHM_V + vst0) = S.st_v0; *(bf16x8*)(V_lds + (bf) * SHM_V + vst1) = S.st_v1; } while (0)
#define SWRITE_H(bf) do { SWRITE_HV(bf); SWRITE_HK(bf); } while (0)
#define LDS3 __attribute__((address_space(3)))
#define QLOADS(R) do { const bf16* qrow_ = (R).Q + (size_t)(wid * QBLK + r32) * D + hi * 8; \
        if constexpr (EXT) { _Pragma("unroll") for (int d0 = 0; d0 < 8 - QL; ++d0) S.qr[d0] = load8(qrow_ + d0 * 16); \
            const bf16* qxrow_ = (R).QX + (size_t)(wid * QBLK + r32) * 64 + hi * 8; \
            _Pragma("unroll") for (int dd = 0; dd < 4; ++dd) __builtin_amdgcn_global_load_lds((const unsigned*)(qxrow_ + dd * 16), (LDS3 unsigned*)(qxw + dd * 1024), 16, 0, 0); \
            _Pragma("unroll") for (int d0 = 8 - QL; d0 < 8; ++d0) __builtin_amdgcn_global_load_lds((const unsigned*)(qrow_ + d0 * 16), (LDS3 unsigned*)(qxw + (4 + d0 - (8 - QL)) * 1024), 16, 0, 0); } \
        else { _Pragma("unroll") for (int d0 = 0; d0 < 8; ++d0) S.qr[d0] = load8(qrow_ + d0 * 16); } } while (0)
template <bool EXT>
__device__ __forceinline__ void attn_prime(const BlockRef& cur, int W, char* lds, Seam<EXT>& S, int tid_in) {
    int tid_ = tid_in; asm volatile("" : "+v"(tid_));
    const int tid = tid_, wid = __builtin_amdgcn_readfirstlane(tid >> 6), lane = tid & 63, r32 = lane & 31, hi = lane >> 5;
    const int sr = tid >> 4, sc = (tid & 15) * 8, kws = KSWZ(sr, sc * 2), xr = tid >> 3, xc = tid & 7, xws = xr * XROW + xc * 16;
    char* K_lds = lds + OFF_K; char* X_lds = lds + OFF_X; char* qxw = lds + OFF_QX + wid * QXW;
    const int kb0 = cur.jlo * KVBLK;
    QLOADS(cur);
    SLOAD_H(cur, kb0); VMW(); SWRITE_HK(0);
    __syncthreads();
}
template <bool EXT, bool NORM, int LDO>
__device__ __forceinline__ void attn_block(const BlockRef& cur, const BlockRef& nxt, int skv, int W, char* lds, Seam<EXT>& S, int tid_in) {
    int tid_ = tid_in; asm volatile("" : "+v"(tid_));
    const int tid = tid_, wid = __builtin_amdgcn_readfirstlane(tid >> 6), lane = tid & 63, r32 = lane & 31, hi = lane >> 5;
    const int j_lo = cur.jlo;
    int j_hi = (cur.P0 + QB - 1) / KVBLK + 1; if (j_hi > skv / KVBLK) j_hi = skv / KVBLK;
    const int NT = j_hi - j_lo;
    const int kbn = nxt.jlo * KVBLK;
    const int qlo = cur.P0 + wid * QBLK, qm = qlo + r32 - 4 * hi;
    char* V_lds = lds + OFF_V; char* K_lds = lds + OFF_K; char* X_lds = lds + OFF_X;
    float* ws = (float*)(lds + OFF_WS) + wid * 64; float* li_l = ws, * al_l = ws + 32;
    char* qxw = lds + OFF_QX + wid * QXW; char* qxl = qxw + lane * 16;
    float m_reg = -1e30f, l_reg = 0; f32x16 o[4] = {};
    const int sr = tid >> 4, sc = (tid & 15) * 8, vst0 = v_st(sr, sc), vst1 = v_st(32 + sr, sc), kws = KSWZ(sr, sc * 2), xr = tid >> 3, xc = tid & 7, xws = xr * XROW + xc * 16;
    const int vb0 = (int)(uintptr_t)V_lds + v_rd_base(lane);
#define RESC(a) do { if (__any((a) < 1.f)) { if (hi == 0) al_l[r32] = (a); asm volatile("s_waitcnt lgkmcnt(0)" ::: "memory");              \
                     for (int d_ = 0; d_ < 4; ++d_) for (int r = 0; r < 16; ++r) o[d_][r] *= al_l[crow(r, hi)]; } } while (0)
#define KBASE(t) ((j_lo + (t)) * KVBLK)
#define MASKT(P0_, P1_, t) do { const int kb_ = KBASE(t); if (kb_ + KVBLK - 1 > qlo || kb_ <= qlo + QBLK - 1 - W) mask_tile(P0_, P1_, qm - kb_, (unsigned)W); } while (0)
    constexpr int NQL = EXT ? 12 : 8;
#define SEAM_K0() do { VMWN(NQL); SWRITE_HK(0); SBAR(); } while (0)
    f32x16 pA0, pA1, pB0, pB1; float mnA, mnB, alA, alB; bf16x8 pa0, pa1, pa2, pa3;
    SWRITE_HV(0); SBAR();
    if constexpr (EXT) { VMW(); SBAR(); }
    if (NT > 1) { SLOAD_H(cur, KBASE(1)); }
    SBAR(); qkt<0, EXT>(pA0, pA1, K_lds, X_lds, r32, hi, S.qr, qxl);
    MASKT(pA0, pA1, 0); partialSM(pA0, pA1, m_reg, mnA, alA);
    if (NT > 1) { VMW(); SWRITE_H(1); }
    __syncthreads();
#define HALF_STEP(PX0, PX1, mnX, alX, PY0, PY1, alY, t, KB, VB, SB) do {                                                      \
        SBAR(); qkt<KB, EXT>(PX0, PX1, K_lds, X_lds, r32, hi, S.qr, qxl);                                                     \
        finishSM(PY0, PY1, alY, l_reg, pa0, pa1, pa2, pa3); SBAR();                                                           \
        if ((t) + 1 < NT) { SLOAD_H(cur, KBASE((t) + 1)); SBAR(); }                                                           \
        pv_tile<VB>(o, vb0, pa0, pa1, pa2, pa3); MASKT(PX0, PX1, (t)); partialSM(PX0, PX1, m_reg, mnX, alX);                  \
        __syncthreads();                                                                                                      \
        if ((t) + 1 < NT) { VMW(); SWRITE_H(SB); }                                                                            \
        RESC(alX); __syncthreads(); } while (0)
    for (int t = 1; t + 1 < NT; t += 2) {
        HALF_STEP(pB0, pB1, mnB, alB, pA0, pA1, alA, t, 1, 0, 0);
        HALF_STEP(pA0, pA1, mnA, alA, pB0, pB1, alB, t + 1, 0, 1, 1);
    }
    const bool even = (NT & 1) == 0;
    if (even) { SBAR(); qkt<1, EXT>(pB0, pB1, K_lds, X_lds, r32, hi, S.qr, qxl); SBAR(); }
    SLOAD_H(nxt, kbn); SBAR();
    QLOADS(nxt);
    SBAR();
    finishSM(pA0, pA1, alA, l_reg, pa0, pa1, pa2, pa3); SBAR();
    pv_tile<0>(o, vb0, pa0, pa1, pa2, pa3);
    if (even) { MASKT(pB0, pB1, NT - 1); partialSM(pB0, pB1, m_reg, mnB, alB); __syncthreads(); RESC(alB);
        finishSM(pB0, pB1, alB, l_reg, pa0, pa1, pa2, pa3); SBAR(); pv_tile<1>(o, vb0, pa0, pa1, pa2, pa3); }
    SBAR(); SEAM_K0();
    if (hi == 0) li_l[r32] = l_reg; asm volatile("s_waitcnt lgkmcnt(0)" ::: "memory");
    float rli[16];
#pragma unroll
    for (int r = 0; r < 16; ++r) rli[r] = __builtin_amdgcn_rcpf(li_l[crow(r, hi)]);
    if constexpr (NORM) {
        float g4[4];
#pragma unroll
        for (int d0 = 0; d0 < 4; ++d0) g4[d0] = cur.G[d0 * 32 + r32];
#pragma unroll
        for (int r = 0; r < 16; ++r) { float ss = 0.f;
#pragma unroll
            for (int d0 = 0; d0 < 4; ++d0) { o[d0][r] *= rli[r]; ss += o[d0][r] * o[d0][r]; }
            ss += __shfl_xor(ss, 1); ss += __shfl_xor(ss, 2); ss += __shfl_xor(ss, 4); ss += __shfl_xor(ss, 8); ss += __shfl_xor(ss, 16);
            rli[r] = __builtin_amdgcn_rsqf(ss * (1.0f / 128.0f) + RMS_EPS); }
#pragma unroll
        for (int r = 0; r < 16; ++r)
#pragma unroll
            for (int d0 = 0; d0 < 4; ++d0) o[d0][r] *= rli[r] * g4[d0];
    } else {
#pragma unroll
        for (int r = 0; r < 16; ++r)
#pragma unroll
            for (int d0 = 0; d0 < 4; ++d0) o[d0][r] *= rli[r];
    }
    bf16* Ow = cur.O + (size_t)(wid * QBLK) * LDO;
#pragma unroll
    for (int r = 0; r < 16; ++r) { const int orow = crow(r, hi);
#pragma unroll
        for (int d0 = 0; d0 < 4; ++d0) { const float v = o[d0][r];
            const float vn = __shfl_xor(v, 1);
            if ((r32 & 1) == 0) *(unsigned*)(Ow + (size_t)orow * LDO + d0 * 32 + r32) = cvtpk(v, vn); } }
    __syncthreads();
#undef RESC
#undef KBASE
#undef MASKT
#undef SEAM_K0
#undef HALF_STEP
}
#undef VMW
#undef VMWN
#undef SLOAD_H
#undef SWRITE_HK
#undef SWRITE_HV
#undef SWRITE_H
#undef QLOADS
#undef LDS3
#undef KSWZ
}
constexpr int NWAVES = 8;
constexpr int BATCH = 2, SEQ = 8192, DM = 4096, DEPTH = 4, M = BATCH * SEQ;
constexpr int IN_COLS = 8520, NIN = 8704, DFF = 16384, MEMT = 256;
constexpr float EPS = 1e-6f;
constexpr float LOG2E = 1.4426950408889634f;
constexpr float QSCALE_MLA = 0.07216878364870323f * LOG2E;
constexpr float QSCALE_128 = 0.08838834764831845f * LOG2E;

constexpr size_t MiB = 1u << 20;
constexpr size_t WS_CTL = 0, CTL_ZERO_BYTES = 1 * MiB;
constexpr size_t WS_ROPE = 1 * MiB;
constexpr size_t WS_LB = 5 * MiB;
constexpr size_t WS_FOXLF = 5 * MiB + 512 * 1024;
constexpr size_t WS_ADEC = 6 * MiB;
constexpr size_t WS_FOXC = 7 * MiB;
constexpr size_t WS_FOXQM = 7 * MiB + 512 * 1024;
constexpr size_t WS_FOXKM = 7 * MiB + 516 * 1024;
constexpr size_t WS_RQ = 7 * MiB + 640 * 1024, WS_RKV = 7 * MiB + 704 * 1024;
constexpr size_t WS_CSS = 28 * MiB;
constexpr size_t WS_MEMN = 8 * MiB;
constexpr size_t WS_KVMEM = 24 * MiB;
constexpr size_t WS_W = 32 * MiB, W_LAYER = 384 * MiB;
constexpr size_t W_IN = 0, W_UQ = 68 * MiB, W_UKV = 73 * MiB, W_O = 77 * MiB, W_MQ = 109 * MiB, W_MKV = 113 * MiB, W_MO = 121 * MiB, W_FF1 = 125 * MiB, W_FF2 = 253 * MiB;
constexpr size_t WS_HN = 1568 * MiB;
constexpr size_t WS_Y = 1696 * MiB;
constexpr size_t WS_YSS = 1824 * MiB;
constexpr size_t WS_HSS = 1828 * MiB;
constexpr size_t WS_QMEM = 1952 * MiB, WS_OMEM = 1968 * MiB;
constexpr size_t WS_MIXER = 1984 * MiB;
constexpr size_t WS_PROJ = WS_MIXER  , WS_FOX = WS_MIXER + 128 * MiB  , WS_LOGF = WS_MIXER + 224 * MiB, WS_PROJX = WS_MIXER + 288 * MiB  , WS_GP = WS_MIXER + 304 * MiB  , WS_CQN = WS_MIXER + 384 * MiB, WS_CKVN = WS_MIXER + 408 * MiB,
                 WS_KROT = WS_MIXER + 424 * MiB, WS_QN = WS_MIXER + 426 * MiB, WS_QR = WS_MIXER + 490 * MiB, WS_KN = WS_MIXER + 522 * MiB, WS_VC = WS_MIXER + 586 * MiB, WS_LT = WS_MIXER + 650 * MiB,
                 WS_ST = WS_MIXER + 778 * MiB, WS_MIX = WS_MIXER + 842 * MiB, WS_QEXT = WS_MIXER + 970 * MiB, WS_KEXT = WS_MIXER + 986 * MiB, WS_MIXER_END = WS_MIXER + 1002 * MiB;
constexpr size_t WS_HID = WS_MIXER;
constexpr size_t WS_END = WS_MIXER_END;
static_assert(WS_HID + 512 * MiB <= WS_MIX, "hidden overlay must not reach MIX/QEXT/KEXT");
constexpr int CW_BAR = 4096, CW_Q = 8192;

constexpr int RING_BYTES = 159744;
constexpr int LDSCTL_OFF = RING_BYTES, MISC_OFF = LDSCTL_OFF + 320;
constexpr int LDS_BYTES = 160256;
static_assert(MISC_OFF + 128 <= LDS_BYTES && att::ATT_LDS_BYTES <= RING_BYTES, "LDS map");

#define GAS __attribute__((address_space(1)))
#define LAS __attribute__((address_space(3)))
typedef unsigned short bf16;
typedef unsigned v4u __attribute__((ext_vector_type(4)));
typedef unsigned v2u __attribute__((ext_vector_type(2)));
typedef float f32x4 __attribute__((ext_vector_type(4)));
typedef float f32x2 __attribute__((ext_vector_type(2)));
typedef float f32x16 __attribute__((ext_vector_type(16)));
typedef short bf16x8 __attribute__((ext_vector_type(8)));
typedef GAS unsigned gu32;
#define RLX_AGENT __ATOMIC_RELAXED, __HIP_MEMORY_SCOPE_AGENT
#define LDS_WAIT() asm volatile("s_waitcnt lgkmcnt(0)" ::: "memory")
#define VM_WAIT() asm volatile("s_waitcnt vmcnt(0)" ::: "memory")
__device__ __forceinline__ unsigned f2bf(float f) { unsigned u = __builtin_bit_cast(unsigned, f); return (u + 0x7fffu + ((u >> 16) & 1u)) >> 16; }
__device__ __forceinline__ unsigned pk2(float lo, float hi) { return f2bf(lo) | (f2bf(hi) << 16); }
__device__ __forceinline__ float bf2f(unsigned short b) { return __builtin_bit_cast(float, ((unsigned)b) << 16); }
__device__ __forceinline__ float bflo(unsigned w) { return __builtin_bit_cast(float, w << 16); }
__device__ __forceinline__ float bfhi(unsigned w) { return __builtin_bit_cast(float, w & 0xffff0000u); }

#define XB_TMO      128
#define XB_XCNT(j)  (256  + 64 * (j))
#define XB_XSUB(j)  (1280 + 64 * (j))
#define XB_XGEN(j)  (2304 + 64 * (j))
#define XB_TOP      3328
#define XB_TOPGEN   3392
#define XCD_BAR_WORDS 3456
#define XB_SPIN_CAP (1u << 22)
__device__ __forceinline__ unsigned xb_ld(unsigned* p)              { return __hip_atomic_load(p, __ATOMIC_RELAXED, __HIP_MEMORY_SCOPE_AGENT); }
__device__ __forceinline__ unsigned xb_add(unsigned* p, unsigned v) { return __hip_atomic_fetch_add(p, v, __ATOMIC_RELAXED, __HIP_MEMORY_SCOPE_AGENT); }
__device__ __forceinline__ unsigned xb_xcc_id() { return (unsigned)__builtin_amdgcn_s_getreg((3 << 11) | 20) & 0xFu; }
#define XB_SPIN(cond, bar) do { unsigned _sp = 0; while (cond) { __builtin_amdgcn_s_sleep(1); \
    if ((++_sp & 255u) == 0u) { if (xb_ld(&(bar)[XB_TMO])) break; if (_sp > XB_SPIN_CAP) { atomicAdd(&(bar)[XB_TMO], 1u); break; } } } } while (0)
struct XcdBarrier { unsigned* bar; unsigned x; volatile LAS unsigned* st; };
__device__ __forceinline__ XcdBarrier xcd_barrier_post(unsigned* bar, volatile LAS unsigned* st) {
    XcdBarrier b; b.bar = bar; b.x = xb_xcc_id(); b.st = st;
    if (threadIdx.x == 0) (void)xb_add(&bar[XB_XCNT(b.x)], 1u);
    return b;
}
__device__ __forceinline__ void xcd_barrier_complete(unsigned* bar, unsigned x, unsigned& nloc, unsigned& nx) {
    const unsigned G = gridDim.x * gridDim.y * gridDim.z;
    unsigned sum, cnt, mine, sp = 0u;
    for (;;) {
        sum = 0u; cnt = 0u; mine = 0u;
#pragma unroll
        for (unsigned j = 0; j < 16; ++j) { const unsigned c = xb_ld(&bar[XB_XCNT(j)]); sum += c; cnt += (c > 0u) ? 1u : 0u; mine = (j == x) ? c : mine; }
        if (sum == G) break;
        __builtin_amdgcn_s_sleep(1);
        if ((++sp & 255u) == 0u) { if (xb_ld(&bar[XB_TMO])) break; if (sp > XB_SPIN_CAP) { atomicAdd(&bar[XB_TMO], 1u); break; } }
    }
    nloc = mine > 0u ? mine : 1u; nx = cnt > 0u ? cnt : 1u;
}
__device__ __forceinline__ void xcd_barrier(const XcdBarrier& b, bool leader  ) {
    asm volatile("s_waitcnt vmcnt(0)" ::: "memory");
    __syncthreads();
    if (leader) {
        unsigned* bar = b.bar; unsigned bx_ = b.x; asm volatile("" : "+s"(bar), "+s"(bx_));
        __builtin_amdgcn_s_waitcnt(0);
        unsigned nloc = b.st[0], nx = b.st[1];
        if (nloc == 0u) { xcd_barrier_complete(bar, bx_, nloc, nx); b.st[0] = nloc; b.st[1] = nx; }
        const unsigned old = xb_add(&bar[XB_XSUB(bx_)], 1u);
        const unsigned gen = old / nloc;
        if (old + 1u == (gen + 1u) * nloc) {
            __builtin_amdgcn_fence(__ATOMIC_RELEASE, "agent");
            asm volatile("s_waitcnt vmcnt(0)" ::: "memory");
            const unsigned og = xb_add(&bar[XB_TOP], 1u);
            const unsigned tg = og / nx;
            if (og + 1u == (tg + 1u) * nx) xb_add(&bar[XB_TOPGEN], 1u);
            else XB_SPIN(xb_ld(&bar[XB_TOPGEN]) == tg, bar);
            __builtin_amdgcn_fence(__ATOMIC_ACQUIRE, "agent");
            xb_add(&bar[XB_XGEN(bx_)], 1u);
            asm volatile("s_waitcnt vmcnt(0)" ::: "memory");
        } else {
            XB_SPIN(xb_ld(&bar[XB_XGEN(bx_)]) == gen, bar);
            __builtin_amdgcn_fence(__ATOMIC_ACQUIRE, "agent");
            asm volatile("s_waitcnt vmcnt(0)" ::: "memory");
        }
    }
    __syncthreads();
}

struct Frame {
    LAS unsigned char* lds; char* ldsg;
    volatile LAS unsigned* MISC;
    int tid, lane, wave;
    int vcu, G, bx;
};
__device__ __forceinline__ int fresh_tid(int wave) { int ln_; asm volatile("v_mbcnt_lo_u32_b32 %0, -1, 0\n\tv_mbcnt_hi_u32_b32 %0, -1, %0" : "=v"(ln_)); return wave * 64 + ln_; }
__device__ __forceinline__ float wave_sum(float v) {
#pragma unroll
    for (int o = 1; o < 64; o <<= 1) v += __shfl_xor(v, o);
    return v;
}

template <int MAP> __device__ __forceinline__ int old_col(int n) {
    if (MAP == 0) return n;
    if (MAP == 1) { if (n < 3584) return n; if (n < 6656) return n + 512; if (n < 8000) return n + 520; if (n < 8008) return n - 8000 + 7168; if (n < 8192) return -1; return n - 4608; }
    if (n < 2048) return (n >> 7) * 192 + (n & 127);
    { const int e = n - 2048, h = e >> 6, w = e & 63, i = w >> 1, p = w & 1; return h * 192 + 128 + i + 32 * p; }
}
template <int MAP> __device__ __forceinline__ f32x4 load4_cols(const float* rowp, int n) {
    if (MAP == 0) return __builtin_nontemporal_load((const GAS f32x4*)(rowp + n));
    if (MAP == 1) { const int oc = old_col<1>(n); if (oc >= 0) return __builtin_nontemporal_load((const GAS f32x4*)(rowp + oc)); return (f32x4){0.f, 0.f, 0.f, 0.f}; }
    if (n < 2048) return __builtin_nontemporal_load((const GAS f32x4*)(rowp + (n >> 7) * 192 + (n & 127)));
    { const int e = n - 2048, h = e >> 6, i = (e & 63) >> 1; const float* p = rowp + h * 192 + 128 + i;
      const f32x2 a = *(const GAS f32x2*)p, b = *(const GAS f32x2*)(p + 32); return (f32x4){a.x, b.x, a.y, b.y}; }
}
struct CvPend { bf16* wt; int K, sk; };
template <int CV_SK>
__device__ __forceinline__ void cv_flush_sk(LAS unsigned char* T, int tid, bf16* wt, int K) {
    constexpr int SN = 8 / CV_SK, PITCH = 128 * CV_SK + 16, ROWS = 64 * SN, PPR = 8 * CV_SK  ;
    v4u o[(ROWS * PPR) / 512];
#pragma unroll
    for (int j = 0; j < (ROWS * PPR) / 512; ++j) { const int p = j * 512 + tid, row = p / PPR, pc = p % PPR; o[j] = *(const LAS v4u*)(T + row * PITCH + pc * 16); }
#pragma unroll
    for (int j = 0; j < (ROWS * PPR) / 512; ++j) { const int p = j * 512 + tid, row = p / PPR, pc = p % PPR; __builtin_nontemporal_store(o[j], (GAS v4u*)(wt + (size_t)row * K + pc * 8)); }
}
__device__ __forceinline__ void cv_flush(LAS unsigned char* T, int tid, CvPend& pend) {
    if (pend.sk == 8) cv_flush_sk<8>(T, tid, pend.wt, pend.K); else if (pend.sk == 4) cv_flush_sk<4>(T, tid, pend.wt, pend.K);
    pend.sk = 0;
    LDS_WAIT(); __syncthreads();
}
template <int MAP, int CV_SK>
__device__ __forceinline__ void p0_transpose_item(CvPend& pend, LAS unsigned char* T, int tid, const float* W, int K, int N, bf16* WT, int row_off, int nblk, int item, int lane, const float* gk = nullptr  ) {
    constexpr int SN = 8 / CV_SK; const int g_ = item >> 3, sub = item & 7, nbg = nblk / SN, kband = g_ / nbg, nbq = g_ - kband * nbg;
    const int kb = kband * CV_SK + sub / SN, nb = nbq * SN + sub % SN, k0 = 64 * kb, n0 = 64 * nb, c = lane & 7, kq = lane >> 3;
    f32x4 v[2][8];
    if constexpr (MAP == 2) {
        if (__builtin_amdgcn_readfirstlane(n0) < 2048) {
#pragma unroll
            for (int hh = 0; hh < 2; ++hh)
#pragma unroll
                for (int i = 0; i < 8; ++i) { const int n = n0 + 32 * hh + 4 * c; v[hh][i] = __builtin_nontemporal_load((const GAS f32x4*)(W + (size_t)(k0 + 8 * kq + i) * N + (n >> 7) * 192 + (n & 127))); }
        } else {
            f32x2 a[2][8], b[2][8];
#pragma unroll
            for (int hh = 0; hh < 2; ++hh)
#pragma unroll
                for (int i = 0; i < 8; ++i) { const int e = n0 + 32 * hh + 4 * c - 2048, h = e >> 6, ii = (e & 63) >> 1; const float* p = W + (size_t)(k0 + 8 * kq + i) * N + h * 192 + 128 + ii;
                    a[hh][i] = *(const GAS f32x2*)p; b[hh][i] = *(const GAS f32x2*)(p + 32); }
#pragma unroll
            for (int hh = 0; hh < 2; ++hh)
#pragma unroll
                for (int i = 0; i < 8; ++i) v[hh][i] = (f32x4){a[hh][i].x, b[hh][i].x, a[hh][i].y, b[hh][i].y};
        }
    } else {
#pragma unroll
    for (int hh = 0; hh < 2; ++hh)
#pragma unroll
        for (int i = 0; i < 8; ++i) v[hh][i] = load4_cols<MAP>(W + (size_t)(k0 + 8 * kq + i) * N, n0 + 32 * hh + 4 * c);
    }
    cv_flush(T, tid, pend);
    if (gk) { const f32x4 g0 = *(const GAS f32x4*)(gk + k0 + 8 * kq), g1 = *(const GAS f32x4*)(gk + k0 + 8 * kq + 4);
#pragma unroll
        for (int hh = 0; hh < 2; ++hh) { v[hh][0] = v[hh][0] * g0[0]; v[hh][1] = v[hh][1] * g0[1]; v[hh][2] = v[hh][2] * g0[2]; v[hh][3] = v[hh][3] * g0[3];
            v[hh][4] = v[hh][4] * g1[0]; v[hh][5] = v[hh][5] * g1[1]; v[hh][6] = v[hh][6] * g1[2]; v[hh][7] = v[hh][7] * g1[3]; } }
    constexpr int PITCH = 128 * CV_SK + 16;
    { LAS unsigned char* tw = T + ((sub % SN) * 64 + 4 * c) * PITCH + ((sub / SN) * 64 + 8 * kq) * 2;
#pragma unroll
      for (int hh = 0; hh < 2; ++hh)
#pragma unroll
        for (int nn = 0; nn < 4; ++nn) { v4u o; o.x = pk2(v[hh][0][nn], v[hh][1][nn]); o.y = pk2(v[hh][2][nn], v[hh][3][nn]); o.z = pk2(v[hh][4][nn], v[hh][5][nn]); o.w = pk2(v[hh][6][nn], v[hh][7][nn]);
            *(LAS v4u*)(tw + (32 * hh + nn) * PITCH) = o; } }
    LDS_WAIT(); __syncthreads();
    pend.wt = WT + (size_t)(row_off + 64 * SN * nbq) * K + 64 * CV_SK * kband; pend.K = K; pend.sk = CV_SK;
}
__device__ __forceinline__ v4u pack8f(const f32x4& a, const f32x4& b) { v4u w; w.x = pk2(a.x, a.y); w.y = pk2(a.z, a.w); w.z = pk2(b.x, b.y); w.w = pk2(b.z, b.w); return w; }
template <bool FULL>
__device__ __forceinline__ void norm_first(int lane, const float* x, const float* g, bf16* a, float* hss) {
    f32x4 v[8][2]; float ss = 0.f;
#pragma unroll
    for (int j = 0; j < 8; ++j) { v[j][0] = *((const GAS f32x4*)x + 2 * lane + 128 * j); v[j][1] = *((const GAS f32x4*)x + 2 * lane + 128 * j + 1);
        ss += (v[j][0].x * v[j][0].x + v[j][0].y * v[j][0].y) + (v[j][0].z * v[j][0].z + v[j][0].w * v[j][0].w) + (v[j][1].x * v[j][1].x + v[j][1].y * v[j][1].y) + (v[j][1].z * v[j][1].z + v[j][1].w * v[j][1].w); }
    const float rstd = __builtin_amdgcn_rsqf(wave_sum(ss) * (1.f / DM) + EPS);
#pragma unroll
    for (int j = 0; j < 8; ++j) {
        if constexpr (FULL) { const f32x4 g0 = *((const GAS f32x4*)g + 2 * lane + 128 * j), g1 = *((const GAS f32x4*)g + 2 * lane + 128 * j + 1);
            *((GAS v4u*)a + lane + 64 * j) = pack8f(v[j][0] * g0 * rstd, v[j][1] * g1 * rstd); }
        else *((GAS v4u*)a + lane + 64 * j) = pack8f(v[j][0], v[j][1]); }
    if (!FULL && lane == 0) *hss = rstd;
}
__device__ __forceinline__ void norm_first_rows(int lane, int first, int stride, int nrows, const float* x, bf16* a, float* hss) {
    if (first >= nrows) return;
    f32x4 v[8][2];
#pragma unroll
    for (int j = 0; j < 8; ++j) { v[j][0] = *((const GAS f32x4*)(x + (size_t)first * DM) + 2 * lane + 128 * j); v[j][1] = *((const GAS f32x4*)(x + (size_t)first * DM) + 2 * lane + 128 * j + 1); }
    for (int m = first; m < nrows; m += stride) {
        v4u o[8]; float ss = 0.f;
#pragma unroll
        for (int j = 0; j < 8; ++j) {
            ss += (v[j][0].x * v[j][0].x + v[j][0].y * v[j][0].y) + (v[j][0].z * v[j][0].z + v[j][0].w * v[j][0].w) + (v[j][1].x * v[j][1].x + v[j][1].y * v[j][1].y) + (v[j][1].z * v[j][1].z + v[j][1].w * v[j][1].w);
            o[j] = pack8f(v[j][0], v[j][1]); }
        const int mn = m + stride;
        if (mn < nrows) {
#pragma unroll
            for (int j = 0; j < 8; ++j) { v[j][0] = *((const GAS f32x4*)(x + (size_t)mn * DM) + 2 * lane + 128 * j); v[j][1] = *((const GAS f32x4*)(x + (size_t)mn * DM) + 2 * lane + 128 * j + 1); } }
#pragma unroll
        for (int j = 0; j < 8; ++j) *((GAS v4u*)(a + (size_t)m * DM) + lane + 64 * j) = o[j];
        const float rstd = __builtin_amdgcn_rsqf(wave_sum(ss) * (1.f / DM) + EPS); if (lane == 0) hss[m] = rstd;
    }
}
template <bool XIN, bool LAST>
__device__ __forceinline__ void norm_step(int lane, const float* x, bf16* hb, const bf16* y, const float* yss, const float* gpost, float* out, float* hss) {
    const float rstd = __builtin_amdgcn_rsqf(wave_sum(yss[lane]) * (1.f / DM) + EPS);
    float ss = 0.f;
#pragma unroll
    for (int j = 0; j < 8; ++j) {
        const v4u yw = *((const GAS v4u*)y + lane + 64 * j);
        f32x4 h0, h1;
        if constexpr (XIN) { h0 = *((const GAS f32x4*)x + 2 * lane + 128 * j); h1 = *((const GAS f32x4*)x + 2 * lane + 128 * j + 1); }
        else { const v4u hw = *((const GAS v4u*)hb + lane + 64 * j); h0 = (f32x4){bflo(hw.x), bfhi(hw.x), bflo(hw.y), bfhi(hw.y)}; h1 = (f32x4){bflo(hw.z), bfhi(hw.z), bflo(hw.w), bfhi(hw.w)}; }
        const f32x4 p0 = *((const GAS f32x4*)gpost + 2 * lane + 128 * j), p1 = *((const GAS f32x4*)gpost + 2 * lane + 128 * j + 1);
        const f32x4 y0 = {bflo(yw.x), bfhi(yw.x), bflo(yw.y), bfhi(yw.y)}, y1 = {bflo(yw.z), bfhi(yw.z), bflo(yw.w), bfhi(yw.w)};
        h0 = h0 + y0 * rstd * p0; h1 = h1 + y1 * rstd * p1;
        if constexpr (LAST) { *((GAS f32x4*)out + 2 * lane + 128 * j) = h0; *((GAS f32x4*)out + 2 * lane + 128 * j + 1) = h1; }
        else { ss += (h0.x * h0.x + h0.y * h0.y) + (h0.z * h0.z + h0.w * h0.w) + (h1.x * h1.x + h1.y * h1.y) + (h1.z * h1.z + h1.w * h1.w);
            *((GAS v4u*)hb + lane + 64 * j) = pack8f(h0, h1); }
    }
    if constexpr (!LAST) { const float r2 = __builtin_amdgcn_rsqf(wave_sum(ss) * (1.f / DM) + EPS); if (lane == 0) *hss = r2; }
}
template <bool XIN, bool LAST>
__device__ __forceinline__ void norm_rows(int lane, int first, int stride, int nrows, const float* x, bf16* hb, const bf16* y, const float* yss, const float* gpost, float* out, float* hss) {
    if (first >= nrows) return;
    f32x4 g[8][2];
#pragma unroll
    for (int j = 0; j < 8; ++j) { g[j][0] = *((const GAS f32x4*)gpost + 2 * lane + 128 * j); g[j][1] = *((const GAS f32x4*)gpost + 2 * lane + 128 * j + 1); }
    v4u yw[8], hw[8]; f32x4 xv[XIN ? 8 : 1][2]; float ys = yss[(size_t)first * 64 + lane];
#pragma unroll
    for (int j = 0; j < 8; ++j) { yw[j] = *((const GAS v4u*)(y + (size_t)first * DM) + lane + 64 * j);
        if constexpr (XIN) { xv[j][0] = *((const GAS f32x4*)(x + (size_t)first * DM) + 2 * lane + 128 * j); xv[j][1] = *((const GAS f32x4*)(x + (size_t)first * DM) + 2 * lane + 128 * j + 1); }
        else hw[j] = *((const GAS v4u*)(hb + (size_t)first * DM) + lane + 64 * j); }
    for (int m = first; m < nrows; m += stride) {
        const float rstd = __builtin_amdgcn_rsqf(wave_sum(ys) * (1.f / DM) + EPS);
        v4u o[LAST ? 1 : 8]; f32x4 of[LAST ? 8 : 1][2]; float ss = 0.f;
#pragma unroll
        for (int j = 0; j < 8; ++j) {
            f32x4 h0, h1;
            if constexpr (XIN) { h0 = xv[j][0]; h1 = xv[j][1]; }
            else { h0 = (f32x4){bflo(hw[j].x), bfhi(hw[j].x), bflo(hw[j].y), bfhi(hw[j].y)}; h1 = (f32x4){bflo(hw[j].z), bfhi(hw[j].z), bflo(hw[j].w), bfhi(hw[j].w)}; }
            const f32x4 y0 = {bflo(yw[j].x), bfhi(yw[j].x), bflo(yw[j].y), bfhi(yw[j].y)}, y1 = {bflo(yw[j].z), bfhi(yw[j].z), bflo(yw[j].w), bfhi(yw[j].w)};
            h0 = h0 + y0 * rstd * g[j][0]; h1 = h1 + y1 * rstd * g[j][1];
            if constexpr (LAST) { of[j][0] = h0; of[j][1] = h1; }
            else { ss += (h0.x * h0.x + h0.y * h0.y) + (h0.z * h0.z + h0.w * h0.w) + (h1.x * h1.x + h1.y * h1.y) + (h1.z * h1.z + h1.w * h1.w); o[j] = pack8f(h0, h1); } }
        const int mn = m + stride;
        if (mn < nrows) { ys = yss[(size_t)mn * 64 + lane];
#pragma unroll
            for (int j = 0; j < 8; ++j) { yw[j] = *((const GAS v4u*)(y + (size_t)mn * DM) + lane + 64 * j);
                if constexpr (XIN) { xv[j][0] = *((const GAS f32x4*)(x + (size_t)mn * DM) + 2 * lane + 128 * j); xv[j][1] = *((const GAS f32x4*)(x + (size_t)mn * DM) + 2 * lane + 128 * j + 1); }
                else hw[j] = *((const GAS v4u*)(hb + (size_t)mn * DM) + lane + 64 * j); } }
#pragma unroll
        for (int j = 0; j < 8; ++j) {
            if constexpr (LAST) { *((GAS f32x4*)(out + (size_t)m * DM) + 2 * lane + 128 * j) = of[j][0]; *((GAS f32x4*)(out + (size_t)m * DM) + 2 * lane + 128 * j + 1) = of[j][1]; }
            else *((GAS v4u*)(hb + (size_t)m * DM) + lane + 64 * j) = o[j]; }
        if constexpr (!LAST) { const float r2 = __builtin_amdgcn_rsqf(wave_sum(ss) * (1.f / DM) + EPS); if (lane == 0) hss[m] = r2; }
    }
}
struct Args { const float* in[25]; float* out; unsigned char* ws; int ph_lo, ph_hi; };
typedef const __attribute__((address_space(4))) Args CArgs;
struct Ptrs { const CArgs* a; float* out; unsigned char* ws;
    __device__ __forceinline__ const float* inp(int k) const { return a->in[k]; } };
#define WSP(T, off) ((T*)(P.ws + (off)))
#define WLAYER(T, l, off) ((T*)(P.ws + WS_W + (size_t)(l) * W_LAYER + (off)))

constexpr int I_IN = (DM / 64) * (NIN / 64), I_UQ = (768 / 64) * (3072 / 64), I_UKV = (512 / 64) * (4096 / 64), I_O = (DM / 64) * (DM / 64), I_MQ = (DM / 64) * (512 / 64),
              I_MO = (512 / 64) * (DM / 64), I_F1 = (DM / 64) * (DFF / 64), I_F2 = (DFF / 64) * (DM / 64);
constexpr int PER_LAYER = I_IN + I_UQ + I_UKV + I_O + 3 * I_MQ + I_MO + I_F1 + I_F2;
#ifndef CV_SKD
#define CV_SKD 4
#endif
constexpr int CV_A = 0, CV_B = (CV_SKD == 8) ? CVB8 : 5984;
static_assert(CV_B % (CV_SKD * (NIN / 64)) == 0, "slot range = whole k bands");
__device__ __forceinline__ void convert_item(CvPend& pend, LAS unsigned char* T, int tid, const Ptrs& P, int l, int r, int lane) {
    if (r < I_IN) { p0_transpose_item<1, CV_SKD>(pend, T, tid, P.inp(3) + (size_t)l * DM * IN_COLS, DM, IN_COLS, WLAYER(bf16, l, W_IN), 0, NIN / 64, r, lane, P.inp(19) + (size_t)l * DM); return; } r -= I_IN;
    if (r < I_UQ) { p0_transpose_item<2, 4>(pend, T, tid, P.inp(8) + (size_t)l * 768 * 3072, 768, 3072, WLAYER(bf16, l, W_UQ), 0, 3072 / 64, r, lane, P.inp(6) + (size_t)l * 768); return; } r -= I_UQ;
    if (r < I_UKV) { p0_transpose_item<0, CV_SKD>(pend, T, tid, P.inp(9) + (size_t)l * 512 * 4096, 512, 4096, WLAYER(bf16, l, W_UKV), 0, 4096 / 64, r, lane, P.inp(7) + (size_t)l * 512); return; } r -= I_UKV;
    if (r < I_O) { p0_transpose_item<0, CV_SKD>(pend, T, tid, P.inp(11) + (size_t)l * DM * DM, DM, DM, WLAYER(bf16, l, W_O), 0, DM / 64, r, lane); return; } r -= I_O;
    if (r < I_MQ) { p0_transpose_item<0, CV_SKD>(pend, T, tid, P.inp(13) + (size_t)l * DM * 512, DM, 512, WLAYER(bf16, l, W_MQ), 0, 512 / 64, r, lane, P.inp(21) + (size_t)l * DM); return; } r -= I_MQ;
    if (r < I_MQ) { p0_transpose_item<0, CV_SKD>(pend, T, tid, P.inp(14) + (size_t)l * DM * 512, DM, 512, WLAYER(bf16, l, W_MKV), 0, 512 / 64, r, lane); return; } r -= I_MQ;
    if (r < I_MQ) { p0_transpose_item<0, CV_SKD>(pend, T, tid, P.inp(15) + (size_t)l * DM * 512, DM, 512, WLAYER(bf16, l, W_MKV), 512, 512 / 64, r, lane); return; } r -= I_MQ;
    if (r < I_MO) { p0_transpose_item<0, CV_SKD>(pend, T, tid, P.inp(16) + (size_t)l * 512 * DM, 512, DM, WLAYER(bf16, l, W_MO), 0, DM / 64, r, lane); return; } r -= I_MO;
    if (r < I_F1) { p0_transpose_item<0, CV_SKD>(pend, T, tid, P.inp(17) + (size_t)l * DM * DFF, DM, DFF, WLAYER(bf16, l, W_FF1), 0, DFF / 64, r, lane, P.inp(23) + (size_t)l * DM); return; } r -= I_F1;
    p0_transpose_item<0, CV_SKD>(pend, T, tid, P.inp(18) + (size_t)l * DFF * DM, DFF, DM, WLAYER(bf16, l, W_FF2), 0, DM / 64, r, lane);
}
__device__ __forceinline__ void convert_slot(Frame& F, const Ptrs& P, int l, int lo, int hi) {
    CvPend pend; pend.sk = 0; pend.wt = nullptr; pend.K = 0;
    for (int it = lo + (F.bx - 128) * NWAVES + F.wave; it < hi; it += 128 * NWAVES) convert_item(pend, F.lds, F.tid, P, l, it, F.lane);
    cv_flush(F.lds, F.tid, pend);
}

constexpr int PER8 = PER_LAYER / 8, MKV8_LO = (I_IN + I_UQ + I_UKV + I_O + I_MQ) / 8, MKV8_N = (2 * I_MQ) / 8, Q8_LAYER = PER8 - MKV8_N, Q8_TOTAL = (DEPTH - 1) * Q8_LAYER;
constexpr int CW_CVQ = CW_Q + 1024;
__device__ __forceinline__ void steal_tile(Frame& F, const Ptrs& P, int t) {
    const int l = 1 + t / Q8_LAYER; int q8 = t - (l - 1) * Q8_LAYER; if (q8 >= MKV8_LO) q8 += MKV8_N;
    CvPend pend; pend.sk = 0; pend.wt = nullptr; pend.K = 0;
    convert_item(pend, F.lds, F.tid, P, l, 8 * q8 + F.wave, F.lane);
    cv_flush(F.lds, F.tid, pend);
}
__device__ __forceinline__ void steal_upto(Frame& F, const Ptrs& P, int upto, int maxn) {
    gu32* qctr = (gu32*)(P.ws + WS_CTL) + CW_CVQ; volatile LAS unsigned* sh = F.MISC + 16;
    for (int i = 0; i < maxn; ++i) {
        if (F.tid == 0) sh[2] = __hip_atomic_fetch_add(qctr, 1u, RLX_AGENT);
        LDS_WAIT(); __syncthreads();
        const int t = (int)sh[2];
        __syncthreads();
        if (t < Q8_TOTAL) steal_tile(F, P, t);
        if (t >= upto) break;
    }
}
__device__ __forceinline__ void xcd_barrier_steal(const XcdBarrier& b, Frame& F, const Ptrs& P) {
    asm volatile("s_waitcnt vmcnt(0)" ::: "memory");
    __syncthreads();
    volatile LAS unsigned* sh = F.MISC + 16;
    const bool leader = F.tid == 0;
    unsigned* bar = b.bar; unsigned bx_ = b.x; asm volatile("" : "+s"(bar), "+s"(bx_));
    if (leader) {
        __builtin_amdgcn_s_waitcnt(0);
        unsigned nloc = b.st[0], nx = b.st[1];
        if (nloc == 0u) { xcd_barrier_complete(bar, bx_, nloc, nx); b.st[0] = nloc; b.st[1] = nx; }
        const unsigned old = xb_add(&bar[XB_XSUB(bx_)], 1u);
        const unsigned gen = old / nloc;
        if (old + 1u == (gen + 1u) * nloc) {
            __builtin_amdgcn_fence(__ATOMIC_RELEASE, "agent");
            asm volatile("s_waitcnt vmcnt(0)" ::: "memory");
            const unsigned og = xb_add(&bar[XB_TOP], 1u);
            const unsigned tg = og / nx;
            if (og + 1u == (tg + 1u) * nx) xb_add(&bar[XB_TOPGEN], 1u);
            else XB_SPIN(xb_ld(&bar[XB_TOPGEN]) == tg, bar);
            __builtin_amdgcn_fence(__ATOMIC_ACQUIRE, "agent");
            xb_add(&bar[XB_XGEN(bx_)], 1u);
            asm volatile("s_waitcnt vmcnt(0)" ::: "memory");
            sh[0] = 0xffffffffu;
        } else sh[0] = gen;
    }
    LDS_WAIT(); __syncthreads();
    const unsigned gen = sh[0];
    if (gen != 0xffffffffu) {
        gu32* qctr = (gu32*)(P.ws + WS_CTL) + CW_CVQ;
        for (;;) {
            if (leader) { const unsigned rel = (xb_ld(&bar[XB_XGEN(bx_)]) != gen) ? 1u : 0u; sh[1] = rel; sh[2] = rel ? 0u : __hip_atomic_fetch_add(qctr, 1u, RLX_AGENT); }
            LDS_WAIT(); __syncthreads();
            const unsigned rel = sh[1]; const int t = (int)sh[2];
            __syncthreads();
            if (rel) break;
            if (t >= Q8_TOTAL) { if (leader) XB_SPIN(xb_ld(&bar[XB_XGEN(bx_)]) == gen, bar); break; }
            steal_tile(F, P, t);
            asm volatile("s_waitcnt vmcnt(0)" ::: "memory");
        }
        if (leader) { __builtin_amdgcn_fence(__ATOMIC_ACQUIRE, "agent"); asm volatile("s_waitcnt vmcnt(0)" ::: "memory"); }
    }
    __syncthreads();
}

__device__ __forceinline__ void p0_prologue(Frame& F, const Ptrs& P) {
    const int gw = F.vcu * NWAVES + F.wave, NGW = F.G * NWAVES;
    CvPend pend; pend.sk = 0; pend.wt = nullptr; pend.K = 0;
    for (int it = gw; it < PER_LAYER + (DEPTH - 1) * 8 * MKV8_N; it += NGW) {
        if (it < PER_LAYER) convert_item(pend, F.lds, F.tid, P, 0, it, F.lane);
        else { const int q = it - PER_LAYER, l = 1 + q / (8 * MKV8_N); convert_item(pend, F.lds, F.tid, P, l, 8 * MKV8_LO + (q - (l - 1) * 8 * MKV8_N), F.lane); }
    }
    cv_flush(F.lds, F.tid, pend);
    norm_first_rows(F.lane, gw, NGW, M, P.inp(0), WSP(bf16, WS_HN), WSP(float, WS_HSS));
    for (int m = gw; m < DEPTH * BATCH * MEMT; m += NGW) { const int l = m / (BATCH * MEMT), r = m % (BATCH * MEMT);
        norm_first<true>(F.lane, P.inp(1) + (size_t)r * DM, P.inp(12) + (size_t)l * DM, WSP(bf16, WS_MEMN) + (size_t)m * DM, nullptr); }
    { const int gt = gw * 64 + F.lane, NT = NGW * 64; const int* pos = (const int*)P.inp(2); f32x2* rope = WSP(f32x2, WS_ROPE);
      for (int e = gt; e < M * 32; e += NT) { const int tok = e >> 5, i = e & 31;
          const float inv = exp2f(-(float)i * (13.287712379549449f / 32.0f));
          const float ang = (float)pos[tok] * inv;
          const double k = rint((double)ang * 0.15915494309189535);
          const float red = (float)((double)ang - k * 6.283185307179586);
          f32x2 cs; cs.x = cosf(red); cs.y = sinf(red); rope[e] = cs; } }
    { const int gt = gw * 64 + F.lane; if (gt < 1024) { const float* G = P.inp(4); float g[4], mx = -3.0e38f;
          for (int l = 0; l < 4; ++l) { g[l] = G[l * 1024 + gt]; mx = fmaxf(mx, g[l]); }
          float e[4], s = 0.f; for (int l = 0; l < 4; ++l) { e[l] = expf(g[l] - mx); s += e[l]; }
          float* LB = WSP(float, WS_LB); float cum = 0.f;
          for (int l = 0; l < 4; ++l) { if (l > 0) cum += e[l] / s; LB[l * 1024 + gt] = fminf(fmaxf(cum, 0.f), 1.0f - 1e-6f); } } }
    { const int gt = gw * 64 + F.lane, NT = NGW * 64; GAS v4u* z = (GAS v4u*)WSP(char, WS_QEXT); const v4u zero = {0u, 0u, 0u, 0u};
      for (int e = gt; e < (int)(32 * MiB / 16); e += NT) z[e] = zero; }
}

__device__ __forceinline__ void p2_rows(Frame& F, const Ptrs& P, int l, int blk  ) {
    const int l16 = F.lane & 15, rsub = F.lane >> 4;
    const float* fb = P.inp(5) + l * 8; const f32x2* rope = WSP(f32x2, WS_ROPE);
#pragma unroll
    for (int it = 0; it < 2; ++it) { const int m = blk * 64 + F.wave * 8 + it * 4 + rsub;
        const float* css = WSP(float, WS_CSS) + (size_t)m * 20; const float* px = WSP(float, WS_PROJX) + (size_t)m * 256;
        const float c0 = css[l16], c1 = l16 < 4 ? css[16 + l16] : 0.f;
        const float x1a = px[l16], x2a = px[32 + l16], x1b = px[16 + l16], x2b = px[48 + l16];
        const f32x2 csa = rope[(size_t)m * 32 + l16], csb = rope[(size_t)m * 32 + 16 + l16];
        const float xf = l16 < 8 ? px[64 + l16] + fb[l16] : 0.f;
        float sq = l16 < 12 ? c0 : 0.f, skv = (l16 >= 12 ? c0 : 0.f) + c1;
#pragma unroll
        for (int x = 1; x < 16; x <<= 1) { sq += __shfl_xor(sq, x); skv += __shfl_xor(skv, x); }
        if (l16 == 0) { WSP(float, WS_RQ)[m] = __builtin_amdgcn_rsqf(sq * (1.f / 768.f) + EPS); WSP(float, WS_RKV)[m] = __builtin_amdgcn_rsqf(skv * (1.f / 512.f) + EPS); }
        GAS unsigned* kr = (GAS unsigned*)(WSP(bf16, WS_KROT) + (size_t)m * 64);
        kr[l16] = pk2(x1a * csa.x - x2a * csa.y, x1a * csa.y + x2a * csa.x); kr[16 + l16] = pk2(x1b * csb.x - x2b * csb.y, x1b * csb.y + x2b * csb.x);
        if (l16 < 8) WSP(float, WS_FOXLF)[(size_t)m * 8 + l16] = fminf(xf, 0.f) - __logf(1.0f + __expf(-fabsf(xf)));
    }
}

__device__ __forceinline__ float block_sum512(Frame& F, float v, LAS float* red) {
    v = wave_sum(v); if (F.lane == 0) red[F.wave] = v; LDS_WAIT(); __syncthreads();
    float t = 0.f;
#pragma unroll
    for (int w = 0; w < 8; ++w) t += red[w];
    __syncthreads(); return t;
}
__device__ __forceinline__ void fox_scan(Frame& F, const Ptrs& P, int item) {
    const int bh = item >> 4, seg = item & 15, b = bh >> 3, h = bh & 7, tid = F.tid;
    LAS float* red = (LAS float*)(F.lds); LAS float* wtot = red + 8; LAS float* mx = red + 16;
    const float* lf = WSP(float, WS_FOXLF) + ((size_t)b * SEQ) * 8 + h;
    float part = 0.f;
#pragma unroll
    for (int j = 0; j < 15; ++j) if (j < seg) part += lf[(size_t)(tid + 512 * j) * 8];
    const float prefix = block_sum512(F, part, red);
    const int s = seg * 512 + tid;
    const float own = lf[(size_t)s * 8];
    float incl = own;
#pragma unroll
    for (int o = 1; o < 64; o <<= 1) { const float t = __shfl_up(incl, o); if (F.lane >= o) incl += t; }
    if (F.lane == 63) wtot[F.wave] = incl;
    LDS_WAIT(); __syncthreads();
    float off = prefix;
    for (int w = 0; w < F.wave; ++w) off += wtot[w];
    const float c = (incl + off) * LOG2E;
    { bf16* qe = WSP(bf16, WS_QEXT) + ((size_t)bh * SEQ + s) * 64; bf16* ke = WSP(bf16, WS_KEXT) + ((size_t)bh * SEQ + s) * 64;
      const unsigned one = 0x3f80u;
      const unsigned c1 = f2bf(c); const float r1 = c - bf2f((unsigned short)c1); const unsigned c2 = f2bf(r1); const float r2 = r1 - bf2f((unsigned short)c2); const unsigned c3 = f2bf(r2);
      v4u q; q.x = c1 | (c2 << 16); q.y = c3 | (one << 16); q.z = one | (one << 16); q.w = 0u;
      v4u k; k.x = one | (one << 16); k.y = one | ((c1 ^ 0x8000u) << 16); k.z = (c2 ^ 0x8000u) | ((c3 ^ 0x8000u) << 16); k.w = 0u;
      *(GAS v4u*)qe = q; *(GAS v4u*)ke = k;
      WSP(float, WS_FOXC)[(size_t)bh * SEQ + s] = c; }
    const bf16* fq = WSP(bf16, WS_FOX) + ((size_t)bh * SEQ + (size_t)seg * 512) * 128; const bf16* fk = fq + (size_t)16 * SEQ * 128;
    float qm0 = 0.f, qm1 = 0.f, km = 0.f;
#pragma unroll
    for (int hb = 0; hb < 2; ++hb) { v4u qa[8], ka[8];
#pragma unroll
        for (int i = 0; i < 8; ++i) { const size_t o = (size_t)((hb * 8 + i) * 32 + (tid >> 4)) * 128 + (tid & 15) * 8; qa[i] = *(const GAS v4u*)(fq + o); ka[i] = *(const GAS v4u*)(fk + o); }
#pragma unroll
        for (int i = 0; i < 8; ++i) {
            float sq = (bflo(qa[i].x) * bflo(qa[i].x) + bfhi(qa[i].x) * bfhi(qa[i].x)) + (bflo(qa[i].y) * bflo(qa[i].y) + bfhi(qa[i].y) * bfhi(qa[i].y)) + (bflo(qa[i].z) * bflo(qa[i].z) + bfhi(qa[i].z) * bfhi(qa[i].z)) + (bflo(qa[i].w) * bflo(qa[i].w) + bfhi(qa[i].w) * bfhi(qa[i].w));
            float sk = (bflo(ka[i].x) * bflo(ka[i].x) + bfhi(ka[i].x) * bfhi(ka[i].x)) + (bflo(ka[i].y) * bflo(ka[i].y) + bfhi(ka[i].y) * bfhi(ka[i].y)) + (bflo(ka[i].z) * bflo(ka[i].z) + bfhi(ka[i].z) * bfhi(ka[i].z)) + (bflo(ka[i].w) * bflo(ka[i].w) + bfhi(ka[i].w) * bfhi(ka[i].w));
#pragma unroll
            for (int x = 1; x < 16; x <<= 1) { sq += __shfl_xor(sq, x); sk += __shfl_xor(sk, x); }
            if (hb == 0) qm0 = fmaxf(qm0, sq); else qm1 = fmaxf(qm1, sq);
            km = fmaxf(km, sk); } }
#pragma unroll
    for (int x = 16; x < 64; x <<= 1) { qm0 = fmaxf(qm0, __shfl_xor(qm0, x)); qm1 = fmaxf(qm1, __shfl_xor(qm1, x)); km = fmaxf(km, __shfl_xor(km, x)); }
    if (F.lane == 0) { mx[F.wave * 3] = qm0; mx[F.wave * 3 + 1] = qm1; mx[F.wave * 3 + 2] = km; }
    LDS_WAIT(); __syncthreads();
    if (tid < 3) { float m = 0.f; for (int w = 0; w < 8; ++w) m = fmaxf(m, mx[w * 3 + tid]);
        if (tid < 2) WSP(float, WS_FOXQM)[bh * 32 + seg * 2 + tid] = m; else WSP(float, WS_FOXKM)[bh * 16 + seg] = m; }
    __syncthreads();
}

constexpr int HL_QT = 0, HL_KT = 17408, HL_QH = 34816, HL_VT = 52224, HL_SC = 70656, HL_QTOT = 79872, HL_RS = 81920, HL_KHT = 0  ;
__device__ __forceinline__ float clampe(float x) { return __expf(fminf(x, 80.f)); }
constexpr int H1_QTOT = 40960  ;
struct H1Regs { f32x4 lf[4]; v2u kw[4], vw[4]; };
__device__ __forceinline__ void hgrn_local_load(Frame& F, const Ptrs& P, int ch, H1Regs& R) {
    const int tid = F.tid, tg = tid >> 5, cg = tid & 31;
    const int bh = ch >> 7, n = ch & 127, b = bh >> 3, h = bh & 7;
    const size_t tok0 = (size_t)b * SEQ + (size_t)n * 64; const int cb = h * 128;
    const float* logf = WSP(float, WS_LOGF) + (tok0 + 4 * tg) * 1024 + cb + 4 * cg; const bf16* proj = WSP(bf16, WS_PROJ) + (tok0 + 4 * tg) * 4096 + cb + 4 * cg;
#pragma unroll
    for (int i = 0; i < 4; ++i) { R.lf[i] = *(const GAS f32x4*)(logf + (size_t)i * 1024); R.kw[i] = *(const GAS v2u*)(proj + (size_t)i * 4096 + 1024); R.vw[i] = *(const GAS v2u*)(proj + (size_t)i * 4096 + 2048); }
}
__device__ __forceinline__ void hgrn_local(Frame& F, const Ptrs& P, int ch, H1Regs& R) {
    const int tid = F.tid, tg = tid >> 5, cg = tid & 31;
    LAS float* QTOT = (LAS float*)(F.lds + H1_QTOT);
    f32x4 lf[4]; v2u kw[4], vw[4];
#pragma unroll
    for (int i = 0; i < 4; ++i) { lf[i] = R.lf[i]; kw[i] = R.kw[i]; vw[i] = R.vw[i]; }
    lf[1] = lf[1] + lf[0]; lf[2] = lf[2] + lf[1]; lf[3] = lf[3] + lf[2];
    *(LAS f32x4*)(QTOT + tg * 128 + 4 * cg) = lf[3];
    { v2u t; t.x = (vw[0].x & 0xffffu) | (vw[1].x << 16); t.y = (vw[2].x & 0xffffu) | (vw[3].x << 16); *(LAS v2u*)(F.lds + HL_VT + (4 * cg + 0) * 144 + 8 * tg) = t;
      t.x = (vw[0].x >> 16) | (vw[1].x & 0xffff0000u); t.y = (vw[2].x >> 16) | (vw[3].x & 0xffff0000u); *(LAS v2u*)(F.lds + HL_VT + (4 * cg + 1) * 144 + 8 * tg) = t;
      t.x = (vw[0].y & 0xffffu) | (vw[1].y << 16); t.y = (vw[2].y & 0xffffu) | (vw[3].y << 16); *(LAS v2u*)(F.lds + HL_VT + (4 * cg + 2) * 144 + 8 * tg) = t;
      t.x = (vw[0].y >> 16) | (vw[1].y & 0xffff0000u); t.y = (vw[2].y >> 16) | (vw[3].y & 0xffff0000u); *(LAS v2u*)(F.lds + HL_VT + (4 * cg + 3) * 144 + 8 * tg) = t; }
    LDS_WAIT(); __syncthreads();
    f32x4 off = {0.f, 0.f, 0.f, 0.f}, bend = {0.f, 0.f, 0.f, 0.f};
#pragma unroll
    for (int g = 0; g < 16; ++g) { const f32x4 t = *(const LAS f32x4*)(QTOT + g * 128 + 4 * cg); if (g < tg) off = off + t; bend = bend + t; }
    f32x4 kh[4];
#pragma unroll
    for (int i = 0; i < 4; ++i) { const f32x4 kv = {bflo(kw[i].x), bfhi(kw[i].x), bflo(kw[i].y), bfhi(kw[i].y)};
#pragma unroll
        for (int j = 0; j < 4; ++j) kh[i][j] = kv[j] * __expf(bend[j] - (lf[i][j] + off[j])); }
#pragma unroll
    for (int j = 0; j < 4; ++j) { v2u t; t.x = pk2(kh[0][j], kh[1][j]); t.y = pk2(kh[2][j], kh[3][j]); *(LAS v2u*)(F.lds + HL_KHT + (4 * cg + j) * 144 + 8 * tg) = t; }
    if (tg == 0) { f32x4 a; a[0] = __expf(bend[0]); a[1] = __expf(bend[1]); a[2] = __expf(bend[2]); a[3] = __expf(bend[3]); *(GAS f32x4*)(WSP(float, WS_ADEC) + (size_t)ch * 128 + 4 * cg) = a; }
    LDS_WAIT(); __syncthreads();
    const int w = F.wave, r32 = F.lane & 31, hi = F.lane >> 5, mt = w >> 1;
    bf16* LT = WSP(bf16, WS_LT) + (size_t)ch * 16384;
#pragma unroll
    for (int n2 = 0; n2 < 2; ++n2) { const int nt = (w & 1) * 2 + n2; f32x16 acc = {};
#pragma unroll
        for (int ks = 0; ks < 4; ++ks) {
            const bf16x8 A = *(const LAS bf16x8*)(F.lds + HL_VT + (32 * mt + r32) * 144 + (16 * ks + 8 * hi) * 2);
            const bf16x8 B = *(const LAS bf16x8*)(F.lds + HL_KHT + (32 * nt + r32) * 144 + (16 * ks + 8 * hi) * 2);
            acc = __builtin_amdgcn_mfma_f32_32x32x16_bf16(A, B, acc, 0, 0, 0); }
#pragma unroll
        for (int r = 0; r < 16; ++r) LT[(32 * mt + att::crow(r, hi)) * 128 + 32 * nt + r32] = (bf16)f2bf(acc[r]); }
    __syncthreads();
}
__device__ __forceinline__ void hgrn_scan(Frame& F, const Ptrs& P) {
    const int gt = (F.vcu * NWAVES + F.wave) * 64 + F.lane, NT = F.G * NWAVES * 64;
    for (int e = gt; e < 16 * 128 * 64; e += NT) {
        const int bh = e >> 13, v = (e >> 6) & 127, k = (e & 63) * 2;
        const bf16* LT = WSP(bf16, WS_LT) + (size_t)bh * 128 * 16384 + v * 128 + k;
        const float* ad = WSP(float, WS_ADEC) + (size_t)bh * 128 * 128 + k;
        bf16* ST = WSP(bf16, WS_ST) + (size_t)bh * 128 * 16384 + v * 128 + k;
        float s0 = 0.f, s1 = 0.f;
        unsigned lt[16]; f32x2 a[16];
#pragma unroll
        for (int i = 0; i < 16; ++i) { lt[i] = *(const GAS unsigned*)(LT + (size_t)i * 16384); a[i] = *(const GAS f32x2*)(ad + i * 128); }
        for (int nb = 0; nb < 128; nb += 16) {
            unsigned o[16];
#pragma unroll
            for (int i = 0; i < 16; ++i) { o[i] = pk2(s0, s1); s0 = a[i].x * s0 + bflo(lt[i]); s1 = a[i].y * s1 + bfhi(lt[i]); }
            if (nb + 16 < 128) {
#pragma unroll
                for (int i = 0; i < 16; ++i) { lt[i] = *(const GAS unsigned*)(LT + (size_t)(nb + 16 + i) * 16384); a[i] = *(const GAS f32x2*)(ad + (nb + 16 + i) * 128); } }
#pragma unroll
            for (int i = 0; i < 16; ++i) *(GAS unsigned*)(ST + (size_t)(nb + i) * 16384) = o[i];
        }
    }
}
constexpr int HO_QTOT = 79872  , HO_RS = 88064  , HO_GT = 89088  ;
__device__ __forceinline__ void hgrn_out(Frame& F, const Ptrs& P, int ch, int l) {
    const int tid = F.tid, tg = tid >> 5, cg = tid & 31;
    const int bh = ch >> 7, n = ch & 127, b = bh >> 3, h = bh & 7;
    const size_t tok0 = (size_t)b * SEQ + (size_t)n * 64; const int cb = h * 128;
    const float* logf = WSP(float, WS_LOGF) + (tok0 + 4 * tg) * 1024 + cb + 4 * cg; const bf16* proj = WSP(bf16, WS_PROJ) + (tok0 + 4 * tg) * 4096 + cb + 4 * cg;
    LAS float* QTOT = (LAS float*)(F.lds + HO_QTOT); LAS float* RS = (LAS float*)(F.lds + HO_RS);
    const int w = F.wave, r32 = F.lane & 31, hi = F.lane >> 5, mt = w >> 2, nt = w & 3;
    f32x4 lf[4]; v2u qw[4], kw[4], vw[4], gw[4]; bf16x8 stf[8];
#pragma unroll
    for (int i = 0; i < 4; ++i) { lf[i] = *(const GAS f32x4*)(logf + (size_t)i * 1024); qw[i] = *(const GAS v2u*)(proj + (size_t)i * 4096); kw[i] = *(const GAS v2u*)(proj + (size_t)i * 4096 + 1024);
        vw[i] = *(const GAS v2u*)(proj + (size_t)i * 4096 + 2048); }
#pragma unroll
    for (int i = 0; i < 4; ++i) gw[i] = *(const GAS v2u*)(proj + (size_t)i * 4096 + 3072);
    { const bf16* ST = WSP(bf16, WS_ST) + (size_t)ch * 16384 + (32 * nt + r32) * 128 + 8 * hi;
#pragma unroll
      for (int ks = 0; ks < 8; ++ks) stf[ks] = *(const GAS bf16x8*)(ST + 16 * ks); }
    lf[1] = lf[1] + lf[0]; lf[2] = lf[2] + lf[1]; lf[3] = lf[3] + lf[2];
    *(LAS f32x4*)(QTOT + tg * 128 + 4 * cg) = lf[3];
#pragma unroll
    for (int i = 0; i < 4; ++i) *(LAS v2u*)(F.lds + HO_GT + (4 * tg + i) * 272 + 8 * cg) = gw[i];
    { v2u t; t.x = (vw[0].x & 0xffffu) | (vw[1].x << 16); t.y = (vw[2].x & 0xffffu) | (vw[3].x << 16); *(LAS v2u*)(F.lds + HL_VT + (4 * cg + 0) * 144 + 8 * tg) = t;
      t.x = (vw[0].x >> 16) | (vw[1].x & 0xffff0000u); t.y = (vw[2].x >> 16) | (vw[3].x & 0xffff0000u); *(LAS v2u*)(F.lds + HL_VT + (4 * cg + 1) * 144 + 8 * tg) = t;
      t.x = (vw[0].y & 0xffffu) | (vw[1].y << 16); t.y = (vw[2].y & 0xffffu) | (vw[3].y << 16); *(LAS v2u*)(F.lds + HL_VT + (4 * cg + 2) * 144 + 8 * tg) = t;
      t.x = (vw[0].y >> 16) | (vw[1].y & 0xffff0000u); t.y = (vw[2].y >> 16) | (vw[3].y & 0xffff0000u); *(LAS v2u*)(F.lds + HL_VT + (4 * cg + 3) * 144 + 8 * tg) = t; }
    LDS_WAIT(); __syncthreads();
    f32x4 off = {0.f, 0.f, 0.f, 0.f}, rref = {0.f, 0.f, 0.f, 0.f};
#pragma unroll
    for (int g = 0; g < 16; ++g) { const f32x4 t = *(const LAS f32x4*)(QTOT + g * 128 + 4 * cg); if (g < tg) off = off + t; if (g < 8) rref = rref + t; }
#pragma unroll
    for (int i = 0; i < 4; ++i) { const f32x4 bb = lf[i] + off;
        const f32x4 qv = {bflo(qw[i].x), bfhi(qw[i].x), bflo(qw[i].y), bfhi(qw[i].y)}, kv = {bflo(kw[i].x), bfhi(kw[i].x), bflo(kw[i].y), bfhi(kw[i].y)};
        f32x4 qt, kt, qh;
#pragma unroll
        for (int j = 0; j < 4; ++j) { qt[j] = qv[j] * clampe(bb[j] - rref[j]); kt[j] = kv[j] * clampe(rref[j] - bb[j]); qh[j] = qv[j] * __expf(bb[j]); }
        v2u a; a.x = pk2(qt[0], qt[1]); a.y = pk2(qt[2], qt[3]); *(LAS v2u*)(F.lds + HL_QT + (4 * tg + i) * 272 + 8 * cg) = a;
        a.x = pk2(kt[0], kt[1]); a.y = pk2(kt[2], kt[3]); *(LAS v2u*)(F.lds + HL_KT + (4 * tg + i) * 272 + 8 * cg) = a;
        a.x = pk2(qh[0], qh[1]); a.y = pk2(qh[2], qh[3]); *(LAS v2u*)(F.lds + HL_QH + (4 * tg + i) * 272 + 8 * cg) = a; }
    LDS_WAIT(); __syncthreads();
    if (w < 4) { const int mt2 = w >> 1, nt2 = w & 1; f32x16 acc = {};
#pragma unroll
        for (int ks = 0; ks < 8; ++ks) {
            const bf16x8 A = *(const LAS bf16x8*)(F.lds + HL_QT + (32 * mt2 + r32) * 272 + (16 * ks + 8 * hi) * 2);
            const bf16x8 B = *(const LAS bf16x8*)(F.lds + HL_KT + (32 * nt2 + r32) * 272 + (16 * ks + 8 * hi) * 2);
            acc = __builtin_amdgcn_mfma_f32_32x32x16_bf16(A, B, acc, 0, 0, 0); }
#pragma unroll
        for (int r = 0; r < 16; ++r) { const int t = 32 * mt2 + att::crow(r, hi), s = 32 * nt2 + r32;
            *(LAS unsigned short*)(F.lds + HL_SC + t * 144 + s * 2) = (unsigned short)f2bf(s <= t ? acc[r] : 0.f); } }
    LDS_WAIT(); __syncthreads();
    f32x16 acc = {};
#pragma unroll
    for (int ks = 0; ks < 4; ++ks) {
        const bf16x8 A = *(const LAS bf16x8*)(F.lds + HL_SC + (32 * mt + r32) * 144 + (16 * ks + 8 * hi) * 2);
        const bf16x8 B = *(const LAS bf16x8*)(F.lds + HL_VT + (32 * nt + r32) * 144 + (16 * ks + 8 * hi) * 2);
        acc = __builtin_amdgcn_mfma_f32_32x32x16_bf16(A, B, acc, 0, 0, 0); }
#pragma unroll
    for (int ks = 0; ks < 8; ++ks) {
        const bf16x8 A = *(const LAS bf16x8*)(F.lds + HL_QH + (32 * mt + r32) * 272 + (16 * ks + 8 * hi) * 2);
        acc = __builtin_amdgcn_mfma_f32_32x32x16_bf16(A, stf[ks], acc, 0, 0, 0); }
#pragma unroll
    for (int r = 0; r < 16; ++r) { float ss = acc[r] * acc[r];
        ss += __shfl_xor(ss, 1); ss += __shfl_xor(ss, 2); ss += __shfl_xor(ss, 4); ss += __shfl_xor(ss, 8); ss += __shfl_xor(ss, 16);
        if (r32 == 0) RS[nt * 64 + 32 * mt + att::crow(r, hi)] = ss; }
    LDS_WAIT(); __syncthreads();
    const int vl = 32 * nt + r32; const float ga = P.inp(10)[(size_t)l * 4096 + cb + vl];
    bf16* mix = WSP(bf16, WS_MIX);
#pragma unroll
    for (int r = 0; r < 16; ++r) { const int t = 32 * mt + att::crow(r, hi);
        const float tot = (RS[t] + RS[64 + t]) + (RS[128 + t] + RS[192 + t]);
        const float rstd = __builtin_amdgcn_rsqf(tot * (1.f / 128.f) + EPS);
        const float g = bf2f(*(const LAS unsigned short*)(F.lds + HO_GT + t * 272 + vl * 2));
        const float o = acc[r] * rstd * ga * (g * __builtin_amdgcn_rcpf(1.0f + __expf(-g)));
        const float on = __shfl_xor(o, 1);
        if ((r32 & 1) == 0) *(GAS unsigned*)(mix + (tok0 + t) * 4096 + cb + vl) = pk2(o, on); }
    __syncthreads();
}
constexpr int ATT_ITEMS = 768;
__device__ __forceinline__ att::BlockRef mix_block(const Ptrs& P, int l, int j, int pass) {
    att::BlockRef r;
    const int x = j & 15, qb = pass ? 31 - x : x;
    if (j < 512) { const int bh = j >> 4, b = bh >> 4, h = bh & 15; const size_t q0 = (size_t)bh * SEQ + (size_t)qb * 256;
        r.Q = WSP(bf16, WS_QN) + q0 * 128; r.QX = WSP(bf16, WS_QR) + q0 * 64;
        r.K = WSP(bf16, WS_KN) + (size_t)bh * SEQ * 128; r.V = WSP(bf16, WS_VC) + (size_t)bh * SEQ * 128; r.KX = WSP(bf16, WS_KROT) + (size_t)b * SEQ * 64;
        r.O = WSP(bf16, WS_MIX) + ((size_t)b * SEQ + (size_t)qb * 256) * 4096 + 2048 + h * 128; r.G = P.inp(10) + (size_t)l * 4096 + 2048 + h * 128; }
    else { const int bh = (j - 512) >> 4, b = bh >> 3, h = bh & 7; const size_t q0 = (size_t)bh * SEQ + (size_t)qb * 256;
        r.Q = WSP(bf16, WS_FOX) + q0 * 128; r.QX = WSP(bf16, WS_QEXT) + q0 * 64;
        r.K = WSP(bf16, WS_FOX) + ((size_t)(16 + bh) * SEQ) * 128; r.V = WSP(bf16, WS_FOX) + ((size_t)(32 + bh) * SEQ) * 128; r.KX = WSP(bf16, WS_KEXT) + (size_t)bh * SEQ * 64;
        r.O = WSP(bf16, WS_MIX) + ((size_t)b * SEQ + (size_t)qb * 256) * 4096 + 1024 + h * 128; r.G = P.inp(10) + (size_t)l * 4096 + 1024 + h * 128; }
    r.P0 = qb * 256; r.jlo = 0;
    if (j >= 512) {
        const int bh = (j - 512) >> 4; const float* C = WSP(float, WS_FOXC) + (size_t)bh * SEQ;
        float km = 0.f;
        for (int sgi = 0; sgi < 16; ++sgi) km = fmaxf(km, WSP(float, WS_FOXKM)[bh * 16 + sgi]);
        const float bound = 2.0f * sqrtf(WSP(float, WS_FOXQM)[bh * 32 + qb] * km) * 1.01f + 100.0f;
        const float ct0 = C[qb * 256];
        const int nt = qb * 4;
        int lane_; asm volatile("v_mbcnt_lo_u32_b32 %0, -1, 0\n\tv_mbcnt_hi_u32_b32 %0, -1, %0" : "=v"(lane_));
        bool keep0 = true, keep1 = true;
        if (lane_ < nt) keep0 = (ct0 - C[64 * lane_ + 63]) >= -bound;
        if (lane_ + 64 < nt) keep1 = (ct0 - C[64 * (lane_ + 64) + 63]) >= -bound;
        const unsigned long long m0 = __ballot(keep0), m1 = __ballot(keep1);
        int jl = m0 ? __builtin_ctzll(m0) : (m1 ? 64 + __builtin_ctzll(m1) : nt);
        r.jlo = __builtin_amdgcn_readfirstlane(jl < nt ? jl : nt);
    }
    return r;
}
__device__ __forceinline__ void mix_attention(Frame& F, const Ptrs& P, int l) {
    const int nit = (ATT_ITEMS - F.vcu + F.G - 1) / F.G;
    if (nit <= 0) return;
    const int nblk = 2 * nit;
    att::Seam<true> S;
    att::BlockRef cur = mix_block(P, l, F.vcu, 0);
    att::attn_prime<true>(cur, 1 << 30, F.ldsg, S, fresh_tid(F.wave));
    for (int k = 0; k < nblk; ++k) {
        const int kn = (k + 1 < nblk) ? k + 1 : k;
        const att::BlockRef nxt = mix_block(P, l, F.vcu + (kn >> 1) * F.G, kn & 1);
        att::attn_block<true, true, 4096>(cur, nxt, SEQ, 1 << 30, F.ldsg, S, fresh_tid(F.wave));
        cur = nxt;
    }
}
__device__ __forceinline__ att::BlockRef mem_block(const Ptrs& P, int l, int j) {
    att::BlockRef r; const int bh = j >> 5, qb = j & 31, b = bh >> 2, h = bh & 3;
    r.Q = WSP(bf16, WS_QMEM) + ((size_t)bh * SEQ + (size_t)qb * 256) * 128; r.QX = r.Q;
    r.K = WSP(bf16, WS_KVMEM) + ((size_t)l * 2 * 8 + bh) * 256 * 128; r.V = r.K + (size_t)8 * 256 * 128; r.KX = r.K;
    r.O = WSP(bf16, WS_OMEM) + ((size_t)b * SEQ + (size_t)qb * 256) * 512 + h * 128; r.G = nullptr; r.P0 = MEMT; r.jlo = 0;
    return r;
}
__device__ __forceinline__ void mem_attention(Frame& F, const Ptrs& P, int l) {
    const int nblk = (256 - F.vcu + F.G - 1) / F.G;
    if (nblk <= 0) return;
    att::Seam<false> S;
    att::BlockRef cur = mem_block(P, l, F.vcu);
    att::attn_prime<false>(cur, 1 << 30, F.ldsg, S, fresh_tid(F.wave));
    for (int k = 0; k < nblk; ++k) {
        const int kn = (k + 1 < nblk) ? k + 1 : k;
        const att::BlockRef nxt = mem_block(P, l, F.vcu + kn * F.G);
        att::attn_block<false, false, 512>(cur, nxt, MEMT, 1 << 30, F.ldsg, S, fresh_tid(F.wave));
        cur = nxt;
    }
}

constexpr int NPH = 13;
constexpr int NPHASES = 1 + DEPTH * NPH;
__global__ void __launch_bounds__(NWAVES * 64, 2) trunk_fwd(Args args) {
    extern __shared__ __attribute__((aligned(16))) unsigned char lds[];
    const int wave_s = __builtin_amdgcn_readfirstlane(threadIdx.x >> 6);
    for (int u = threadIdx.x; u < (LDS_BYTES - LDSCTL_OFF) / 4; u += NWAVES * 64) ((LAS unsigned*)((LAS unsigned char*)lds + LDSCTL_OFF))[u] = 0u;
    __syncthreads();
    XcdBarrier bar = xcd_barrier_post((unsigned*)(args.ws + WS_CTL) + CW_BAR, (volatile LAS unsigned*)((LAS unsigned char*)lds + MISC_OFF) + 8);
#define PH_BEGIN() Frame F; { int ln_; asm volatile("v_mbcnt_lo_u32_b32 %0, -1, 0\n\tv_mbcnt_hi_u32_b32 %0, -1, %0" : "=v"(ln_)); F.tid = wave_s * 64 + ln_; } F.lds = (LAS unsigned char*)lds; F.ldsg = (char*)lds; F.MISC = (volatile LAS unsigned*)(F.lds + MISC_OFF); F.lane = F.tid & 63; F.wave = __builtin_amdgcn_readfirstlane(F.tid >> 6); \
    F.G = gridDim.x; { int bx = blockIdx.x; asm volatile("" : "+s"(bx)); F.vcu = (F.G % 8 == 0) ? (bx % 8) * (F.G / 8) + bx / 8 : bx; F.bx = bx; } \
    const CArgs* ap_ = (const CArgs*)__builtin_amdgcn_kernarg_segment_ptr(); asm volatile("" : "+s"(ap_)); const Ptrs P{ap_, ap_->out, ap_->ws}; LAS unsigned char* ring = F.lds;
    const int lo = args.ph_lo, hi = args.ph_hi;
#ifndef PH_MASK
#define PH_MASK 0xFFFFFFFFu
#endif
#define RUN(g) (lo <= (g) && (g) < hi)
#define EN(p) ((PH_MASK >> (p)) & 1u)
#ifndef DBL_MASK
#define DBL_MASK 0u
#endif
#define REPS(p) (((DBL_MASK >> (p)) & 1u) ? 2 : 1)
#ifdef PROBE_ID
    unsigned long long pr_acc = 0ull, pr_t0 = 0ull;
#define PR_BEGIN(id) do { if ((id) == PROBE_ID) pr_t0 = __builtin_amdgcn_s_memrealtime(); } while (0)
#define PR_END(id) do { if ((id) == PROBE_ID) pr_acc += __builtin_amdgcn_s_memrealtime() - pr_t0; } while (0)
#else
#define PR_BEGIN(id) do {} while (0)
#define PR_END(id) do {} while (0)
#endif
#define PHASE_END(g) do { if ((g) + 1 < hi) { PH_BEGIN(); xcd_barrier_steal(bar, F, P); } } while (0)

    if (EN(0) && RUN(0)) { PR_BEGIN(0); for (int rep_ = 0; rep_ < REPS(0); ++rep_) { PH_BEGIN(); p0_prologue(F, P); __syncthreads(); } PHASE_END(0); PR_END(0); }

    const int F0G = gridDim.x;
    for (int l = 0; l < DEPTH; ++l) {
        const int g0 = 1 + l * NPH;
        static_assert(pg8::WGM == 8 && pg8::NXCD == 8 && NIN == 8704 && M == 16384, "the cut after 8 rounds relies on StaticOrder dealing column tiles 32, 33 (all 64 row panels) in round 8 of a 256-workgroup grid");
        const int nfull = (F0G == 256) ? (64 * (NIN / 256)) / 256 : (1 << 20);
        if (EN(1) && RUN(g0 + 0)) { PR_BEGIN(1); for (int rep_ = 0; rep_ < REPS(1); ++rep_) { PH_BEGIN();
            { pg8::Gemm g{WSP(bf16, WS_HN), WLAYER(bf16, l, W_IN), M, NIN, DM}; pg8::RoundOrder S; S.s.init(M, NIN, F.G, F.bx); S.lo = 0; S.hi = nfull;
              pg8::EpiProj E{WSP(bf16, WS_PROJ), WSP(bf16, WS_FOX), WSP(float, WS_LOGF), WSP(float, WS_PROJX), WSP(bf16, WS_CQN), WSP(bf16, WS_CKVN), WSP(float, WS_CSS), WSP(float, WS_LB) + l * 1024, QSCALE_128, WSP(float, WS_HSS)};
              pg8::gemm_phase<pg8::EpiProj, pg8::RoundOrder, true, true>(ring, g, S, E, F.tid); }
            __syncthreads(); }
            PHASE_END(g0 + 0); PR_END(1);
        }
        if (EN(2) && RUN(g0 + 1)) { PR_BEGIN(2); for (int rep_ = 0; rep_ < REPS(2); ++rep_) { PH_BEGIN();
            PR_BEGIN(22); { pg8::Gemm g{WSP(bf16, WS_HN), WLAYER(bf16, l, W_IN), M, NIN, DM}; pg8::RoundOrder S; S.s.init(M, NIN, F.G, F.bx); S.lo = nfull; S.hi = 1 << 30;
              pg8::EpiProj E{WSP(bf16, WS_PROJ), WSP(bf16, WS_FOX), WSP(float, WS_LOGF), WSP(float, WS_PROJX), WSP(bf16, WS_CQN), WSP(bf16, WS_CKVN), WSP(float, WS_CSS), WSP(float, WS_LB) + l * 1024, QSCALE_128, WSP(float, WS_HSS)};
              pg8::gemm_phase<pg8::EpiProj, pg8::RoundOrder, true, true>(ring, g, S, E, F.tid); } PR_END(22);
            if (l == 0) {
                for (int ll = 0; ll < DEPTH; ++ll) {
                    pg8::Gemm g{WSP(bf16, WS_MEMN) + (size_t)ll * 512 * DM, WLAYER(bf16, ll, W_MKV), BATCH * MEMT, 1024, DM}; pg8::StaticOrder S;
                    S.init(BATCH * MEMT, 1024, F.G, (int)((F.bx + F.G - (F.G / 2 + 8 * ll) % F.G) % F.G));
                    pg8::EpiKVmem E{WSP(bf16, WS_KVMEM) + (size_t)ll * 2 * 8 * 256 * 128, WSP(bf16, WS_KVMEM) + ((size_t)ll * 2 + 1) * 8 * 256 * 128};
                    pg8::gemm_phase<pg8::EpiKVmem, pg8::StaticOrder, true, true>(ring, g, S, E, F.tid); }
            }
            __syncthreads();
            PR_BEGIN(23); { gu32* qctr = (gu32*)(P.ws + WS_CTL) + CW_Q + (l * 2 + rep_) * 64; volatile LAS unsigned* slot = F.MISC + 4;
              for (;;) {
                  if (F.tid == 0) *slot = __hip_atomic_fetch_add(qctr, 4u, RLX_AGENT);
                  LDS_WAIT(); __syncthreads();
                  const int it0 = (int)*slot;
                  __syncthreads();
                  if (it0 >= 256 + 2048) break;
                  if (it0 < 256) { for (int it = it0; it < it0 + 4; ++it) p2_rows(F, P, l, it); }
                  else { const int c0_ = it0 - 256; H1Regs R0, R1;
                      hgrn_local_load(F, P, c0_, R0); hgrn_local_load(F, P, c0_ + 1, R1); hgrn_local(F, P, c0_, R0);
                      hgrn_local_load(F, P, c0_ + 2, R0); hgrn_local(F, P, c0_ + 1, R1);
                      hgrn_local_load(F, P, c0_ + 3, R1); hgrn_local(F, P, c0_ + 2, R0); hgrn_local(F, P, c0_ + 3, R1); }
              } } PR_END(23);
            __syncthreads(); }
            PHASE_END(g0 + 1); PR_END(2);
        }
        if (EN(3) && RUN(g0 + 2)) { PR_BEGIN(3); for (int rep_ = 0; rep_ < REPS(3); ++rep_) { PH_BEGIN();
#ifndef NO_SCANS
            PR_BEGIN(30); PR_BEGIN(33); for (int it = F.vcu; it < 256; it += F.G) fox_scan(F, P, it); PR_END(33);
            PR_BEGIN(34); hgrn_scan(F, P); PR_END(34);
            __syncthreads(); PR_END(30);
#endif
#ifndef NO_QFULL
            PR_BEGIN(31); { pg8::Gemm g{WSP(bf16, WS_CQN), WLAYER(bf16, l, W_UQ), M, 3072, 768}; pg8::StaticOrder S; S.init(M, 3072, F.G, F.bx);
              pg8::EpiQfull E{WSP(bf16, WS_QN), WSP(bf16, WS_QR), WSP(float, WS_ROPE), QSCALE_MLA, WSP(float, WS_RQ)};
              pg8::gemm_phase<pg8::EpiQfull, pg8::StaticOrder, true, true>(ring, g, S, E, F.tid); } PR_END(31);
#endif
            PR_BEGIN(32); { pg8::Gemm g{WSP(bf16, WS_CKVN), WLAYER(bf16, l, W_UKV), M, 4096, 512}; pg8::StaticOrder S; S.init(M, 4096, F.G, F.bx);
              pg8::EpiKV E{WSP(bf16, WS_KN), WSP(bf16, WS_VC), WSP(float, WS_RKV)};
              pg8::gemm_phase<pg8::EpiKV, pg8::StaticOrder, true, true>(ring, g, S, E, F.tid); } PR_END(32);
            __syncthreads(); }
            PHASE_END(g0 + 2); PR_END(3);
        }
        if (EN(4) && RUN(g0 + 3)) { PR_BEGIN(4); for (int rep_ = 0; rep_ < REPS(4); ++rep_) { PH_BEGIN();
#ifndef NO_ATT
            PR_BEGIN(40); mix_attention(F, P, l);
            __syncthreads(); PR_END(40);
#endif
#ifndef NO_HOUT
            PR_BEGIN(41); { PH_BEGIN(); for (int ch = F.vcu; ch < 2048; ch += F.G) hgrn_out(F, P, ch, l); } PR_END(41);
#endif
            __syncthreads(); }
            PHASE_END(g0 + 3); PR_END(4);
        }
        if (EN(5) && RUN(g0 + 4)) { PR_BEGIN(5); for (int rep_ = 0; rep_ < REPS(5); ++rep_) { PH_BEGIN();
            pg8::Gemm g{WSP(bf16, WS_MIX), WLAYER(bf16, l, W_O), M, DM, DM}; pg8::StaticOrder S; S.init(M, DM, F.G, F.bx);
            pg8::EpiY E{WSP(bf16, WS_Y), WSP(float, WS_YSS)};
            pg8::gemm_phase<pg8::EpiY, pg8::StaticOrder, true, true>(ring, g, S, E, F.tid);
            __syncthreads(); }
            PHASE_END(g0 + 4); PR_END(5);
        }
        if (EN(6) && RUN(g0 + 5)) { PR_BEGIN(6); PH_BEGIN();
            const int gw = F.vcu * NWAVES + F.wave, NGW = F.G * NWAVES;
            if (l == 0) { for (int m = gw; m < M; m += NGW) norm_step<true, false>(F.lane, P.inp(0) + (size_t)m * DM, WSP(bf16, WS_HN) + (size_t)m * DM, WSP(bf16, WS_Y) + (size_t)m * DM, WSP(float, WS_YSS) + (size_t)m * 64, P.inp(20) + (size_t)l * DM, nullptr, WSP(float, WS_HSS) + m); }
            else { norm_rows<false, false>(F.lane, gw, NGW, M, nullptr, WSP(bf16, WS_HN), WSP(bf16, WS_Y), WSP(float, WS_YSS), P.inp(20) + (size_t)l * DM, nullptr, WSP(float, WS_HSS)); }
            PHASE_END(g0 + 5); PR_END(6);
        }
        if (EN(7) && RUN(g0 + 6)) { PR_BEGIN(7); for (int rep_ = 0; rep_ < REPS(7); ++rep_) { PH_BEGIN();
            pg8::Gemm g{WSP(bf16, WS_HN), WLAYER(bf16, l, W_MQ), M, 512, DM}; pg8::StaticOrder S; S.init(M, 512, F.G, F.bx);
            pg8::EpiQmem E{WSP(bf16, WS_QMEM), QSCALE_128, WSP(float, WS_HSS)};
            pg8::gemm_phase<pg8::EpiQmem, pg8::StaticOrder, true, true>(ring, g, S, E, F.tid);
            if (F.G == 256 && F.bx >= 128) steal_upto(F, P, Q8_TOTAL, 5);
            __syncthreads(); }
            PHASE_END(g0 + 6); PR_END(7);
        }
        if (EN(8) && RUN(g0 + 7)) { PR_BEGIN(7); for (int rep_ = 0; rep_ < REPS(8); ++rep_) { PH_BEGIN(); mem_attention(F, P, l); __syncthreads(); } PHASE_END(g0 + 7); PR_END(7); }
        if (EN(9) && RUN(g0 + 8)) { PR_BEGIN(7); for (int rep_ = 0; rep_ < REPS(9); ++rep_) { PH_BEGIN();
            pg8::Gemm g{WSP(bf16, WS_OMEM), WLAYER(bf16, l, W_MO), M, DM, 512}; pg8::StaticOrder S; S.init(M, DM, F.G, F.bx);
            pg8::EpiY E{WSP(bf16, WS_Y), WSP(float, WS_YSS)};
            pg8::gemm_phase<pg8::EpiY, pg8::StaticOrder, true, true>(ring, g, S, E, F.tid);
            __syncthreads(); }
            PHASE_END(g0 + 8); PR_END(7);
        }
        if (EN(10) && RUN(g0 + 9)) { PR_BEGIN(6); PH_BEGIN();
            const int gw = F.vcu * NWAVES + F.wave, NGW = F.G * NWAVES;
            norm_rows<false, false>(F.lane, gw, NGW, M, nullptr, WSP(bf16, WS_HN), WSP(bf16, WS_Y), WSP(float, WS_YSS), P.inp(22) + (size_t)l * DM, nullptr, WSP(float, WS_HSS));
            PHASE_END(g0 + 9); PR_END(6);
        }
        if (EN(11) && RUN(g0 + 10)) { PR_BEGIN(11); for (int rep_ = 0; rep_ < REPS(11); ++rep_) { PH_BEGIN();
            pg8::Gemm g{WSP(bf16, WS_HN), WLAYER(bf16, l, W_FF1), M, DFF, DM}; pg8::StaticOrder S; S.init(M, DFF, F.G, F.bx);
            pg8::EpiRelu2 E{WSP(bf16, WS_HID), DFF, WSP(float, WS_HSS)};
            pg8::gemm_phase<pg8::EpiRelu2, pg8::StaticOrder, true, true>(ring, g, S, E, F.tid);
            __syncthreads(); }
            PHASE_END(g0 + 10); PR_END(11);
        }
        if (EN(12) && RUN(g0 + 11)) { PR_BEGIN(12); for (int rep_ = 0; rep_ < REPS(12); ++rep_) { PH_BEGIN();
            pg8::Gemm g{WSP(bf16, WS_HID), WLAYER(bf16, l, W_FF2), M, DM, DFF}; pg8::StaticOrder S; S.init(M, DM, F.G, F.bx);
            pg8::EpiY E{WSP(bf16, WS_Y), WSP(float, WS_YSS)};
            pg8::gemm_phase<pg8::EpiY, pg8::StaticOrder, true, true>(ring, g, S, E, F.tid);
            __syncthreads(); }
            PHASE_END(g0 + 11); PR_END(12);
        }
        if (EN(13) && RUN(g0 + 12)) { PR_BEGIN(6); PH_BEGIN();
            if (l + 1 < DEPTH) steal_upto(F, P, (l + 1) * Q8_LAYER, 1 << 30);
            const int gw = F.vcu * NWAVES + F.wave, NGW = F.G * NWAVES;
            if (l + 1 < DEPTH) { norm_rows<false, false>(F.lane, gw, NGW, M, nullptr, WSP(bf16, WS_HN), WSP(bf16, WS_Y), WSP(float, WS_YSS), P.inp(24) + (size_t)l * DM, nullptr, WSP(float, WS_HSS)); }
            else { for (int m = gw; m < M; m += NGW) norm_step<false, true>(F.lane, nullptr, WSP(bf16, WS_HN) + (size_t)m * DM, WSP(bf16, WS_Y) + (size_t)m * DM, WSP(float, WS_YSS) + (size_t)m * 64, P.inp(24) + (size_t)l * DM, P.out + (size_t)m * DM, nullptr); }
            PHASE_END(g0 + 12); PR_END(6);
        }
    }
#ifdef PROBE_ID
    if (blockIdx.x == 0) { const unsigned long long t0_ = __builtin_amdgcn_s_memrealtime(), want_ = (unsigned long long)(PROBE_AMP) * pr_acc; while (__builtin_amdgcn_s_memrealtime() - t0_ < want_) __builtin_amdgcn_s_sleep(32); }
#endif
#undef RUN
#undef PHASE_END
}

#ifndef MK_PER_PHASE
#define MK_PER_PHASE 0
#endif
extern "C" void kernel_launch(void* const* d_in, const int* in_sizes, int n_in, void* d_out, int out_size, void* d_ws, size_t ws_size, hipStream_t stream) {
    static int grid = 0;
    if (grid == 0) {
        if (n_in != 25 || in_sizes[0] != M * DM || out_size != M * DM || ws_size < WS_END) { fprintf(stderr, "kernel_launch: unexpected shapes (n_in %d, in0 %d, out %d, ws %zu; need ws >= %zu); nothing launched\n", n_in, n_in > 0 ? in_sizes[0] : -1, out_size, ws_size, (size_t)WS_END); grid = -1; return; }
        int dev = 0, cus = 0, per_cu = 0;
        if (hipGetDevice(&dev) != hipSuccess || hipDeviceGetAttribute(&cus, hipDeviceAttributeMultiprocessorCount, dev) != hipSuccess) { fprintf(stderr, "kernel_launch: device query failed\n"); grid = -1; return; }
        if (hipFuncSetAttribute((const void*)trunk_fwd, hipFuncAttributeMaxDynamicSharedMemorySize, LDS_BYTES) != hipSuccess) { fprintf(stderr, "kernel_launch: hipFuncSetAttribute failed\n"); grid = -1; return; }
        if (hipOccupancyMaxActiveBlocksPerMultiprocessor(&per_cu, (const void*)trunk_fwd, NWAVES * 64, LDS_BYTES) != hipSuccess || per_cu < 1)
            fprintf(stderr, "kernel_launch: note: occupancy query reports %d workgroups per CU\n", per_cu);
        (void)hipGetLastError();
        grid = cus;
    }
    if (grid < 0) return;
    if (hipMemsetAsync((char*)d_ws + WS_CTL, 0, CTL_ZERO_BYTES, stream) != hipSuccess) { fprintf(stderr, "kernel_launch: memset failed\n"); return; }
    Args a{};
    for (int i = 0; i < 25; ++i) a.in[i] = (const float*)d_in[i];
    a.out = (float*)d_out; a.ws = (unsigned char*)d_ws;
#if MK_PER_PHASE
    for (int p = 0; p < NPHASES; ++p) { a.ph_lo = p; a.ph_hi = p + 1; hipLaunchKernelGGL(trunk_fwd, dim3(grid), dim3(NWAVES * 64), LDS_BYTES, stream, a); }
#else
    a.ph_lo = 0; a.ph_hi = NPHASES;
    hipLaunchKernelGGL(trunk_fwd, dim3(grid), dim3(NWAVES * 64), LDS_BYTES, stream, a);
#endif
    const hipError_t le = hipPeekAtLastError();
    if (le != hipSuccess) fprintf(stderr, "kernel_launch: launch failed: %s\n", hipGetErrorName(le));
}
```

```cpp
#define CV_SKD 8
#define CVB8 5440
#include <hip/hip_runtime.h>
#include <cstdio>
#include <cstdint>
namespace pg8 {
#define PG8_LAS __attribute__((address_space(3)))
typedef unsigned short bf16_t;
typedef short bf16x8 __attribute__((ext_vector_type(8)));
typedef float f32x4 __attribute__((ext_vector_type(4)));
typedef unsigned u32x4 __attribute__((ext_vector_type(4)));
constexpr int BM = 256, BK = 64, HALF = 128, HTB = HALF * BK * 2  , STAGE_BYTES = 8 * HTB, NXCD = 8, WGM = 8;

__host__ __device__ __forceinline__ int lds_byte(int r, int c) { const int st = (r >> 4) * 2 + (c >> 5), rr = r & 15, cc = c & 31, ob = rr * 64 + cc * 2; return st * 1024 + (ob ^ (((ob >> 9) & 1) << 5)); }
__host__ __device__ __forceinline__ void stage_rc(int b, int& R, int& C) { const int st = b / 1024, sb = b % 1024, swz = sb ^ (((sb >> 9) & 1) << 5); R = (st >> 1) * 16 + swz / 64; C = (st & 1) * 32 + (swz % 64) / 2; }
__host__ __device__ __forceinline__ int perm32(int rho) { const int n = rho >> 4, i = rho & 15; return 8 * (i >> 2) + 4 * n + (i & 3); }

struct Unit { int pm, pn, ko; };
struct Gemm { const bf16_t* A; const bf16_t* Bt; int M, N, K; int ld; };

struct StaticOrder {
    int nM, nN, nwg, G, c;
    __host__ __device__ void init(int M, int N, int G_, int c_) { nM = M / BM; nN = N / BM; nwg = nM * nN; G = G_; c = c_; }
    __host__ __device__ bool next(int i, Unit& u) const {
        const long L = (long)i * G + c; if (L >= nwg) return false;
        int wgid = (int)L; { const int q = nwg / NXCD, r = nwg % NXCD, xcd = wgid % NXCD, off = wgid / NXCD; wgid = (xcd < r ? xcd * (q + 1) : r * (q + 1) + (xcd - r) * q) + off; }
        const int nig = WGM * nN, gid = wgid / nig, fm = gid * WGM, gsz = (nM - fm) < WGM ? (nM - fm) : WGM;
        u.pm = fm + ((wgid % nig) % gsz); u.pn = (wgid % nig) / gsz; u.ko = 0; return true;
    }
    __device__ __forceinline__ void a_ready(const Unit&) const {}
    __device__ __forceinline__ void done(const Unit&) const {}
};

struct HalfKOrder {
    StaticOrder s; int round, c, khalf;
    __device__ __forceinline__ bool next(int i, Unit& u) const { if (i > 0 || !s.next(round, u)) return false; u.ko = (c >> 7) * khalf; return true; }
    __device__ __forceinline__ void a_ready(const Unit&) const {}
    __device__ __forceinline__ void done(const Unit&) const {}
};
struct RoundOrder {
    StaticOrder s; int lo, hi;
    __device__ __forceinline__ bool next(int i, Unit& u) const { return (i + lo < hi) && s.next(i + lo, u); }
    __device__ __forceinline__ void a_ready(const Unit&) const {}
    __device__ __forceinline__ void done(const Unit&) const {}
};
__device__ __forceinline__ unsigned cvt_pk_bf16(float lo, float hi) { unsigned r; asm volatile("v_cvt_pk_bf16_f32 %0, %1, %2" : "=v"(r) : "v"(lo), "v"(hi)); return r; }
typedef float f32x2 __attribute__((ext_vector_type(2)));
__device__ __forceinline__ u32x4 pack8_bf16(const f32x4& v0, const f32x4& v1) { u32x4 w; w.x = cvt_pk_bf16(v0[0], v0[1]); w.y = cvt_pk_bf16(v0[2], v0[3]); w.z = cvt_pk_bf16(v1[0], v1[1]); w.w = cvt_pk_bf16(v1[2], v1[3]); return w; }

struct EpiBf16S {
    static constexpr bool PERM = true, AFTER_DRAIN = false;
    bf16_t* O; int ldc; float scale;
    __device__ __forceinline__ void operator()(const f32x4 (&acc)[2][2][4][2], const Unit& u, int wr, int wc, int fr, int fq) const {
        const int row0 = u.pm * BM + wr * 64 + fr, col0 = u.pn * BM + wc * 32 + 8 * fq;
#pragma unroll
        for (int ai = 0; ai < 2; ++ai)
#pragma unroll
            for (int m = 0; m < 4; ++m) { bf16_t* rowp = O + (size_t)(row0 + ai * HALF + m * 16) * ldc + col0;
#pragma unroll
                for (int bj = 0; bj < 2; ++bj) *(u32x4*)(rowp + bj * HALF) = pack8_bf16(acc[ai][bj][m][0] * scale, acc[ai][bj][m][1] * scale); }
    }
};
struct EpiRelu2 {
    static constexpr bool PERM = true, AFTER_DRAIN = false;
    bf16_t* O; int ldc; const float* rs;
    __device__ __forceinline__ void operator()(const f32x4 (&acc)[2][2][4][2], const Unit& u, int wr, int wc, int fr, int fq) const {
        const int row0 = u.pm * BM + wr * 64 + fr, col0 = u.pn * BM + wc * 32 + 8 * fq;
        const f32x4 z4 = {0.f, 0.f, 0.f, 0.f};
        float rv[2][4];
#pragma unroll
        for (int ai = 0; ai < 2; ++ai)
#pragma unroll
            for (int m = 0; m < 4; ++m) rv[ai][m] = rs[row0 + ai * HALF + m * 16];
#pragma unroll
        for (int ai = 0; ai < 2; ++ai)
#pragma unroll
            for (int m = 0; m < 4; ++m) { bf16_t* rowp = O + (size_t)(row0 + ai * HALF + m * 16) * ldc + col0; const float r2 = rv[ai][m] * rv[ai][m];
#pragma unroll
                for (int bj = 0; bj < 2; ++bj) { f32x4 a = __builtin_elementwise_max(acc[ai][bj][m][0], z4), b = __builtin_elementwise_max(acc[ai][bj][m][1], z4);
                    *(u32x4*)(rowp + bj * HALF) = pack8_bf16(a * a * r2, b * b * r2); } }
    }
};
struct EpiY {
    static constexpr bool PERM = true, AFTER_DRAIN = false;
    bf16_t* Y; float* yss;
    __device__ __forceinline__ void operator()(const f32x4 (&acc)[2][2][4][2], const Unit& u, int wr, int wc, int fr, int fq) const {
        const int row0 = u.pm * BM + wr * 64 + fr, col0 = u.pn * BM + wc * 32 + 8 * fq;
#pragma unroll
        for (int ai = 0; ai < 2; ++ai)
#pragma unroll
            for (int m = 0; m < 4; ++m) { const size_t r = (size_t)(row0 + ai * HALF + m * 16); bf16_t* rowp = Y + r * 4096 + col0; float s = 0.f;
#pragma unroll
                for (int bj = 0; bj < 2; ++bj) { const f32x4 a = acc[ai][bj][m][0], c = acc[ai][bj][m][1];
                    s += (a[0] * a[0] + a[1] * a[1]) + (a[2] * a[2] + a[3] * a[3]) + (c[0] * c[0] + c[1] * c[1]) + (c[2] * c[2] + c[3] * c[3]);
                    *(u32x4*)(rowp + bj * HALF) = pack8_bf16(a, c); }
                s += __shfl_xor(s, 16); s += __shfl_xor(s, 32);
                if (fq == 0) yss[r * 64 + u.pn * 4 + wc] = s; }
    }
};
template <int RS> __device__ __forceinline__ void store_hm(const f32x4 (&acc)[2][2][4][2], int bj, bf16_t* dst, float sc) {
#pragma unroll
    for (int ai = 0; ai < 2; ++ai)
#pragma unroll
        for (int m = 0; m < 4; ++m) *(u32x4*)(dst + (size_t)(ai * HALF + m * 16) * RS) = pack8_bf16(acc[ai][bj][m][0] * sc, acc[ai][bj][m][1] * sc);
}
struct EpiProj {
    static constexpr bool PERM = true, AFTER_DRAIN = false;
    bf16_t* proj; bf16_t* fox; float* logf; float* projx; bf16_t* cqb; bf16_t* ckvb; float* css; const float* lb; float fqscale; const float* rs;
    __device__ __forceinline__ void operator()(const f32x4 (&acc)[2][2][4][2], const Unit& u, int wr, int wc, int fr, int fq) const {
        const int row0 = u.pm * BM + wr * 64 + fr, cl = wc * 32 + 8 * fq;
#define RVLOAD() float rv[2][4]; _Pragma("unroll") for (int ai = 0; ai < 2; ++ai) _Pragma("unroll") for (int m = 0; m < 4; ++m) rv[ai][m] = rs[row0 + ai * HALF + m * 16]
#define RV(ai, m) rv[ai][m]
        if (u.pn == 31) {
            RVLOAD();
#pragma unroll
            for (int ai = 0; ai < 2; ++ai)
#pragma unroll
                for (int m = 0; m < 4; ++m) { float* rowp = projx + (size_t)(row0 + ai * HALF + m * 16) * 256 + cl; const float rvv = RV(ai, m);
#pragma unroll
                    for (int bj = 0; bj < 2; ++bj) { *(f32x4*)(rowp + bj * HALF) = acc[ai][bj][m][0] * rvv; *(f32x4*)(rowp + bj * HALF + 4) = acc[ai][bj][m][1] * rvv; } }
        } else if (u.pn >= 26 && u.pn < 31) {
            RVLOAD(); const bool isq = u.pn < 29; bf16_t* dst = isq ? cqb + (u.pn - 26) * BM : ckvb + (u.pn - 29) * BM; const int ld = isq ? 768 : 512;
#pragma unroll
            for (int ai = 0; ai < 2; ++ai)
#pragma unroll
                for (int m = 0; m < 4; ++m) { const size_t r = (size_t)(row0 + ai * HALF + m * 16); const float rvv = RV(ai, m); float s = 0.f;
#pragma unroll
                    for (int bj = 0; bj < 2; ++bj) { const f32x4 a = acc[ai][bj][m][0] * rvv, c = acc[ai][bj][m][1] * rvv;
                        s += (a[0] * a[0] + a[1] * a[1]) + (a[2] * a[2] + a[3] * a[3]) + (c[0] * c[0] + c[1] * c[1]) + (c[2] * c[2] + c[3] * c[3]);
                        *(u32x4*)(dst + r * ld + cl + bj * HALF) = pack8_bf16(a, c); }
                    s += __shfl_xor(s, 16); s += __shfl_xor(s, 32);
                    if (fq == 0) css[r * 20 + (u.pn - 26) * 4 + wc] = s; }
        } else if (u.pn >= 14 && u.pn < 26) {
            const int part = (u.pn - 14) >> 2, hp = (u.pn - 14) & 3, b = u.pm >> 5, s0 = (u.pm & 31) * BM + wr * 64 + fr;
            const float sc = part == 0 ? fqscale : 1.0f; RVLOAD();
#pragma unroll
            for (int bj = 0; bj < 2; ++bj) { bf16_t* dst = fox + ((size_t)(part * 16 + b * 8 + 2 * hp + bj) * 8192 + s0) * 128 + cl;
#pragma unroll
                for (int ai = 0; ai < 2; ++ai)
#pragma unroll
                    for (int m = 0; m < 4; ++m) { const float f = sc * RV(ai, m); *(u32x4*)(dst + (size_t)(ai * HALF + m * 16) * 128) = pack8_bf16(acc[ai][bj][m][0] * f, acc[ai][bj][m][1] * f); } }
        } else if (u.pn >= 4 && u.pn < 8) {
            const int c0 = (u.pn - 4) * BM + cl;
            f32x4 lbv[2][2];
#pragma unroll
            for (int bj = 0; bj < 2; ++bj) { lbv[bj][0] = *(const f32x4*)(lb + c0 + bj * HALF); lbv[bj][1] = *(const f32x4*)(lb + c0 + bj * HALF + 4); }
#pragma unroll
            for (int ai = 0; ai < 2; ++ai)
#pragma unroll
                for (int m = 0; m < 4; ++m) { const size_t r = (size_t)(row0 + ai * HALF + m * 16); const float rvv = rs[r];
#pragma unroll
                    for (int bj = 0; bj < 2; ++bj) { f32x4 lf[2], ka[2];
#pragma unroll
                        for (int n = 0; n < 2; ++n)
#pragma unroll
                            for (int j = 0; j < 4; ++j) { const float z = acc[ai][bj][m][n][j] * rvv, L = lbv[bj][n][j];
                                const float t = __expf(-fabsf(z)), rr = __builtin_amdgcn_rcpf(1.0f + t), sm = t * rr;
                                const float s = z >= 0.f ? rr : sm, sn = z >= 0.f ? sm : rr;
                                const float f = L + (1.0f - L) * s;
                                lf[n][j] = __logf(fmaxf(f, 1e-30f)); ka[n][j] = (1.0f - L) * sn; }
                        *(f32x4*)(logf + r * 1024 + c0 + bj * HALF) = lf[0]; *(f32x4*)(logf + r * 1024 + c0 + bj * HALF + 4) = lf[1];
                        *(u32x4*)(proj + r * 4096 + 1024 + c0 + bj * HALF) = pack8_bf16(ka[0], ka[1]); } }
        } else {
            const int c0 = (u.pn < 14 ? u.pn * BM : 3584 + (u.pn - 32) * BM) + cl; RVLOAD();
#pragma unroll
            for (int ai = 0; ai < 2; ++ai)
#pragma unroll
                for (int m = 0; m < 4; ++m) { bf16_t* rowp = proj + (size_t)(row0 + ai * HALF + m * 16) * 4096 + c0; const float rvv = RV(ai, m);
#pragma unroll
                    for (int bj = 0; bj < 2; ++bj) *(u32x4*)(rowp + bj * HALF) = pack8_bf16(acc[ai][bj][m][0] * rvv, acc[ai][bj][m][1] * rvv); }
        }
    }
};
#undef RV
#undef RVLOAD
struct EpiQfull {
    static constexpr bool PERM = true, AFTER_DRAIN = false;
    bf16_t* qn; bf16_t* qr; const float* rope; float qscale; const float* rq;
    __device__ __forceinline__ void operator()(const f32x4 (&acc)[2][2][4][2], const Unit& u, int wr, int wc, int fr, int fq) const {
        const int row0 = u.pm * BM + wr * 64 + fr, cl = wc * 32 + 8 * fq, b = u.pm >> 5, s0 = (u.pm & 31) * BM + wr * 64 + fr;
        float rv[2][4];
#pragma unroll
        for (int ai = 0; ai < 2; ++ai)
#pragma unroll
            for (int m = 0; m < 4; ++m) rv[ai][m] = qscale * rq[row0 + ai * HALF + m * 16];
        if (u.pn < 8) {
#pragma unroll
            for (int bj = 0; bj < 2; ++bj) { bf16_t* dst = qn + ((size_t)(b * 16 + 2 * u.pn + bj) * 8192 + s0) * 128 + cl;
#pragma unroll
                for (int ai = 0; ai < 2; ++ai)
#pragma unroll
                    for (int m = 0; m < 4; ++m) { const float f = rv[ai][m]; *(u32x4*)(dst + (size_t)(ai * HALF + m * 16) * 128) = pack8_bf16(acc[ai][bj][m][0] * f, acc[ai][bj][m][1] * f); } }
        } else {
            const int i0 = (cl & 63) >> 1;
#pragma unroll
            for (int ai = 0; ai < 2; ++ai) {
                f32x4 cs[4][2];
#pragma unroll
                for (int m = 0; m < 4; ++m) { const size_t r = (size_t)(row0 + ai * HALF + m * 16); cs[m][0] = *(const f32x4*)(rope + (r * 32 + i0) * 2); cs[m][1] = *(const f32x4*)(rope + (r * 32 + i0) * 2 + 4); }
#pragma unroll
                for (int m = 0; m < 4; ++m) { const int s = s0 + ai * HALF + m * 16; const float qs = rv[ai][m]; const f32x4 cs0 = cs[m][0], cs1 = cs[m][1];
#pragma unroll
                    for (int bj = 0; bj < 2; ++bj) { const int head = 4 * (u.pn - 8) + 2 * bj + (cl >> 6);
                        const f32x4 a = acc[ai][bj][m][0], bq = acc[ai][bj][m][1];
                        f32x4 oa, ob;
                        oa[0] = (a[0] * cs0[0] - a[1] * cs0[1]) * qs; oa[1] = (a[0] * cs0[1] + a[1] * cs0[0]) * qs;
                        oa[2] = (a[2] * cs0[2] - a[3] * cs0[3]) * qs; oa[3] = (a[2] * cs0[3] + a[3] * cs0[2]) * qs;
                        ob[0] = (bq[0] * cs1[0] - bq[1] * cs1[1]) * qs; ob[1] = (bq[0] * cs1[1] + bq[1] * cs1[0]) * qs;
                        ob[2] = (bq[2] * cs1[2] - bq[3] * cs1[3]) * qs; ob[3] = (bq[2] * cs1[3] + bq[3] * cs1[2]) * qs;
                        *(u32x4*)(qr + ((size_t)(b * 16 + head) * 8192 + s) * 64 + (cl & 63)) = pack8_bf16(oa, ob); } }
                asm volatile("" ::: "memory"); }
        }
    }
};
struct EpiKV {
    static constexpr bool PERM = true, AFTER_DRAIN = false;
    bf16_t* kn; bf16_t* vc; const float* rkv;
    __device__ __forceinline__ void operator()(const f32x4 (&acc)[2][2][4][2], const Unit& u, int wr, int wc, int fr, int fq) const {
        const int cl = wc * 32 + 8 * fq, b = u.pm >> 5, s0 = (u.pm & 31) * BM + wr * 64 + fr;
        const size_t off = ((size_t)(b * 16 + u.pn) * 8192 + s0) * 128 + cl;
        float rv[2][4];
#pragma unroll
        for (int ai = 0; ai < 2; ++ai)
#pragma unroll
            for (int m = 0; m < 4; ++m) rv[ai][m] = rkv[u.pm * BM + wr * 64 + fr + ai * HALF + m * 16];
#pragma unroll
        for (int ai = 0; ai < 2; ++ai)
#pragma unroll
            for (int m = 0; m < 4; ++m) { const float f = rv[ai][m]; const size_t o2 = off + (size_t)(ai * HALF + m * 16) * 128;
                *(u32x4*)(kn + o2) = pack8_bf16(acc[ai][0][m][0] * f, acc[ai][0][m][1] * f); *(u32x4*)(vc + o2) = pack8_bf16(acc[ai][1][m][0] * f, acc[ai][1][m][1] * f); }
    }
};
struct EpiQmem {
    static constexpr bool PERM = true, AFTER_DRAIN = false;
    bf16_t* qm; float scale; const float* rs;
    __device__ __forceinline__ void operator()(const f32x4 (&acc)[2][2][4][2], const Unit& u, int wr, int wc, int fr, int fq) const {
        const int cl = wc * 32 + 8 * fq, b = u.pm >> 5, s0 = (u.pm & 31) * BM + wr * 64 + fr;
        float rv[2][4];
#pragma unroll
        for (int ai = 0; ai < 2; ++ai)
#pragma unroll
            for (int m = 0; m < 4; ++m) rv[ai][m] = scale * rs[u.pm * BM + wr * 64 + fr + ai * HALF + m * 16];
#pragma unroll
        for (int bj = 0; bj < 2; ++bj) { bf16_t* dst = qm + ((size_t)(b * 4 + 2 * u.pn + bj) * 8192 + s0) * 128 + cl;
#pragma unroll
            for (int ai = 0; ai < 2; ++ai)
#pragma unroll
                for (int m = 0; m < 4; ++m) { const float f = rv[ai][m]; *(u32x4*)(dst + (size_t)(ai * HALF + m * 16) * 128) = pack8_bf16(acc[ai][bj][m][0] * f, acc[ai][bj][m][1] * f); } }
    }
};
struct EpiKVmem {
    static constexpr bool PERM = true, AFTER_DRAIN = false;
    bf16_t* km; bf16_t* vm;
    __device__ __forceinline__ void operator()(const f32x4 (&acc)[2][2][4][2], const Unit& u, int wr, int wc, int fr, int fq) const {
        const int cl = wc * 32 + 8 * fq, b = u.pm, s0 = wr * 64 + fr;
        bf16_t* base = u.pn < 2 ? km : vm; const int hp = u.pn & 1;
#pragma unroll
        for (int bj = 0; bj < 2; ++bj) store_hm<128>(acc, bj, base + ((size_t)(b * 4 + 2 * hp + bj) * 256 + s0) * 128 + cl, 1.0f);
    }
};
template <class Epi, class Sched, bool ALIGN_EPI = false, bool SP2 = false>
__device__ __forceinline__ void gemm_phase(PG8_LAS unsigned char* lds, const Gemm g, const Sched& S, const Epi& E, int tid_in) {
    int tid_ = tid_in; asm volatile("" : "+v"(tid_));
    const int tid = tid_, wid = __builtin_amdgcn_readfirstlane(tid >> 6), lane = tid & 63, wr = wid >> 2, wc = wid & 3, fr = lane & 15, fq = lane >> 4;
    const int K = g.ld ? g.ld : g.K  , nt = g.K / BK;
    unsigned voffA[2], voffB[2];
#pragma unroll
    for (int i = 0; i < 2; ++i) { int R, C; stage_rc(tid * 16 + i * 8192, R, C); const int Rb = Epi::PERM ? ((R & ~31) + perm32(R & 31)) : R;
        voffA[i] = (unsigned)(R * K + C) * 2u; voffB[i] = (unsigned)(Rb * K + C) * 2u; }
    const size_t kstep = (size_t)(BK * 2);
    const size_t hstep = (size_t)HALF * K * 2;
    const size_t tstep = 2 * hstep;
    const unsigned ldsw = (unsigned)wid * 1024u;
    const int aoff = lds_byte(wr * 64 + fr, fq * 8), boff = lds_byte(wc * 32 + fr, fq * 8);
#define PG8_SA(b, h) (((b) * 2 + (h)) * HTB)
#define PG8_SB(b, h) ((4 + (b) * 2 + (h)) * HTB)
#define PG8_STAGE(bufoff, gbase, voff) do { _Pragma("unroll") for (int _i = 0; _i < 2; ++_i) \
        __builtin_amdgcn_global_load_lds((const unsigned*)((const char*)(gbase) + (voff)[_i]), (PG8_LAS unsigned*)(lds + (bufoff) + ldsw + _i * 8192), 16, 0, 0); } while (0)
#define PG8_LDA(dst, b, h) do { _Pragma("unroll") for (int m = 0; m < 4; ++m) _Pragma("unroll") for (int k = 0; k < 2; ++k) dst[m][k] = *(const PG8_LAS bf16x8*)(lds + PG8_SA(b, h) + aoff + m * 2048 + k * 1024); } while (0)
#define PG8_LDB(dst, b, h) do { _Pragma("unroll") for (int n = 0; n < 2; ++n) _Pragma("unroll") for (int k = 0; k < 2; ++k) dst[n][k] = *(const PG8_LAS bf16x8*)(lds + PG8_SB(b, h) + boff + n * 2048 + k * 1024); } while (0)
#define PG8_MMA(ai, bj, At, Bt) do { __builtin_amdgcn_s_setprio(1); _Pragma("unroll") for (int m = 0; m < 4; ++m) _Pragma("unroll") for (int n = 0; n < 2; ++n) _Pragma("unroll") for (int k = 0; k < 2; ++k) \
        acc[ai][bj][m][n] = __builtin_amdgcn_mfma_f32_16x16x32_bf16(Bt[n][k], At[m][k], acc[ai][bj][m][n], 0, 0, 0); __builtin_amdgcn_s_setprio(0); } while (0)
#define PG8_WAIT_V(n) asm volatile("s_waitcnt vmcnt(" #n ")" ::: "memory")
#define PG8_WAIT_L(n) asm volatile("s_waitcnt lgkmcnt(" #n ")" ::: "memory")
#define PG8_BAR __builtin_amdgcn_s_barrier()
#define PG8_SCHED __builtin_amdgcn_sched_barrier(0)
    Unit cur, nxt; int ui = 0;
    if (!S.next(0, cur)) return;
    f32x4 acc[2][2][4][2];
#pragma unroll
    for (int a = 0; a < 2; ++a)
#pragma unroll
        for (int b = 0; b < 2; ++b)
#pragma unroll
            for (int m = 0; m < 4; ++m)
#pragma unroll
                for (int n = 0; n < 2; ++n) acc[a][b][m][n] = (f32x4){0.f, 0.f, 0.f, 0.f};
    bf16x8 At[4][2], B0[2][2], B1[2][2];
    const char* cA = (const char*)g.A + (size_t)cur.pm * tstep + (size_t)cur.ko * 2; const char* cB = (const char*)g.Bt + (size_t)cur.pn * tstep + (size_t)cur.ko * 2;
    S.a_ready(cur);
    if constexpr (SP2) {
        PG8_STAGE(PG8_SB(0, 0), cB, voffB); PG8_STAGE(PG8_SB(0, 1), cB + hstep, voffB); PG8_STAGE(PG8_SA(0, 0), cA, voffA); PG8_STAGE(PG8_SA(0, 1), cA + hstep, voffA);
        if (wr == 1) PG8_BAR;
        PG8_WAIT_V(2); PG8_BAR;
        PG8_STAGE(PG8_SB(1, 0), cB + kstep, voffB); PG8_STAGE(PG8_SA(1, 0), cA + kstep, voffA); PG8_STAGE(PG8_SB(1, 1), cB + hstep + kstep, voffB);
        PG8_WAIT_V(6); PG8_BAR;
    } else {
        PG8_STAGE(PG8_SB(0, 0), cB, voffB); PG8_STAGE(PG8_SA(0, 0), cA, voffA); PG8_STAGE(PG8_SB(0, 1), cB + hstep, voffB); PG8_STAGE(PG8_SA(0, 1), cA + hstep, voffA);
        if (wr == 1) PG8_BAR;
        PG8_WAIT_V(4); PG8_BAR;
        PG8_STAGE(PG8_SB(1, 0), cB + kstep, voffB); PG8_STAGE(PG8_SA(1, 0), cA + kstep, voffA); PG8_STAGE(PG8_SB(1, 1), cB + hstep + kstep, voffB);
        PG8_WAIT_V(6); PG8_BAR;
    }
    for (;;) {
        const bool has_next = S.next(ui + 1, nxt);
        const char* nA = has_next ? (const char*)g.A + (size_t)nxt.pm * tstep + (size_t)nxt.ko * 2 : cA; const char* nB = has_next ? (const char*)g.Bt + (size_t)nxt.pn * tstep + (size_t)nxt.ko * 2 : cB;
        for (int t = 0; t < nt; t += 2) {
            const bool last = (t == nt - 2);
            const char* a1 = cA + (size_t)(t + 1) * kstep;
            const char* a2 = last ? nA : cA + (size_t)(t + 2) * kstep; const char* b2 = last ? nB : cB + (size_t)(t + 2) * kstep;
            const char* a3 = a2 + kstep; const char* b3 = b2 + kstep;
            if (last && has_next) S.a_ready(nxt);
            if constexpr (SP2) {
            PG8_LDB(B0, 0, 0); PG8_LDB(B1, 0, 1); PG8_SCHED; PG8_LDA(At, 0, 0); PG8_STAGE(PG8_SA(1, 1), a1 + hstep, voffA);
            PG8_WAIT_V(8); PG8_WAIT_L(0); PG8_BAR; PG8_MMA(0, 0, At, B0); PG8_MMA(0, 1, At, B1); PG8_BAR; PG8_SCHED;
            PG8_LDA(At, 0, 1); PG8_STAGE(PG8_SB(0, 0), b2, voffB); PG8_STAGE(PG8_SB(0, 1), b2 + hstep, voffB); PG8_STAGE(PG8_SA(0, 0), a2, voffA);
            PG8_WAIT_V(8); PG8_WAIT_L(0); PG8_BAR; PG8_MMA(1, 0, At, B0); PG8_MMA(1, 1, At, B1); PG8_BAR; PG8_SCHED;
            PG8_LDB(B0, 1, 0); PG8_LDB(B1, 1, 1); PG8_SCHED; PG8_LDA(At, 1, 0); PG8_STAGE(PG8_SA(0, 1), a2 + hstep, voffA);
            PG8_WAIT_V(8); PG8_WAIT_L(0); PG8_BAR; PG8_MMA(0, 0, At, B0); PG8_MMA(0, 1, At, B1); PG8_BAR; PG8_SCHED;
            PG8_LDA(At, 1, 1); PG8_STAGE(PG8_SB(1, 0), b3, voffB); PG8_STAGE(PG8_SB(1, 1), b3 + hstep, voffB); PG8_STAGE(PG8_SA(1, 0), a3, voffA);
            PG8_WAIT_V(8); PG8_WAIT_L(0); PG8_BAR; PG8_MMA(1, 0, At, B0); PG8_MMA(1, 1, At, B1); PG8_BAR; PG8_SCHED;
            } else {
            PG8_LDB(B0, 0, 0); PG8_SCHED; PG8_LDA(At, 0, 0); PG8_STAGE(PG8_SA(1, 1), a1 + hstep, voffA);
            PG8_WAIT_L(8); PG8_BAR; PG8_WAIT_L(0); PG8_MMA(0, 0, At, B0); PG8_BAR; PG8_SCHED;
            PG8_LDB(B1, 0, 1); PG8_STAGE(PG8_SB(0, 0), b2, voffB);
            PG8_BAR; PG8_WAIT_L(0); PG8_MMA(0, 1, At, B1); PG8_BAR;
            PG8_LDA(At, 0, 1); PG8_STAGE(PG8_SA(0, 0), a2, voffA);
            PG8_BAR; PG8_WAIT_L(0); PG8_MMA(1, 0, At, B0); PG8_BAR; PG8_SCHED;
            PG8_STAGE(PG8_SB(0, 1), b2 + hstep, voffB);
            PG8_WAIT_V(6); PG8_BAR; PG8_MMA(1, 1, At, B1); PG8_BAR;
            PG8_LDB(B0, 1, 0); PG8_SCHED; PG8_LDA(At, 1, 0); PG8_STAGE(PG8_SA(0, 1), a2 + hstep, voffA);
            PG8_WAIT_L(8); PG8_BAR; PG8_WAIT_L(0); PG8_MMA(0, 0, At, B0); PG8_BAR; PG8_SCHED;
            PG8_LDB(B1, 1, 1); PG8_STAGE(PG8_SB(1, 0), b3, voffB);
            PG8_BAR; PG8_WAIT_L(0); PG8_MMA(0, 1, At, B1); PG8_BAR;
            PG8_LDA(At, 1, 1); PG8_STAGE(PG8_SA(1, 0), a3, voffA);
            PG8_BAR; PG8_WAIT_L(0); PG8_MMA(1, 0, At, B0); PG8_BAR; PG8_SCHED;
            PG8_STAGE(PG8_SB(1, 1), b3 + hstep, voffB);
            PG8_WAIT_V(6); PG8_BAR; PG8_MMA(1, 1, At, B1); PG8_BAR;
            }
        }
        if constexpr (ALIGN_EPI) { if (wr == 0) PG8_BAR; }
        if constexpr (!Epi::AFTER_DRAIN) { E(acc, cur, wr, wc, fr, fq); S.done(cur); }
        if (!has_next) break;
#pragma unroll
        for (int a = 0; a < 2; ++a)
#pragma unroll
            for (int b = 0; b < 2; ++b)
#pragma unroll
                for (int m = 0; m < 4; ++m)
#pragma unroll
                    for (int n = 0; n < 2; ++n) acc[a][b][m][n] = (f32x4){0.f, 0.f, 0.f, 0.f};
        cur = nxt; cA = nA; cB = nB; ++ui;
        if constexpr (ALIGN_EPI) { if (wr == 1) PG8_BAR; }
    }
    PG8_WAIT_V(0);
    if constexpr (!ALIGN_EPI) { if (wr == 0) PG8_BAR; }
    PG8_BAR;
    if constexpr (Epi::AFTER_DRAIN) { E.fused(acc, cur, wr, wc, fr, fq, lds, wid, lane); S.done(cur); }
#undef PG8_SA
#undef PG8_SB
#undef PG8_STAGE
#undef PG8_LDA
#undef PG8_LDB
#undef PG8_MMA
#undef PG8_WAIT_V
#undef PG8_WAIT_L
#undef PG8_BAR
#undef PG8_SCHED
}
}
namespace att {
typedef unsigned short bf16;
typedef short bf16x8 __attribute__((ext_vector_type(8)));
typedef short s16x4 __attribute__((ext_vector_type(4)));
typedef float f32x16 __attribute__((ext_vector_type(16)));
typedef float f32x4 __attribute__((ext_vector_type(4)));
typedef unsigned u32x4 __attribute__((ext_vector_type(4)));
constexpr int NW = 8, QBLK = 32, KVBLK = 64, QB = NW * QBLK, D = 128;
constexpr int SHM_V = KVBLK * D * 2, SHM_K = KVBLK * D * 2, XROW = 144, SHM_X = KVBLK * XROW;
constexpr int OFF_V = 0, OFF_K = 2 * SHM_V, OFF_X = OFF_K + 2 * SHM_K, OFF_WS = OFF_X + 2 * SHM_X, OFF_QX = OFF_WS + NW * 64 * 4;
constexpr int QL = 5;
constexpr int QXW = (4 + QL) * 1024, ATT_LDS_BYTES = OFF_QX + NW * QXW;
constexpr float THR = 11.5f;
constexpr float RMS_EPS = 1e-6f;

#define KSWZ(row, colB) ((row) * 256 + ((colB) ^ (((row) & 7) << 4)))
#define SBAR() __builtin_amdgcn_sched_barrier(0)
__device__ __forceinline__ int v_st(int k, int c) { const int kk = (k & ~0xC) | ((k & 4) << 1) | ((k & 8) >> 1); return ((kk >> 3) * 4 + (c >> 5)) * 512 + ((kk & 7) * 32 + (c & 31)) * 2; }
__device__ __forceinline__ int v_rd_base(int lane) { return ((lane & 3) << 3) | (((lane >> 2) & 3) << 6) | (((lane >> 4) & 1) << 5) | (((lane >> 5) & 1) << 8); }
constexpr int v_rd_off(int d0, int ks, int half) { return d0 * 512 + ks * 4096 + half * 2048; }
__device__ __forceinline__ int crow(int r, int hi) { return (r & 3) + 8 * (r >> 2) + 4 * hi; }
__device__ __forceinline__ unsigned cvtpk(float lo, float hi) { unsigned r; asm volatile("v_cvt_pk_bf16_f32 %0, %1, %2" : "=v"(r) : "v"(lo), "v"(hi)); return r; }
__device__ __forceinline__ bf16x8 load8(const bf16* p) { return *reinterpret_cast<const bf16x8*>(p); }
__device__ __forceinline__ void mask_tile(f32x16& p0, f32x16& p1, int dq, unsigned W) {
    const float NEG = -__builtin_inff();
#pragma unroll
    for (int r = 0; r < 16; ++r) {
        const int c = (r & 3) + 8 * (r >> 2);
        if ((unsigned)(dq - c) >= W) p0[r] = NEG;
        if ((unsigned)(dq - c - 32) >= W) p1[r] = NEG;
    }
}
__device__ __forceinline__ void partialSM(f32x16& p0, f32x16& p1, float& m_reg, float& mn, float& alpha) {
    float pmax = p0[0]; for (int r = 1; r < 16; ++r) pmax = fmaxf(pmax, p0[r]); for (int r = 0; r < 16; ++r) pmax = fmaxf(pmax, p1[r]);
    { auto rr = __builtin_amdgcn_permlane32_swap(__float_as_uint(pmax), __float_as_uint(pmax), false, false);
      pmax = fmaxf(__uint_as_float(rr[0]), __uint_as_float(rr[1])); }
    if (__builtin_expect(__all((pmax - m_reg) <= THR), 1)) { mn = m_reg; alpha = 1.f; }
    else { mn = fmaxf(m_reg, pmax); alpha = __builtin_amdgcn_exp2f(m_reg - mn); m_reg = mn; }
    for (int r = 0; r < 16; ++r) p0[r] = p0[r] - mn; for (int r = 0; r < 16; ++r) p1[r] = p1[r] - mn;
    for (int r = 0; r < 16; ++r) p0[r] = __builtin_amdgcn_exp2f(p0[r]);
}
__device__ __forceinline__ void finishSM(f32x16& p0, f32x16& p1, float alpha, float& l_reg, bf16x8& pa0, bf16x8& pa1, bf16x8& pa2, bf16x8& pa3) {
    for (int r = 0; r < 16; ++r) p1[r] = __builtin_amdgcn_exp2f(p1[r]);
    float ps = 0; for (int r = 0; r < 16; ++r) ps += p0[r]; for (int r = 0; r < 16; ++r) ps += p1[r];
    { auto rr = __builtin_amdgcn_permlane32_swap(__float_as_uint(ps), __float_as_uint(ps), false, false);
      ps = __uint_as_float(rr[0]) + __uint_as_float(rr[1]); }
    l_reg = l_reg * alpha + ps;
#define PK4(P, B_, OUT) do { unsigned a0 = cvtpk(P[B_+0], P[B_+1]), a1 = cvtpk(P[B_+2], P[B_+3]);                          \
        unsigned b0 = cvtpk(P[B_+4], P[B_+5]), b1 = cvtpk(P[B_+6], P[B_+7]);                                             \
        auto r0 = __builtin_amdgcn_permlane32_swap(a0, b0, false, false); auto r1 = __builtin_amdgcn_permlane32_swap(a1, b1, false, false); \
        u32x4 w = {r0[0], r1[0], r0[1], r1[1]}; OUT = *reinterpret_cast<bf16x8*>(&w); } while (0)
    PK4(p0, 0, pa0); PK4(p0, 8, pa1); PK4(p1, 0, pa2); PK4(p1, 8, pa3);
#undef PK4
}
template <int KB, bool EXT>
__device__ __forceinline__ void qkt(f32x16& p0, f32x16& p1, const char* K_lds, const char* X_lds, int r32, int hi, const bf16x8* qr, const char* qxl) {
    p0 = f32x16{}; p1 = f32x16{};
    const char* kb[4];
#pragma unroll
    for (int dd = 0; dd < 4; ++dd) kb[dd] = K_lds + KB * SHM_K + KSWZ(r32, (dd * 16 + hi * 8) * 2);
#pragma unroll
    for (int d0 = 0; d0 < 8; ++d0) { const char* a = kb[d0 & 3] + (d0 >> 2) * 128;
        bf16x8 b0 = *reinterpret_cast<const bf16x8*>(a);
        bf16x8 b1 = *reinterpret_cast<const bf16x8*>(a + 32 * 256);
        bf16x8 qf; if (EXT && d0 >= 8 - QL) qf = *reinterpret_cast<const bf16x8*>(qxl + (4 + d0 - (8 - QL)) * 1024); else qf = qr[d0];
        p0 = __builtin_amdgcn_mfma_f32_32x32x16_bf16(b0, qf, p0, 0, 0, 0);
        p1 = __builtin_amdgcn_mfma_f32_32x32x16_bf16(b1, qf, p1, 0, 0, 0); }
    if constexpr (EXT) { const char* xb = X_lds + KB * SHM_X + r32 * XROW + hi * 16;
#pragma unroll
        for (int dd = 0; dd < 4; ++dd) {
            bf16x8 b0 = *reinterpret_cast<const bf16x8*>(xb + dd * 32);
            bf16x8 b1 = *reinterpret_cast<const bf16x8*>(xb + dd * 32 + 32 * XROW);
            const bf16x8 qf = *reinterpret_cast<const bf16x8*>(qxl + dd * 1024);
            p0 = __builtin_amdgcn_mfma_f32_32x32x16_bf16(b0, qf, p0, 0, 0, 0);
            p1 = __builtin_amdgcn_mfma_f32_32x32x16_bf16(b1, qf, p1, 0, 0, 0); } }
}
template <int VB>
__device__ __forceinline__ void pv_tile(f32x16* o, int vb0, bf16x8 pa0, bf16x8 pa1, bf16x8 pa2, bf16x8 pa3) {
#define TRRD(dst, off) asm volatile("ds_read_b64_tr_b16 %0, %1 offset:%2" : "=&v"(dst) : "v"(vb0), "i"(off) : "memory")
#define PV_D0(d0) do { s16x4 l0, l1, l2, l3, h0, h1, h2, h3; constexpr int b_ = VB * SHM_V + v_rd_off(d0, 0, 0);     \
        TRRD(l0, b_); TRRD(h0, b_ + 2048); TRRD(l1, b_ + 4096); TRRD(h1, b_ + 6144); TRRD(l2, b_ + 8192); TRRD(h2, b_ + 10240); TRRD(l3, b_ + 12288); TRRD(h3, b_ + 14336); \
        asm volatile("s_waitcnt lgkmcnt(0)" ::: "memory"); SBAR();   \
        o[d0] = __builtin_amdgcn_mfma_f32_32x32x16_bf16(pa0, (bf16x8){l0[0], l0[1], l0[2], l0[3], h0[0], h0[1], h0[2], h0[3]}, o[d0], 0, 0, 0);   \
        o[d0] = __builtin_amdgcn_mfma_f32_32x32x16_bf16(pa1, (bf16x8){l1[0], l1[1], l1[2], l1[3], h1[0], h1[1], h1[2], h1[3]}, o[d0], 0, 0, 0);   \
        o[d0] = __builtin_amdgcn_mfma_f32_32x32x16_bf16(pa2, (bf16x8){l2[0], l2[1], l2[2], l2[3], h2[0], h2[1], h2[2], h2[3]}, o[d0], 0, 0, 0);   \
        o[d0] = __builtin_amdgcn_mfma_f32_32x32x16_bf16(pa3, (bf16x8){l3[0], l3[1], l3[2], l3[3], h3[0], h3[1], h3[2], h3[3]}, o[d0], 0, 0, 0); } while (0)
    PV_D0(0); PV_D0(1); PV_D0(2); PV_D0(3);
#undef PV_D0
#undef TRRD
}

struct BlockRef { const bf16* Q; const bf16* K; const bf16* V; const bf16* QX; const bf16* KX; bf16* O; const float* G; int P0; int jlo; };
template <bool EXT> struct Seam { bf16x8 qr[8]; bf16x8 st_v0, st_v1, st_k0, st_k1, st_x; };
__device__ __forceinline__ int swa_jlo(int P0, int W) { const int lowk = P0 - W + 1; return lowk > 0 ? lowk / KVBLK : 0; }
#define VMW() asm volatile("s_waitcnt vmcnt(0)" ::: "memory")
#define VMWN(n) asm volatile("s_waitcnt vmcnt(%0)" :: "i"(n) : "memory")
#define SLOAD_H(R, k0) do { S.st_v0 = load8((R).V + (size_t)((k0) + sr) * D + sc); S.st_v1 = load8((R).V + (size_t)((k0) + 32 + sr) * D + sc);              \
                            S.st_k0 = load8((R).K + (size_t)((k0) + sr) * D + sc); S.st_k1 = load8((R).K + (size_t)((k0) + 32 + sr) * D + sc);              \
                            if constexpr (EXT) S.st_x = load8((R).KX + (size_t)((k0) + xr) * 64 + xc * 8); } while (0)
#define SWRITE_HK(bf) do { *(bf16x8*)(K_lds + (bf) * SHM_K + kws) = S.st_k0; *(bf16x8*)(K_lds + (bf) * SHM_K + kws + 32 * 256) = S.st_k1; \
                           if constexpr (EXT) *(bf16x8*)(X_lds + (bf) * SHM_X + xws) = S.st_x; } while (0)
#define SWRITE_HV(bf) do { *(bf16x8*)(V_lds + (bf) * SHM_V + vst0) = S.st_v0; *(bf16x8*)(V_lds + (bf) * SHM_V + vst1) = S.st_v1; } while (0)
#define SWRITE_H(bf) do { SWRITE_HV(bf); SWRITE_HK(bf); } while (0)
#define LDS3 __attribute__((address_space(3)))
#define QLOADS(R) do { const bf16* qrow_ = (R).Q + (size_t)(wid * QBLK + r32) * D + hi * 8; \
        if constexpr (EXT) { _Pragma("unroll") for (int d0 = 0; d0 < 8 - QL; ++d0) S.qr[d0] = load8(qrow_ + d0 * 16); \
            const bf16* qxrow_ = (R).QX + (size_t)(wid * QBLK + r32) * 64 + hi * 8; \
            _Pragma("unroll") for (int dd = 0; dd < 4; ++dd) __builtin_amdgcn_global_load_lds((const unsigned*)(qxrow_ + dd * 16), (LDS3 unsigned*)(qxw + dd * 1024), 16, 0, 0); \
            _Pragma("unroll") for (int d0 = 8 - QL; d0 < 8; ++d0) __builtin_amdgcn_global_load_lds((const unsigned*)(qrow_ + d0 * 16), (LDS3 unsigned*)(qxw + (4 + d0 - (8 - QL)) * 1024), 16, 0, 0); } \
        else { _Pragma("unroll") for (int d0 = 0; d0 < 8; ++d0) S.qr[d0] = load8(qrow_ + d0 * 16); } } while (0)
template <bool EXT>
__device__ __forceinline__ void attn_prime(const BlockRef& cur, int W, char* lds, Seam<EXT>& S, int tid_in) {
    int tid_ = tid_in; asm volatile("" : "+v"(tid_));
    const int tid = tid_, wid = __builtin_amdgcn_readfirstlane(tid >> 6), lane = tid & 63, r32 = lane & 31, hi = lane >> 5;
    const int sr = tid >> 4, sc = (tid & 15) * 8, kws = KSWZ(sr, sc * 2), xr = tid >> 3, xc = tid & 7, xws = xr * XROW + xc * 16;
    char* K_lds = lds + OFF_K; char* X_lds = lds + OFF_X; char* qxw = lds + OFF_QX + wid * QXW;
    const int kb0 = cur.jlo * KVBLK;
    QLOADS(cur);
    SLOAD_H(cur, kb0); VMW(); SWRITE_HK(0);
    __syncthreads();
}
template <bool EXT, bool NORM, int LDO>
__device__ __forceinline__ void attn_block(const BlockRef& cur, const BlockRef& nxt, int skv, int W, char* lds, Seam<EXT>& S, int tid_in) {
    int tid_ = tid_in; asm volatile("" : "+v"(tid_));
    const int tid = tid_, wid = __builtin_amdgcn_readfirstlane(tid >> 6), lane = tid & 63, r32 = lane & 31, hi = lane >> 5;
    const int j_lo = cur.jlo;
    int j_hi = (cur.P0 + QB - 1) / KVBLK + 1; if (j_hi > skv / KVBLK) j_hi = skv / KVBLK;
    const int NT = j_hi - j_lo;
    const int kbn = nxt.jlo * KVBLK;
    const int qlo = cur.P0 + wid * QBLK, qm = qlo + r32 - 4 * hi;
    char* V_lds = lds + OFF_V; char* K_lds = lds + OFF_K; char* X_lds = lds + OFF_X;
    float* ws = (float*)(lds + OFF_WS) + wid * 64; float* li_l = ws, * al_l = ws + 32;
    char* qxw = lds + OFF_QX + wid * QXW; char* qxl = qxw + lane * 16;
    float m_reg = -1e30f, l_reg = 0; f32x16 o[4] = {};
    const int sr = tid >> 4, sc = (tid & 15) * 8, vst0 = v_st(sr, sc), vst1 = v_st(32 + sr, sc), kws = KSWZ(sr, sc * 2), xr = tid >> 3, xc = tid & 7, xws = xr * XROW + xc * 16;
    const int vb0 = (int)(uintptr_t)V_lds + v_rd_base(lane);
#define RESC(a) do { if (__any((a) < 1.f)) { if (hi == 0) al_l[r32] = (a); asm volatile("s_waitcnt lgkmcnt(0)" ::: "memory");              \
                     for (int d_ = 0; d_ < 4; ++d_) for (int r = 0; r < 16; ++r) o[d_][r] *= al_l[crow(r, hi)]; } } while (0)
#define KBASE(t) ((j_lo + (t)) * KVBLK)
#define MASKT(P0_, P1_, t) do { const int kb_ = KBASE(t); if (kb_ + KVBLK - 1 > qlo || kb_ <= qlo + QBLK - 1 - W) mask_tile(P0_, P1_, qm - kb_, (unsigned)W); } while (0)
    constexpr int NQL = EXT ? 12 : 8;
#define SEAM_K0() do { VMWN(NQL); SWRITE_HK(0); SBAR(); } while (0)
    f32x16 pA0, pA1, pB0, pB1; float mnA, mnB, alA, alB; bf16x8 pa0, pa1, pa2, pa3;
    SWRITE_HV(0); SBAR();
    if constexpr (EXT) { VMW(); SBAR(); }
    if (NT > 1) { SLOAD_H(cur, KBASE(1)); }
    SBAR(); qkt<0, EXT>(pA0, pA1, K_lds, X_lds, r32, hi, S.qr, qxl);
    MASKT(pA0, pA1, 0); partialSM(pA0, pA1, m_reg, mnA, alA);
    if (NT > 1) { VMW(); SWRITE_H(1); }
    __syncthreads();
#define HALF_STEP(PX0, PX1, mnX, alX, PY0, PY1, alY, t, KB, VB, SB) do {                                                      \
        SBAR(); qkt<KB, EXT>(PX0, PX1, K_lds, X_lds, r32, hi, S.qr, qxl);                                                     \
        finishSM(PY0, PY1, alY, l_reg, pa0, pa1, pa2, pa3); SBAR();                                                           \
        if ((t) + 1 < NT) { SLOAD_H(cur, KBASE((t) + 1)); SBAR(); }                                                           \
        pv_tile<VB>(o, vb0, pa0, pa1, pa2, pa3); MASKT(PX0, PX1, (t)); partialSM(PX0, PX1, m_reg, mnX, alX);                  \
        __syncthreads();                                                                                                      \
        if ((t) + 1 < NT) { VMW(); SWRITE_H(SB); }                                                                            \
        RESC(alX); __syncthreads(); } while (0)
    for (int t = 1; t + 1 < NT; t += 2) {
        HALF_STEP(pB0, pB1, mnB, alB, pA0, pA1, alA, t, 1, 0, 0);
        HALF_STEP(pA0, pA1, mnA, alA, pB0, pB1, alB, t + 1, 0, 1, 1);
    }
    const bool even = (NT & 1) == 0;
    if (even) { SBAR(); qkt<1, EXT>(pB0, pB1, K_lds, X_lds, r32, hi, S.qr, qxl); SBAR(); }
    SLOAD_H(nxt, kbn); SBAR();
    QLOADS(nxt);
    SBAR();
    finishSM(pA0, pA1, alA, l_reg, pa0, pa1, pa2, pa3); SBAR();
    pv_tile<0>(o, vb0, pa0, pa1, pa2, pa3);
    if (even) { MASKT(pB0, pB1, NT - 1); partialSM(pB0, pB1, m_reg, mnB, alB); __syncthreads(); RESC(alB);
        finishSM(pB0, pB1, alB, l_reg, pa0, pa1, pa2, pa3); SBAR(); pv_tile<1>(o, vb0, pa0, pa1, pa2, pa3); }
    SBAR(); SEAM_K0();
    if (hi == 0) li_l[r32] = l_reg; asm volatile("s_waitcnt lgkmcnt(0)" ::: "memory");
    float rli[16];
#pragma unroll
    for (int r = 0; r < 16; ++r) rli[r] = __builtin_amdgcn_rcpf(li_l[crow(r, hi)]);
    if constexpr (NORM) {
        float g4[4];
#pragma unroll
        for (int d0 = 0; d0 < 4; ++d0) g4[d0] = cur.G[d0 * 32 + r32];
#pragma unroll
        for (int r = 0; r < 16; ++r) { float ss = 0.f;
#pragma unroll
            for (int d0 = 0; d0 < 4; ++d0) { o[d0][r] *= rli[r]; ss += o[d0][r] * o[d0][r]; }
            ss += __shfl_xor(ss, 1); ss += __shfl_xor(ss, 2); ss += __shfl_xor(ss, 4); ss += __shfl_xor(ss, 8); ss += __shfl_xor(ss, 16);
            rli[r] = __builtin_amdgcn_rsqf(ss * (1.0f / 128.0f) + RMS_EPS); }
#pragma unroll
        for (int r = 0; r < 16; ++r)
#pragma unroll
            for (int d0 = 0; d0 < 4; ++d0) o[d0][r] *= rli[r] * g4[d0];
    } else {
#pragma unroll
        for (int r = 0; r < 16; ++r)
#pragma unroll
            for (int d0 = 0; d0 < 4; ++d0) o[d0][r] *= rli[r];
    }
    bf16* Ow = cur.O + (size_t)(wid * QBLK) * LDO;
#pragma unroll
    for (int r = 0; r < 16; ++r) { const int orow = crow(r, hi);
#pragma unroll
        for (int d0 = 0; d0 < 4; ++d0) { const float v = o[d0][r];
            const float vn = __shfl_xor(v, 1);
            if ((r32 & 1) == 0) *(unsigned*)(Ow + (size_t)orow * LDO + d0 * 32 + r32) = cvtpk(v, vn); } }
    __syncthreads();
#undef RESC
#undef KBASE
#undef MASKT
#undef SEAM_K0
#undef HALF_STEP
}
#undef VMW
#undef VMWN
#undef SLOAD_H
#undef SWRITE_HK
#undef SWRITE_HV
#undef SWRITE_H
#undef QLOADS
#undef LDS3
#undef KSWZ
}
constexpr int NWAVES = 8;
constexpr int BATCH = 2, SEQ = 8192, DM = 4096, DEPTH = 4, M = BATCH * SEQ;
constexpr int IN_COLS = 8520, NIN = 8704, DFF = 16384, MEMT = 256;
constexpr float EPS = 1e-6f;
constexpr float LOG2E = 1.4426950408889634f;
constexpr float QSCALE_MLA = 0.07216878364870323f * LOG2E;
constexpr float QSCALE_128 = 0.08838834764831845f * LOG2E;

constexpr size_t MiB = 1u << 20;
constexpr size_t WS_CTL = 0, CTL_ZERO_BYTES = 1 * MiB;
constexpr size_t WS_ROPE = 1 * MiB;
constexpr size_t WS_LB = 5 * MiB;
constexpr size_t WS_FOXLF = 5 * MiB + 512 * 1024;
constexpr size_t WS_ADEC = 6 * MiB;
constexpr size_t WS_FOXC = 7 * MiB;
constexpr size_t WS_FOXQM = 7 * MiB + 512 * 1024;
constexpr size_t WS_FOXKM = 7 * MiB + 516 * 1024;
constexpr size_t WS_RQ = 7 * MiB + 640 * 1024, WS_RKV = 7 * MiB + 704 * 1024;
constexpr size_t WS_CSS = 28 * MiB;
constexpr size_t WS_MEMN = 8 * MiB;
constexpr size_t WS_KVMEM = 24 * MiB;
constexpr size_t WS_W = 32 * MiB, W_LAYER = 384 * MiB;
constexpr size_t W_IN = 0, W_UQ = 68 * MiB, W_UKV = 73 * MiB, W_O = 77 * MiB, W_MQ = 109 * MiB, W_MKV = 113 * MiB, W_MO = 121 * MiB, W_FF1 = 125 * MiB, W_FF2 = 253 * MiB;
constexpr size_t WS_HN = 1568 * MiB;
constexpr size_t WS_Y = 1696 * MiB;
constexpr size_t WS_YSS = 1824 * MiB;
constexpr size_t WS_HSS = 1828 * MiB;
constexpr size_t WS_QMEM = 1952 * MiB, WS_OMEM = 1968 * MiB;
constexpr size_t WS_MIXER = 1984 * MiB;
constexpr size_t WS_PROJ = WS_MIXER  , WS_FOX = WS_MIXER + 128 * MiB  , WS_LOGF = WS_MIXER + 224 * MiB, WS_PROJX = WS_MIXER + 288 * MiB  , WS_GP = WS_MIXER + 304 * MiB  , WS_CQN = WS_MIXER + 384 * MiB, WS_CKVN = WS_MIXER + 408 * MiB,
                 WS_KROT = WS_MIXER + 424 * MiB, WS_QN = WS_MIXER + 426 * MiB, WS_QR = WS_MIXER + 490 * MiB, WS_KN = WS_MIXER + 522 * MiB, WS_VC = WS_MIXER + 586 * MiB, WS_LT = WS_MIXER + 650 * MiB,
                 WS_ST = WS_MIXER + 778 * MiB, WS_MIX = WS_MIXER + 842 * MiB, WS_QEXT = WS_MIXER + 970 * MiB, WS_KEXT = WS_MIXER + 986 * MiB, WS_MIXER_END = WS_MIXER + 1002 * MiB;
constexpr size_t WS_HID = WS_MIXER;
constexpr size_t WS_END = WS_MIXER_END;
static_assert(WS_HID + 512 * MiB <= WS_MIX, "hidden overlay must not reach MIX/QEXT/KEXT");
constexpr int CW_BAR = 4096, CW_Q = 8192;

constexpr int RING_BYTES = 159744;
constexpr int LDSCTL_OFF = RING_BYTES, MISC_OFF = LDSCTL_OFF + 320;
constexpr int LDS_BYTES = 160256;
static_assert(MISC_OFF + 128 <= LDS_BYTES && att::ATT_LDS_BYTES <= RING_BYTES, "LDS map");

#define GAS __attribute__((address_space(1)))
#define LAS __attribute__((address_space(3)))
typedef unsigned short bf16;
typedef unsigned v4u __attribute__((ext_vector_type(4)));
typedef unsigned v2u __attribute__((ext_vector_type(2)));
typedef float f32x4 __attribute__((ext_vector_type(4)));
typedef float f32x2 __attribute__((ext_vector_type(2)));
typedef float f32x16 __attribute__((ext_vector_type(16)));
typedef short bf16x8 __attribute__((ext_vector_type(8)));
typedef GAS unsigned gu32;
#define RLX_AGENT __ATOMIC_RELAXED, __HIP_MEMORY_SCOPE_AGENT
#define LDS_WAIT() asm volatile("s_waitcnt lgkmcnt(0)" ::: "memory")
#define VM_WAIT() asm volatile("s_waitcnt vmcnt(0)" ::: "memory")
__device__ __forceinline__ unsigned f2bf(float f) { unsigned u = __builtin_bit_cast(unsigned, f); return (u + 0x7fffu + ((u >> 16) & 1u)) >> 16; }
__device__ __forceinline__ unsigned pk2(float lo, float hi) { return f2bf(lo) | (f2bf(hi) << 16); }
__device__ __forceinline__ float bf2f(unsigned short b) { return __builtin_bit_cast(float, ((unsigned)b) << 16); }
__device__ __forceinline__ float bflo(unsigned w) { return __builtin_bit_cast(float, w << 16); }
__device__ __forceinline__ float bfhi(unsigned w) { return __builtin_bit_cast(float, w & 0xffff0000u); }

#define XB_TMO      128
#define XB_XCNT(j)  (256  + 64 * (j))
#define XB_XSUB(j)  (1280 + 64 * (j))
#define XB_XGEN(j)  (2304 + 64 * (j))
#define XB_TOP      3328
#define XB_TOPGEN   3392
#define XCD_BAR_WORDS 3456
#define XB_SPIN_CAP (1u << 22)
__device__ __forceinline__ unsigned xb_ld(unsigned* p)              { return __hip_atomic_load(p, __ATOMIC_RELAXED, __HIP_MEMORY_SCOPE_AGENT); }
__device__ __forceinline__ unsigned xb_add(unsigned* p, unsigned v) { return __hip_atomic_fetch_add(p, v, __ATOMIC_RELAXED, __HIP_MEMORY_SCOPE_AGENT); }
__device__ __forceinline__ unsigned xb_xcc_id() { return (unsigned)__builtin_amdgcn_s_getreg((3 << 11) | 20) & 0xFu; }
#define XB_SPIN(cond, bar) do { unsigned _sp = 0; while (cond) { __builtin_amdgcn_s_sleep(1); \
    if ((++_sp & 255u) == 0u) { if (xb_ld(&(bar)[XB_TMO])) break; if (_sp > XB_SPIN_CAP) { atomicAdd(&(bar)[XB_TMO], 1u); break; } } } } while (0)
struct XcdBarrier { unsigned* bar; unsigned x; volatile LAS unsigned* st; };
__device__ __forceinline__ XcdBarrier xcd_barrier_post(unsigned* bar, volatile LAS unsigned* st) {
    XcdBarrier b; b.bar = bar; b.x = xb_xcc_id(); b.st = st;
    if (threadIdx.x == 0) (void)xb_add(&bar[XB_XCNT(b.x)], 1u);
    return b;
}
__device__ __forceinline__ void xcd_barrier_complete(unsigned* bar, unsigned x, unsigned& nloc, unsigned& nx) {
    const unsigned G = gridDim.x * gridDim.y * gridDim.z;
    unsigned sum, cnt, mine, sp = 0u;
    for (;;) {
        sum = 0u; cnt = 0u; mine = 0u;
#pragma unroll
        for (unsigned j = 0; j < 16; ++j) { const unsigned c = xb_ld(&bar[XB_XCNT(j)]); sum += c; cnt += (c > 0u) ? 1u : 0u; mine = (j == x) ? c : mine; }
        if (sum == G) break;
        __builtin_amdgcn_s_sleep(1);
        if ((++sp & 255u) == 0u) { if (xb_ld(&bar[XB_TMO])) break; if (sp > XB_SPIN_CAP) { atomicAdd(&bar[XB_TMO], 1u); break; } }
    }
    nloc = mine > 0u ? mine : 1u; nx = cnt > 0u ? cnt : 1u;
}
__device__ __forceinline__ void xcd_barrier(const XcdBarrier& b, bool leader  ) {
    asm volatile("s_waitcnt vmcnt(0)" ::: "memory");
    __syncthreads();
    if (leader) {
        unsigned* bar = b.bar; unsigned bx_ = b.x; asm volatile("" : "+s"(bar), "+s"(bx_));
        __builtin_amdgcn_s_waitcnt(0);
        unsigned nloc = b.st[0], nx = b.st[1];
        if (nloc == 0u) { xcd_barrier_complete(bar, bx_, nloc, nx); b.st[0] = nloc; b.st[1] = nx; }
        const unsigned old = xb_add(&bar[XB_XSUB(bx_)], 1u);
        const unsigned gen = old / nloc;
        if (old + 1u == (gen + 1u) * nloc) {
            __builtin_amdgcn_fence(__ATOMIC_RELEASE, "agent");
            asm volatile("s_waitcnt vmcnt(0)" ::: "memory");
            const unsigned og = xb_add(&bar[XB_TOP], 1u);
            const unsigned tg = og / nx;
            if (og + 1u == (tg + 1u) * nx) xb_add(&bar[XB_TOPGEN], 1u);
            else XB_SPIN(xb_ld(&bar[XB_TOPGEN]) == tg, bar);
            __builtin_amdgcn_fence(__ATOMIC_ACQUIRE, "agent");
            xb_add(&bar[XB_XGEN(bx_)], 1u);
            asm volatile("s_waitcnt vmcnt(0)" ::: "memory");
        } else {
            XB_SPIN(xb_ld(&bar[XB_XGEN(bx_)]) == gen, bar);
            __builtin_amdgcn_fence(__ATOMIC_ACQUIRE, "agent");
            asm volatile("s_waitcnt vmcnt(0)" ::: "memory");
        }
    }
    __syncthreads();
}

struct Frame {
    LAS unsigned char* lds; char* ldsg;
    volatile LAS unsigned* MISC;
    int tid, lane, wave;
    int vcu, G, bx;
};
__device__ __forceinline__ int fresh_tid(int wave) { int ln_; asm volatile("v_mbcnt_lo_u32_b32 %0, -1, 0\n\tv_mbcnt_hi_u32_b32 %0, -1, %0" : "=v"(ln_)); return wave * 64 + ln_; }
__device__ __forceinline__ float wave_sum(float v) {
#pragma unroll
    for (int o = 1; o < 64; o <<= 1) v += __shfl_xor(v, o);
    return v;
}

template <int MAP> __device__ __forceinline__ int old_col(int n) {
    if (MAP == 0) return n;
    if (MAP == 1) { if (n < 3584) return n; if (n < 6656) return n + 512; if (n < 8000) return n + 520; if (n < 8008) return n - 8000 + 7168; if (n < 8192) return -1; return n - 4608; }
    if (n < 2048) return (n >> 7) * 192 + (n & 127);
    { const int e = n - 2048, h = e >> 6, w = e & 63, i = w >> 1, p = w & 1; return h * 192 + 128 + i + 32 * p; }
}
template <int MAP> __device__ __forceinline__ f32x4 load4_cols(const float* rowp, int n) {
    if (MAP == 0) return __builtin_nontemporal_load((const GAS f32x4*)(rowp + n));
    if (MAP == 1) { const int oc = old_col<1>(n); if (oc >= 0) return __builtin_nontemporal_load((const GAS f32x4*)(rowp + oc)); return (f32x4){0.f, 0.f, 0.f, 0.f}; }
    if (n < 2048) return __builtin_nontemporal_load((const GAS f32x4*)(rowp + (n >> 7) * 192 + (n & 127)));
    { const int e = n - 2048, h = e >> 6, i = (e & 63) >> 1; const float* p = rowp + h * 192 + 128 + i;
      const f32x2 a = *(const GAS f32x2*)p, b = *(const GAS f32x2*)(p + 32); return (f32x4){a.x, b.x, a.y, b.y}; }
}
struct CvPend { bf16* wt; int K, sk, hsel; };
template <int CV_SK>
__device__ __forceinline__ void cv_flush_sk(LAS unsigned char* T, int tid, bf16* wt, int K, int hsel) {
    constexpr int SN = 8 / CV_SK, PITCH = 128 * CV_SK + 16, ROWS = 64 * SN, PPR = 8 * CV_SK  , NJ = (ROWS * PPR) / 512;
    if (hsel < 0) {
        v4u o[NJ];
#pragma unroll
        for (int j = 0; j < NJ; ++j) { const int p = j * 512 + tid, row = p / PPR, pc = p % PPR; o[j] = *(const LAS v4u*)(T + row * PITCH + pc * 16); }
#pragma unroll
        for (int j = 0; j < NJ; ++j) { const int p = j * 512 + tid, row = p / PPR, pc = p % PPR; __builtin_nontemporal_store(o[j], (GAS v4u*)(wt + (size_t)row * K + pc * 8)); }
    } else {
        v4u o[NJ / 2];
#pragma unroll
        for (int j = 0; j < NJ / 2; ++j) { const int p = j * 512 + tid, row = 32 * hsel + p / PPR, pc = p % PPR; o[j] = *(const LAS v4u*)(T + row * PITCH + pc * 16); }
#pragma unroll
        for (int j = 0; j < NJ / 2; ++j) { const int p = j * 512 + tid, row = 32 * hsel + p / PPR, pc = p % PPR; __builtin_nontemporal_store(o[j], (GAS v4u*)(wt + (size_t)row * K + pc * 8)); }
    }
}
__device__ __forceinline__ void cv_flush(LAS unsigned char* T, int tid, CvPend& pend) {
    if (pend.sk == 8) cv_flush_sk<8>(T, tid, pend.wt, pend.K, pend.hsel); else if (pend.sk == 4) cv_flush_sk<4>(T, tid, pend.wt, pend.K, -1);
    pend.sk = 0;
    LDS_WAIT(); __syncthreads();
}
template <int MAP, int CV_SK>
__device__ __forceinline__ void p0_transpose_item(CvPend& pend, LAS unsigned char* T, int tid, const float* W, int K, int N, bf16* WT, int row_off, int nblk, int item, int lane, const float* gk = nullptr  , int hsel = -1) {
    constexpr int SN = 8 / CV_SK; const int g_ = item >> 3, sub = item & 7, nbg = nblk / SN, kband = g_ / nbg, nbq = g_ - kband * nbg;
    const int kb = kband * CV_SK + sub / SN, nb = nbq * SN + sub % SN, k0 = 64 * kb, n0 = 64 * nb, c = lane & 7, kq = lane >> 3;
    f32x4 v[2][8];
#pragma unroll
    for (int hh = 0; hh < 2; ++hh) if (hsel < 0 || hh == hsel) {
#pragma unroll
        for (int i = 0; i < 8; ++i) v[hh][i] = load4_cols<MAP>(W + (size_t)(k0 + 8 * kq + i) * N, n0 + 32 * hh + 4 * c); }
    else {
#pragma unroll
        for (int i = 0; i < 8; ++i) v[hh][i] = (f32x4){0.f, 0.f, 0.f, 0.f}; }
    cv_flush(T, tid, pend);
    if (gk) { const f32x4 g0 = *(const GAS f32x4*)(gk + k0 + 8 * kq), g1 = *(const GAS f32x4*)(gk + k0 + 8 * kq + 4);
#pragma unroll
        for (int hh = 0; hh < 2; ++hh) { v[hh][0] = v[hh][0] * g0[0]; v[hh][1] = v[hh][1] * g0[1]; v[hh][2] = v[hh][2] * g0[2]; v[hh][3] = v[hh][3] * g0[3];
            v[hh][4] = v[hh][4] * g1[0]; v[hh][5] = v[hh][5] * g1[1]; v[hh][6] = v[hh][6] * g1[2]; v[hh][7] = v[hh][7] * g1[3]; } }
    constexpr int PITCH = 128 * CV_SK + 16;
    { LAS unsigned char* tw = T + ((sub % SN) * 64 + 4 * c) * PITCH + ((sub / SN) * 64 + 8 * kq) * 2;
#pragma unroll
      for (int hh = 0; hh < 2; ++hh) if (hsel < 0 || hh == hsel)
#pragma unroll
        for (int nn = 0; nn < 4; ++nn) { v4u o; o.x = pk2(v[hh][0][nn], v[hh][1][nn]); o.y = pk2(v[hh][2][nn], v[hh][3][nn]); o.z = pk2(v[hh][4][nn], v[hh][5][nn]); o.w = pk2(v[hh][6][nn], v[hh][7][nn]);
            *(LAS v4u*)(tw + (32 * hh + nn) * PITCH) = o; } }
    LDS_WAIT(); __syncthreads();
    pend.wt = WT + (size_t)(row_off + 64 * SN * nbq) * K + 64 * CV_SK * kband; pend.K = K; pend.sk = CV_SK; pend.hsel = hsel;
}
__device__ __forceinline__ v4u pack8f(const f32x4& a, const f32x4& b) { v4u w; w.x = pk2(a.x, a.y); w.y = pk2(a.z, a.w); w.z = pk2(b.x, b.y); w.w = pk2(b.z, b.w); return w; }
template <bool FULL>
__device__ __forceinline__ void norm_first(int lane, const float* x, const float* g, bf16* a, float* hss) {
    f32x4 v[8][2]; float ss = 0.f;
#pragma unroll
    for (int j = 0; j < 8; ++j) { v[j][0] = *((const GAS f32x4*)x + 2 * lane + 128 * j); v[j][1] = *((const GAS f32x4*)x + 2 * lane + 128 * j + 1);
        ss += (v[j][0].x * v[j][0].x + v[j][0].y * v[j][0].y) + (v[j][0].z * v[j][0].z + v[j][0].w * v[j][0].w) + (v[j][1].x * v[j][1].x + v[j][1].y * v[j][1].y) + (v[j][1].z * v[j][1].z + v[j][1].w * v[j][1].w); }
    const float rstd = __builtin_amdgcn_rsqf(wave_sum(ss) * (1.f / DM) + EPS);
#pragma unroll
    for (int j = 0; j < 8; ++j) {
        if constexpr (FULL) { const f32x4 g0 = *((const GAS f32x4*)g + 2 * lane + 128 * j), g1 = *((const GAS f32x4*)g + 2 * lane + 128 * j + 1);
            *((GAS v4u*)a + lane + 64 * j) = pack8f(v[j][0] * g0 * rstd, v[j][1] * g1 * rstd); }
        else *((GAS v4u*)a + lane + 64 * j) = pack8f(v[j][0], v[j][1]); }
    if (!FULL && lane == 0) *hss = rstd;
}
__device__ __forceinline__ void norm_first_rows(int lane, int first, int stride, int nrows, const float* x, bf16* a, float* hss) {
    if (first >= nrows) return;
    f32x4 v[8][2];
#pragma unroll
    for (int j = 0; j < 8; ++j) { v[j][0] = *((const GAS f32x4*)(x + (size_t)first * DM) + 2 * lane + 128 * j); v[j][1] = *((const GAS f32x4*)(x + (size_t)first * DM) + 2 * lane + 128 * j + 1); }
    for (int m = first; m < nrows; m += stride) {
        v4u o[8]; float ss = 0.f;
#pragma unroll
        for (int j = 0; j < 8; ++j) {
            ss += (v[j][0].x * v[j][0].x + v[j][0].y * v[j][0].y) + (v[j][0].z * v[j][0].z + v[j][0].w * v[j][0].w) + (v[j][1].x * v[j][1].x + v[j][1].y * v[j][1].y) + (v[j][1].z * v[j][1].z + v[j][1].w * v[j][1].w);
            o[j] = pack8f(v[j][0], v[j][1]); }
        const int mn = m + stride;
        if (mn < nrows) {
#pragma unroll
            for (int j = 0; j < 8; ++j) { v[j][0] = *((const GAS f32x4*)(x + (size_t)mn * DM) + 2 * lane + 128 * j); v[j][1] = *((const GAS f32x4*)(x + (size_t)mn * DM) + 2 * lane + 128 * j + 1); } }
#pragma unroll
        for (int j = 0; j < 8; ++j) *((GAS v4u*)(a + (size_t)m * DM) + lane + 64 * j) = o[j];
        const float rstd = __builtin_amdgcn_rsqf(wave_sum(ss) * (1.f / DM) + EPS); if (lane == 0) hss[m] = rstd;
    }
}
template <bool XIN, bool LAST>
__device__ __forceinline__ void norm_step(int lane, const float* x, bf16* hb, const bf16* y, const float* yss, const float* gpost, float* out, float* hss) {
    const float rstd = __builtin_amdgcn_rsqf(wave_sum(yss[lane]) * (1.f / DM) + EPS);
    float ss = 0.f;
#pragma unroll
    for (int j = 0; j < 8; ++j) {
        const v4u yw = *((const GAS v4u*)y + lane + 64 * j);
        f32x4 h0, h1;
        if constexpr (XIN) { h0 = *((const GAS f32x4*)x + 2 * lane + 128 * j); h1 = *((const GAS f32x4*)x + 2 * lane + 128 * j + 1); }
        else { const v4u hw = *((const GAS v4u*)hb + lane + 64 * j); h0 = (f32x4){bflo(hw.x), bfhi(hw.x), bflo(hw.y), bfhi(hw.y)}; h1 = (f32x4){bflo(hw.z), bfhi(hw.z), bflo(hw.w), bfhi(hw.w)}; }
        const f32x4 p0 = *((const GAS f32x4*)gpost + 2 * lane + 128 * j), p1 = *((const GAS f32x4*)gpost + 2 * lane + 128 * j + 1);
        const f32x4 y0 = {bflo(yw.x), bfhi(yw.x), bflo(yw.y), bfhi(yw.y)}, y1 = {bflo(yw.z), bfhi(yw.z), bflo(yw.w), bfhi(yw.w)};
        h0 = h0 + y0 * rstd * p0; h1 = h1 + y1 * rstd * p1;
        if constexpr (LAST) { *((GAS f32x4*)out + 2 * lane + 128 * j) = h0; *((GAS f32x4*)out + 2 * lane + 128 * j + 1) = h1; }
        else { ss += (h0.x * h0.x + h0.y * h0.y) + (h0.z * h0.z + h0.w * h0.w) + (h1.x * h1.x + h1.y * h1.y) + (h1.z * h1.z + h1.w * h1.w);
            *((GAS v4u*)hb + lane + 64 * j) = pack8f(h0, h1); }
    }
    if constexpr (!LAST) { const float r2 = __builtin_amdgcn_rsqf(wave_sum(ss) * (1.f / DM) + EPS); if (lane == 0) *hss = r2; }
}
template <bool XIN, bool LAST>
__device__ __forceinline__ void norm_rows(int lane, int first, int stride, int nrows, const float* x, bf16* hb, const bf16* y, const float* yss, const float* gpost, float* out, float* hss) {
    if (first >= nrows) return;
    f32x4 g[8][2];
#pragma unroll
    for (int j = 0; j < 8; ++j) { g[j][0] = *((const GAS f32x4*)gpost + 2 * lane + 128 * j); g[j][1] = *((const GAS f32x4*)gpost + 2 * lane + 128 * j + 1); }
    v4u yw[8], hw[8]; f32x4 xv[XIN ? 8 : 1][2]; float ys = yss[(size_t)first * 64 + lane];
#pragma unroll
    for (int j = 0; j < 8; ++j) { yw[j] = *((const GAS v4u*)(y + (size_t)first * DM) + lane + 64 * j);
        if constexpr (XIN) { xv[j][0] = *((const GAS f32x4*)(x + (size_t)first * DM) + 2 * lane + 128 * j); xv[j][1] = *((const GAS f32x4*)(x + (size_t)first * DM) + 2 * lane + 128 * j + 1); }
        else hw[j] = *((const GAS v4u*)(hb + (size_t)first * DM) + lane + 64 * j); }
    for (int m = first; m < nrows; m += stride) {
        const float rstd = __builtin_amdgcn_rsqf(wave_sum(ys) * (1.f / DM) + EPS);
        v4u o[LAST ? 1 : 8]; f32x4 of[LAST ? 8 : 1][2]; float ss = 0.f;
#pragma unroll
        for (int j = 0; j < 8; ++j) {
            f32x4 h0, h1;
            if constexpr (XIN) { h0 = xv[j][0]; h1 = xv[j][1]; }
            else { h0 = (f32x4){bflo(hw[j].x), bfhi(hw[j].x), bflo(hw[j].y), bfhi(hw[j].y)}; h1 = (f32x4){bflo(hw[j].z), bfhi(hw[j].z), bflo(hw[j].w), bfhi(hw[j].w)}; }
            const f32x4 y0 = {bflo(yw[j].x), bfhi(yw[j].x), bflo(yw[j].y), bfhi(yw[j].y)}, y1 = {bflo(yw[j].z), bfhi(yw[j].z), bflo(yw[j].w), bfhi(yw[j].w)};
            h0 = h0 + y0 * rstd * g[j][0]; h1 = h1 + y1 * rstd * g[j][1];
            if constexpr (LAST) { of[j][0] = h0; of[j][1] = h1; }
            else { ss += (h0.x * h0.x + h0.y * h0.y) + (h0.z * h0.z + h0.w * h0.w) + (h1.x * h1.x + h1.y * h1.y) + (h1.z * h1.z + h1.w * h1.w); o[j] = pack8f(h0, h1); } }
        const int mn = m + stride;
        if (mn < nrows) { ys = yss[(size_t)mn * 64 + lane];
#pragma unroll
            for (int j = 0; j < 8; ++j) { yw[j] = *((const GAS v4u*)(y + (size_t)mn * DM) + lane + 64 * j);
                if constexpr (XIN) { xv[j][0] = *((const GAS f32x4*)(x + (size_t)mn * DM) + 2 * lane + 128 * j); xv[j][1] = *((const GAS f32x4*)(x + (size_t)mn * DM) + 2 * lane + 128 * j + 1); }
                else hw[j] = *((const GAS v4u*)(hb + (size_t)mn * DM) + lane + 64 * j); } }
#pragma unroll
        for (int j = 0; j < 8; ++j) {
            if constexpr (LAST) { *((GAS f32x4*)(out + (size_t)m * DM) + 2 * lane + 128 * j) = of[j][0]; *((GAS f32x4*)(out + (size_t)m * DM) + 2 * lane + 128 * j + 1) = of[j][1]; }
            else *((GAS v4u*)(hb + (size_t)m * DM) + lane + 64 * j) = o[j]; }
        if constexpr (!LAST) { const float r2 = __builtin_amdgcn_rsqf(wave_sum(ss) * (1.f / DM) + EPS); if (lane == 0) hss[m] = r2; }
    }
}
struct Args { const float* in[25]; float* out; unsigned char* ws; int ph_lo, ph_hi; };
typedef const __attribute__((address_space(4))) Args CArgs;
struct Ptrs { const CArgs* a; float* out; unsigned char* ws;
    __device__ __forceinline__ const float* inp(int k) const { return a->in[k]; } };
#define WSP(T, off) ((T*)(P.ws + (off)))
#define WLAYER(T, l, off) ((T*)(P.ws + WS_W + (size_t)(l) * W_LAYER + (off)))

constexpr int I_IN = (DM / 64) * (NIN / 64), I_UQ = (768 / 64) * (3072 / 64), I_UKV = (512 / 64) * (4096 / 64), I_O = (DM / 64) * (DM / 64), I_MQ = (DM / 64) * (512 / 64),
              I_MO = (512 / 64) * (DM / 64), I_F1 = (DM / 64) * (DFF / 64), I_F2 = (DFF / 64) * (DM / 64);
constexpr int PER_LAYER = I_IN + I_UQ + I_UKV + I_O + 3 * I_MQ + I_MO + I_F1 + I_F2;
#ifndef CV_SKD
#define CV_SKD 4
#endif
constexpr int CV_A = 0, CV_B = (CV_SKD == 8) ? CVB8 : 5984;
static_assert(CV_B % (CV_SKD * (NIN / 64)) == 0, "slot range = whole k bands");
__device__ __forceinline__ void convert_item(CvPend& pend, LAS unsigned char* T, int tid, const Ptrs& P, int l, int r, int lane, int hsel = -1) {
    if (r < I_IN) { p0_transpose_item<1, CV_SKD>(pend, T, tid, P.inp(3) + (size_t)l * DM * IN_COLS, DM, IN_COLS, WLAYER(bf16, l, W_IN), 0, NIN / 64, r, lane, P.inp(19) + (size_t)l * DM, hsel); return; } r -= I_IN;
    if (r < I_UQ) { p0_transpose_item<2, 4>(pend, T, tid, P.inp(8) + (size_t)l * 768 * 3072, 768, 3072, WLAYER(bf16, l, W_UQ), 0, 3072 / 64, r, lane, P.inp(6) + (size_t)l * 768); return; } r -= I_UQ;
    if (r < I_UKV) { p0_transpose_item<0, CV_SKD>(pend, T, tid, P.inp(9) + (size_t)l * 512 * 4096, 512, 4096, WLAYER(bf16, l, W_UKV), 0, 4096 / 64, r, lane, P.inp(7) + (size_t)l * 512, hsel); return; } r -= I_UKV;
    if (r < I_O) { p0_transpose_item<0, CV_SKD>(pend, T, tid, P.inp(11) + (size_t)l * DM * DM, DM, DM, WLAYER(bf16, l, W_O), 0, DM / 64, r, lane, nullptr, hsel); return; } r -= I_O;
    if (r < I_MQ) { p0_transpose_item<0, CV_SKD>(pend, T, tid, P.inp(13) + (size_t)l * DM * 512, DM, 512, WLAYER(bf16, l, W_MQ), 0, 512 / 64, r, lane, P.inp(21) + (size_t)l * DM, hsel); return; } r -= I_MQ;
    if (r < I_MQ) { p0_transpose_item<0, CV_SKD>(pend, T, tid, P.inp(14) + (size_t)l * DM * 512, DM, 512, WLAYER(bf16, l, W_MKV), 0, 512 / 64, r, lane, nullptr, hsel); return; } r -= I_MQ;
    if (r < I_MQ) { p0_transpose_item<0, CV_SKD>(pend, T, tid, P.inp(15) + (size_t)l * DM * 512, DM, 512, WLAYER(bf16, l, W_MKV), 512, 512 / 64, r, lane, nullptr, hsel); return; } r -= I_MQ;
    if (r < I_MO) { p0_transpose_item<0, CV_SKD>(pend, T, tid, P.inp(16) + (size_t)l * 512 * DM, 512, DM, WLAYER(bf16, l, W_MO), 0, DM / 64, r, lane, nullptr, hsel); return; } r -= I_MO;
    if (r < I_F1) { p0_transpose_item<0, CV_SKD>(pend, T, tid, P.inp(17) + (size_t)l * DM * DFF, DM, DFF, WLAYER(bf16, l, W_FF1), 0, DFF / 64, r, lane, P.inp(23) + (size_t)l * DM, hsel); return; } r -= I_F1;
    p0_transpose_item<0, CV_SKD>(pend, T, tid, P.inp(18) + (size_t)l * DFF * DM, DFF, DM, WLAYER(bf16, l, W_FF2), 0, DM / 64, r, lane, nullptr, hsel);
}
__device__ __forceinline__ void convert_slot(Frame& F, const Ptrs& P, int l, int lo, int hi) {
    CvPend pend; pend.sk = 0; pend.wt = nullptr; pend.K = 0; pend.hsel = -1;
    for (int it = lo + (F.bx - 128) * NWAVES + F.wave; it < hi; it += 128 * NWAVES) convert_item(pend, F.lds, F.tid, P, l, it, F.lane);
    cv_flush(F.lds, F.tid, pend);
}

constexpr int PER8 = PER_LAYER / 8, MKV8_LO = (I_IN + I_UQ + I_UKV + I_O + I_MQ) / 8, MKV8_N = (2 * I_MQ) / 8, Q8_LAYER = PER8 - MKV8_N, Q8_TOTAL = (DEPTH - 1) * Q8_LAYER;
constexpr int CW_CVQ = CW_Q + 1024;
__device__ __forceinline__ void steal_tile(Frame& F, const Ptrs& P, int t2) {
    const int t = t2 >> 1; int hh = t2 & 1;
    const int l = 1 + t / Q8_LAYER; int q8 = t - (l - 1) * Q8_LAYER; if (q8 >= MKV8_LO) q8 += MKV8_N;
    if (q8 >= I_IN / 8 && q8 < (I_IN + I_UQ) / 8) { if (hh) return; hh = -1; }
    CvPend pend; pend.sk = 0; pend.wt = nullptr; pend.K = 0; pend.hsel = -1;
    convert_item(pend, F.lds, F.tid, P, l, 8 * q8 + F.wave, F.lane, hh);
    cv_flush(F.lds, F.tid, pend);
}
__device__ __forceinline__ void steal_upto(Frame& F, const Ptrs& P, int upto, int maxn) {
    gu32* qctr = (gu32*)(P.ws + WS_CTL) + CW_CVQ; volatile LAS unsigned* sh = F.MISC + 16;
    for (int i = 0; i < maxn; ++i) {
        if (F.tid == 0) sh[2] = __hip_atomic_fetch_add(qctr, 1u, RLX_AGENT);
        LDS_WAIT(); __syncthreads();
        const int t = (int)sh[2];
        __syncthreads();
        if (t < 2 * Q8_TOTAL) steal_tile(F, P, t);
        if (t >= 2 * upto) break;
    }
}
__device__ __forceinline__ void xcd_barrier_steal(const XcdBarrier& b, Frame& F, const Ptrs& P) {
    asm volatile("s_waitcnt vmcnt(0)" ::: "memory");
    __syncthreads();
    volatile LAS unsigned* sh = F.MISC + 16;
    const bool leader = F.tid == 0;
    unsigned* bar = b.bar; unsigned bx_ = b.x; asm volatile("" : "+s"(bar), "+s"(bx_));
    if (leader) {
        __builtin_amdgcn_s_waitcnt(0);
        unsigned nloc = b.st[0], nx = b.st[1];
        if (nloc == 0u) { xcd_barrier_complete(bar, bx_, nloc, nx); b.st[0] = nloc; b.st[1] = nx; }
        const unsigned old = xb_add(&bar[XB_XSUB(bx_)], 1u);
        const unsigned gen = old / nloc;
        if (old + 1u == (gen + 1u) * nloc) {
            __builtin_amdgcn_fence(__ATOMIC_RELEASE, "agent");
            asm volatile("s_waitcnt vmcnt(0)" ::: "memory");
            const unsigned og = xb_add(&bar[XB_TOP], 1u);
            const unsigned tg = og / nx;
            if (og + 1u == (tg + 1u) * nx) xb_add(&bar[XB_TOPGEN], 1u);
            else XB_SPIN(xb_ld(&bar[XB_TOPGEN]) == tg, bar);
            __builtin_amdgcn_fence(__ATOMIC_ACQUIRE, "agent");
            xb_add(&bar[XB_XGEN(bx_)], 1u);
            asm volatile("s_waitcnt vmcnt(0)" ::: "memory");
            sh[0] = 0xffffffffu;
        } else sh[0] = gen;
    }
    LDS_WAIT(); __syncthreads();
    const unsigned gen = sh[0];
    if (gen != 0xffffffffu) {
        gu32* qctr = (gu32*)(P.ws + WS_CTL) + CW_CVQ;
        for (;;) {
            if (leader) { const unsigned rel = (xb_ld(&bar[XB_XGEN(bx_)]) != gen) ? 1u : 0u; sh[1] = rel; sh[2] = rel ? 0u : __hip_atomic_fetch_add(qctr, 1u, RLX_AGENT); }
            LDS_WAIT(); __syncthreads();
            const unsigned rel = sh[1]; const int t = (int)sh[2];
            __syncthreads();
            if (rel) break;
            if (t >= 2 * Q8_TOTAL) { if (leader) XB_SPIN(xb_ld(&bar[XB_XGEN(bx_)]) == gen, bar); break; }
            steal_tile(F, P, t);
            asm volatile("s_waitcnt vmcnt(0)" ::: "memory");
        }
        if (leader) { __builtin_amdgcn_fence(__ATOMIC_ACQUIRE, "agent"); asm volatile("s_waitcnt vmcnt(0)" ::: "memory"); }
    }
    __syncthreads();
}

__device__ __forceinline__ void p0_prologue(Frame& F, const Ptrs& P) {
    const int gw = F.vcu * NWAVES + F.wave, NGW = F.G * NWAVES;
    CvPend pend; pend.sk = 0; pend.wt = nullptr; pend.K = 0; pend.hsel = -1;
    for (int it = gw; it < PER_LAYER + (DEPTH - 1) * 8 * MKV8_N; it += NGW) {
        if (it < PER_LAYER) convert_item(pend, F.lds, F.tid, P, 0, it, F.lane);
        else { const int q = it - PER_LAYER, l = 1 + q / (8 * MKV8_N); convert_item(pend, F.lds, F.tid, P, l, 8 * MKV8_LO + (q - (l - 1) * 8 * MKV8_N), F.lane); }
    }
    cv_flush(F.lds, F.tid, pend);
    norm_first_rows(F.lane, gw, NGW, M, P.inp(0), WSP(bf16, WS_HN), WSP(float, WS_HSS));
    for (int m = gw; m < DEPTH * BATCH * MEMT; m += NGW) { const int l = m / (BATCH * MEMT), r = m % (BATCH * MEMT);
        norm_first<true>(F.lane, P.inp(1) + (size_t)r * DM, P.inp(12) + (size_t)l * DM, WSP(bf16, WS_MEMN) + (size_t)m * DM, nullptr); }
    { const int gt = gw * 64 + F.lane, NT = NGW * 64; const int* pos = (const int*)P.inp(2); f32x2* rope = WSP(f32x2, WS_ROPE);
      for (int e = gt; e < M * 32; e += NT) { const int tok = e >> 5, i = e & 31;
          const float inv = exp2f(-(float)i * (13.287712379549449f / 32.0f));
          const float ang = (float)pos[tok] * inv;
          const double k = rint((double)ang * 0.15915494309189535);
          const float red = (float)((double)ang - k * 6.283185307179586);
          f32x2 cs; cs.x = cosf(red); cs.y = sinf(red); rope[e] = cs; } }
    { const int gt = gw * 64 + F.lane; if (gt < 1024) { const float* G = P.inp(4); float g[4], mx = -3.0e38f;
          for (int l = 0; l < 4; ++l) { g[l] = G[l * 1024 + gt]; mx = fmaxf(mx, g[l]); }
          float e[4], s = 0.f; for (int l = 0; l < 4; ++l) { e[l] = expf(g[l] - mx); s += e[l]; }
          float* LB = WSP(float, WS_LB); float cum = 0.f;
          for (int l = 0; l < 4; ++l) { if (l > 0) cum += e[l] / s; LB[l * 1024 + gt] = fminf(fmaxf(cum, 0.f), 1.0f - 1e-6f); } } }
    { const int gt = gw * 64 + F.lane, NT = NGW * 64; GAS v4u* z = (GAS v4u*)WSP(char, WS_QEXT); const v4u zero = {0u, 0u, 0u, 0u};
      for (int e = gt; e < (int)(32 * MiB / 16); e += NT) z[e] = zero; }
}

__device__ __forceinline__ void p2_rows(Frame& F, const Ptrs& P, int l, int blk  ) {
    const int l16 = F.lane & 15, rsub = F.lane >> 4;
    const float* fb = P.inp(5) + l * 8; const f32x2* rope = WSP(f32x2, WS_ROPE);
#pragma unroll
    for (int it = 0; it < 2; ++it) { const int m = blk * 64 + F.wave * 8 + it * 4 + rsub;
        const float* css = WSP(float, WS_CSS) + (size_t)m * 20; const float* px = WSP(float, WS_PROJX) + (size_t)m * 256;
        const float c0 = css[l16], c1 = l16 < 4 ? css[16 + l16] : 0.f;
        const float x1a = px[l16], x2a = px[32 + l16], x1b = px[16 + l16], x2b = px[48 + l16];
        const f32x2 csa = rope[(size_t)m * 32 + l16], csb = rope[(size_t)m * 32 + 16 + l16];
        const float xf = l16 < 8 ? px[64 + l16] + fb[l16] : 0.f;
        float sq = l16 < 12 ? c0 : 0.f, skv = (l16 >= 12 ? c0 : 0.f) + c1;
#pragma unroll
        for (int x = 1; x < 16; x <<= 1) { sq += __shfl_xor(sq, x); skv += __shfl_xor(skv, x); }
        if (l16 == 0) { WSP(float, WS_RQ)[m] = __builtin_amdgcn_rsqf(sq * (1.f / 768.f) + EPS); WSP(float, WS_RKV)[m] = __builtin_amdgcn_rsqf(skv * (1.f / 512.f) + EPS); }
        GAS unsigned* kr = (GAS unsigned*)(WSP(bf16, WS_KROT) + (size_t)m * 64);
        kr[l16] = pk2(x1a * csa.x - x2a * csa.y, x1a * csa.y + x2a * csa.x); kr[16 + l16] = pk2(x1b * csb.x - x2b * csb.y, x1b * csb.y + x2b * csb.x);
        if (l16 < 8) WSP(float, WS_FOXLF)[(size_t)m * 8 + l16] = fminf(xf, 0.f) - __logf(1.0f + __expf(-fabsf(xf)));
    }
}

__device__ __forceinline__ float block_sum512(Frame& F, float v, LAS float* red) {
    v = wave_sum(v); if (F.lane == 0) red[F.wave] = v; LDS_WAIT(); __syncthreads();
    float t = 0.f;
#pragma unroll
    for (int w = 0; w < 8; ++w) t += red[w];
    __syncthreads(); return t;
}
__device__ __forceinline__ void fox_scan(Frame& F, const Ptrs& P, int item) {
    const int bh = item >> 4, seg = item & 15, b = bh >> 3, h = bh & 7, tid = F.tid;
    LAS float* red = (LAS float*)(F.lds); LAS float* wtot = red + 8; LAS float* mx = red + 16;
    const float* lf = WSP(float, WS_FOXLF) + ((size_t)b * SEQ) * 8 + h;
    float part = 0.f;
#pragma unroll
    for (int j = 0; j < 15; ++j) if (j < seg) part += lf[(size_t)(tid + 512 * j) * 8];
    const float prefix = block_sum512(F, part, red);
    const int s = seg * 512 + tid;
    const float own = lf[(size_t)s * 8];
    float incl = own;
#pragma unroll
    for (int o = 1; o < 64; o <<= 1) { const float t = __shfl_up(incl, o); if (F.lane >= o) incl += t; }
    if (F.lane == 63) wtot[F.wave] = incl;
    LDS_WAIT(); __syncthreads();
    float off = prefix;
    for (int w = 0; w < F.wave; ++w) off += wtot[w];
    const float c = (incl + off) * LOG2E;
    { bf16* qe = WSP(bf16, WS_QEXT) + ((size_t)bh * SEQ + s) * 64; bf16* ke = WSP(bf16, WS_KEXT) + ((size_t)bh * SEQ + s) * 64;
      const unsigned one = 0x3f80u;
      const unsigned c1 = f2bf(c); const float r1 = c - bf2f((unsigned short)c1); const unsigned c2 = f2bf(r1); const float r2 = r1 - bf2f((unsigned short)c2); const unsigned c3 = f2bf(r2);
      v4u q; q.x = c1 | (c2 << 16); q.y = c3 | (one << 16); q.z = one | (one << 16); q.w = 0u;
      v4u k; k.x = one | (one << 16); k.y = one | ((c1 ^ 0x8000u) << 16); k.z = (c2 ^ 0x8000u) | ((c3 ^ 0x8000u) << 16); k.w = 0u;
      *(GAS v4u*)qe = q; *(GAS v4u*)ke = k;
      WSP(float, WS_FOXC)[(size_t)bh * SEQ + s] = c; }
    const bf16* fq = WSP(bf16, WS_FOX) + ((size_t)bh * SEQ + (size_t)seg * 512) * 128; const bf16* fk = fq + (size_t)16 * SEQ * 128;
    float qm0 = 0.f, qm1 = 0.f, km = 0.f;
#pragma unroll
    for (int hb = 0; hb < 2; ++hb) { v4u qa[8], ka[8];
#pragma unroll
        for (int i = 0; i < 8; ++i) { const size_t o = (size_t)((hb * 8 + i) * 32 + (tid >> 4)) * 128 + (tid & 15) * 8; qa[i] = *(const GAS v4u*)(fq + o); ka[i] = *(const GAS v4u*)(fk + o); }
#pragma unroll
        for (int i = 0; i < 8; ++i) {
            float sq = (bflo(qa[i].x) * bflo(qa[i].x) + bfhi(qa[i].x) * bfhi(qa[i].x)) + (bflo(qa[i].y) * bflo(qa[i].y) + bfhi(qa[i].y) * bfhi(qa[i].y)) + (bflo(qa[i].z) * bflo(qa[i].z) + bfhi(qa[i].z) * bfhi(qa[i].z)) + (bflo(qa[i].w) * bflo(qa[i].w) + bfhi(qa[i].w) * bfhi(qa[i].w));
            float sk = (bflo(ka[i].x) * bflo(ka[i].x) + bfhi(ka[i].x) * bfhi(ka[i].x)) + (bflo(ka[i].y) * bflo(ka[i].y) + bfhi(ka[i].y) * bfhi(ka[i].y)) + (bflo(ka[i].z) * bflo(ka[i].z) + bfhi(ka[i].z) * bfhi(ka[i].z)) + (bflo(ka[i].w) * bflo(ka[i].w) + bfhi(ka[i].w) * bfhi(ka[i].w));
#pragma unroll
            for (int x = 1; x < 16; x <<= 1) { sq += __shfl_xor(sq, x); sk += __shfl_xor(sk, x); }
            if (hb == 0) qm0 = fmaxf(qm0, sq); else qm1 = fmaxf(qm1, sq);
            km = fmaxf(km, sk); } }
#pragma unroll
    for (int x = 16; x < 64; x <<= 1) { qm0 = fmaxf(qm0, __shfl_xor(qm0, x)); qm1 = fmaxf(qm1, __shfl_xor(qm1, x)); km = fmaxf(km, __shfl_xor(km, x)); }
    if (F.lane == 0) { mx[F.wave * 3] = qm0; mx[F.wave * 3 + 1] = qm1; mx[F.wave * 3 + 2] = km; }
    LDS_WAIT(); __syncthreads();
    if (tid < 3) { float m = 0.f; for (int w = 0; w < 8; ++w) m = fmaxf(m, mx[w * 3 + tid]);
        if (tid < 2) WSP(float, WS_FOXQM)[bh * 32 + seg * 2 + tid] = m; else WSP(float, WS_FOXKM)[bh * 16 + seg] = m; }
    __syncthreads();
}

constexpr int HL_QT = 0, HL_KT = 17408, HL_QH = 34816, HL_VT = 52224, HL_SC = 70656, HL_QTOT = 79872, HL_RS = 81920, HL_KHT = 0  ;
__device__ __forceinline__ float clampe(float x) { return __expf(fminf(x, 80.f)); }
constexpr int H1_QTOT = 40960  ;
struct H1Regs { f32x4 lf[4]; v2u kw[4], vw[4]; };
__device__ __forceinline__ void hgrn_local_load(Frame& F, const Ptrs& P, int ch, H1Regs& R) {
    const int tid = F.tid, tg = tid >> 5, cg = tid & 31;
    const int bh = ch >> 7, n = ch & 127, b = bh >> 3, h = bh & 7;
    const size_t tok0 = (size_t)b * SEQ + (size_t)n * 64; const int cb = h * 128;
    const float* logf = WSP(float, WS_LOGF) + (tok0 + 4 * tg) * 1024 + cb + 4 * cg; const bf16* proj = WSP(bf16, WS_PROJ) + (tok0 + 4 * tg) * 4096 + cb + 4 * cg;
#pragma unroll
    for (int i = 0; i < 4; ++i) { R.lf[i] = *(const GAS f32x4*)(logf + (size_t)i * 1024); R.kw[i] = *(const GAS v2u*)(proj + (size_t)i * 4096 + 1024); R.vw[i] = *(const GAS v2u*)(proj + (size_t)i * 4096 + 2048); }
}
__device__ __forceinline__ void hgrn_local(Frame& F, const Ptrs& P, int ch, H1Regs& R) {
    const int tid = F.tid, tg = tid >> 5, cg = tid & 31;
    LAS float* QTOT = (LAS float*)(F.lds + H1_QTOT);
    f32x4 lf[4]; v2u kw[4], vw[4];
#pragma unroll
    for (int i = 0; i < 4; ++i) { lf[i] = R.lf[i]; kw[i] = R.kw[i]; vw[i] = R.vw[i]; }
    lf[1] = lf[1] + lf[0]; lf[2] = lf[2] + lf[1]; lf[3] = lf[3] + lf[2];
    *(LAS f32x4*)(QTOT + tg * 128 + 4 * cg) = lf[3];
    { v2u t; t.x = (vw[0].x & 0xffffu) | (vw[1].x << 16); t.y = (vw[2].x & 0xffffu) | (vw[3].x << 16); *(LAS v2u*)(F.lds + HL_VT + (4 * cg + 0) * 144 + 8 * tg) = t;
      t.x = (vw[0].x >> 16) | (vw[1].x & 0xffff0000u); t.y = (vw[2].x >> 16) | (vw[3].x & 0xffff0000u); *(LAS v2u*)(F.lds + HL_VT + (4 * cg + 1) * 144 + 8 * tg) = t;
      t.x = (vw[0].y & 0xffffu) | (vw[1].y << 16); t.y = (vw[2].y & 0xffffu) | (vw[3].y << 16); *(LAS v2u*)(F.lds + HL_VT + (4 * cg + 2) * 144 + 8 * tg) = t;
      t.x = (vw[0].y >> 16) | (vw[1].y & 0xffff0000u); t.y = (vw[2].y >> 16) | (vw[3].y & 0xffff0000u); *(LAS v2u*)(F.lds + HL_VT + (4 * cg + 3) * 144 + 8 * tg) = t; }
    LDS_WAIT(); __syncthreads();
    f32x4 off = {0.f, 0.f, 0.f, 0.f}, bend = {0.f, 0.f, 0.f, 0.f};
#pragma unroll
    for (int g = 0; g < 16; ++g) { const f32x4 t = *(const LAS f32x4*)(QTOT + g * 128 + 4 * cg); if (g < tg) off = off + t; bend = bend + t; }
    f32x4 kh[4];
#pragma unroll
    for (int i = 0; i < 4; ++i) { const f32x4 kv = {bflo(kw[i].x), bfhi(kw[i].x), bflo(kw[i].y), bfhi(kw[i].y)};
#pragma unroll
        for (int j = 0; j < 4; ++j) kh[i][j] = kv[j] * __expf(bend[j] - (lf[i][j] + off[j])); }
#pragma unroll
    for (int j = 0; j < 4; ++j) { v2u t; t.x = pk2(kh[0][j], kh[1][j]); t.y = pk2(kh[2][j], kh[3][j]); *(LAS v2u*)(F.lds + HL_KHT + (4 * cg + j) * 144 + 8 * tg) = t; }
    if (tg == 0) { f32x4 a; a[0] = __expf(bend[0]); a[1] = __expf(bend[1]); a[2] = __expf(bend[2]); a[3] = __expf(bend[3]); *(GAS f32x4*)(WSP(float, WS_ADEC) + (size_t)ch * 128 + 4 * cg) = a; }
    LDS_WAIT(); __syncthreads();
    const int w = F.wave, r32 = F.lane & 31, hi = F.lane >> 5, mt = w >> 1;
    bf16* LT = WSP(bf16, WS_LT) + (size_t)ch * 16384;
#pragma unroll
    for (int n2 = 0; n2 < 2; ++n2) { const int nt = (w & 1) * 2 + n2; f32x16 acc = {};
#pragma unroll
        for (int ks = 0; ks < 4; ++ks) {
            const bf16x8 A = *(const LAS bf16x8*)(F.lds + HL_VT + (32 * mt + r32) * 144 + (16 * ks + 8 * hi) * 2);
            const bf16x8 B = *(const LAS bf16x8*)(F.lds + HL_KHT + (32 * nt + r32) * 144 + (16 * ks + 8 * hi) * 2);
            acc = __builtin_amdgcn_mfma_f32_32x32x16_bf16(A, B, acc, 0, 0, 0); }
#pragma unroll
        for (int r = 0; r < 16; ++r) LT[(32 * mt + att::crow(r, hi)) * 128 + 32 * nt + r32] = (bf16)f2bf(acc[r]); }
    __syncthreads();
}
__device__ __forceinline__ void hgrn_scan(Frame& F, const Ptrs& P) {
    const int gt = (F.vcu * NWAVES + F.wave) * 64 + F.lane, NT = F.G * NWAVES * 64;
    for (int e = gt; e < 16 * 128 * 64; e += NT) {
        const int bh = e >> 13, v = (e >> 6) & 127, k = (e & 63) * 2;
        const bf16* LT = WSP(bf16, WS_LT) + (size_t)bh * 128 * 16384 + v * 128 + k;
        const float* ad = WSP(float, WS_ADEC) + (size_t)bh * 128 * 128 + k;
        bf16* ST = WSP(bf16, WS_ST) + (size_t)bh * 128 * 16384 + v * 128 + k;
        float s0 = 0.f, s1 = 0.f;
        unsigned lt[16]; f32x2 a[16];
#pragma unroll
        for (int i = 0; i < 16; ++i) { lt[i] = *(const GAS unsigned*)(LT + (size_t)i * 16384); a[i] = *(const GAS f32x2*)(ad + i * 128); }
        for (int nb = 0; nb < 128; nb += 16) {
            unsigned o[16];
#pragma unroll
            for (int i = 0; i < 16; ++i) { o[i] = pk2(s0, s1); s0 = a[i].x * s0 + bflo(lt[i]); s1 = a[i].y * s1 + bfhi(lt[i]); }
            if (nb + 16 < 128) {
#pragma unroll
                for (int i = 0; i < 16; ++i) { lt[i] = *(const GAS unsigned*)(LT + (size_t)(nb + 16 + i) * 16384); a[i] = *(const GAS f32x2*)(ad + (nb + 16 + i) * 128); } }
#pragma unroll
            for (int i = 0; i < 16; ++i) *(GAS unsigned*)(ST + (size_t)(nb + i) * 16384) = o[i];
        }
    }
}
constexpr int HO_QTOT = 79872  , HO_RS = 88064  , HO_GT = 89088  ;
__device__ __forceinline__ void hgrn_out(Frame& F, const Ptrs& P, int ch, int l) {
    const int tid = F.tid, tg = tid >> 5, cg = tid & 31;
    const int bh = ch >> 7, n = ch & 127, b = bh >> 3, h = bh & 7;
    const size_t tok0 = (size_t)b * SEQ + (size_t)n * 64; const int cb = h * 128;
    const float* logf = WSP(float, WS_LOGF) + (tok0 + 4 * tg) * 1024 + cb + 4 * cg; const bf16* proj = WSP(bf16, WS_PROJ) + (tok0 + 4 * tg) * 4096 + cb + 4 * cg;
    LAS float* QTOT = (LAS float*)(F.lds + HO_QTOT); LAS float* RS = (LAS float*)(F.lds + HO_RS);
    const int w = F.wave, r32 = F.lane & 31, hi = F.lane >> 5, mt = w >> 2, nt = w & 3;
    f32x4 lf[4]; v2u qw[4], kw[4], vw[4], gw[4]; bf16x8 stf[8];
#pragma unroll
    for (int i = 0; i < 4; ++i) { lf[i] = *(const GAS f32x4*)(logf + (size_t)i * 1024); qw[i] = *(const GAS v2u*)(proj + (size_t)i * 4096); kw[i] = *(const GAS v2u*)(proj + (size_t)i * 4096 + 1024);
        vw[i] = *(const GAS v2u*)(proj + (size_t)i * 4096 + 2048); }
#pragma unroll
    for (int i = 0; i < 4; ++i) gw[i] = *(const GAS v2u*)(proj + (size_t)i * 4096 + 3072);
    { const bf16* ST = WSP(bf16, WS_ST) + (size_t)ch * 16384 + (32 * nt + r32) * 128 + 8 * hi;
#pragma unroll
      for (int ks = 0; ks < 8; ++ks) stf[ks] = *(const GAS bf16x8*)(ST + 16 * ks); }
    lf[1] = lf[1] + lf[0]; lf[2] = lf[2] + lf[1]; lf[3] = lf[3] + lf[2];
    *(LAS f32x4*)(QTOT + tg * 128 + 4 * cg) = lf[3];
#pragma unroll
    for (int i = 0; i < 4; ++i) *(LAS v2u*)(F.lds + HO_GT + (4 * tg + i) * 272 + 8 * cg) = gw[i];
    { v2u t; t.x = (vw[0].x & 0xffffu) | (vw[1].x << 16); t.y = (vw[2].x & 0xffffu) | (vw[3].x << 16); *(LAS v2u*)(F.lds + HL_VT + (4 * cg + 0) * 144 + 8 * tg) = t;
      t.x = (vw[0].x >> 16) | (vw[1].x & 0xffff0000u); t.y = (vw[2].x >> 16) | (vw[3].x & 0xffff0000u); *(LAS v2u*)(F.lds + HL_VT + (4 * cg + 1) * 144 + 8 * tg) = t;
      t.x = (vw[0].y & 0xffffu) | (vw[1].y << 16); t.y = (vw[2].y & 0xffffu) | (vw[3].y << 16); *(LAS v2u*)(F.lds + HL_VT + (4 * cg + 2) * 144 + 8 * tg) = t;
      t.x = (vw[0].y >> 16) | (vw[1].y & 0xffff0000u); t.y = (vw[2].y >> 16) | (vw[3].y & 0xffff0000u); *(LAS v2u*)(F.lds + HL_VT + (4 * cg + 3) * 144 + 8 * tg) = t; }
    LDS_WAIT(); __syncthreads();
    f32x4 off = {0.f, 0.f, 0.f, 0.f}, rref = {0.f, 0.f, 0.f, 0.f};
#pragma unroll
    for (int g = 0; g < 16; ++g) { const f32x4 t = *(const LAS f32x4*)(QTOT + g * 128 + 4 * cg); if (g < tg) off = off + t; if (g < 8) rref = rref + t; }
#pragma unroll
    for (int i = 0; i < 4; ++i) { const f32x4 bb = lf[i] + off;
        const f32x4 qv = {bflo(qw[i].x), bfhi(qw[i].x), bflo(qw[i].y), bfhi(qw[i].y)}, kv = {bflo(kw[i].x), bfhi(kw[i].x), bflo(kw[i].y), bfhi(kw[i].y)};
        f32x4 qt, kt, qh;
#pragma unroll
        for (int j = 0; j < 4; ++j) { qt[j] = qv[j] * clampe(bb[j] - rref[j]); kt[j] = kv[j] * clampe(rref[j] - bb[j]); qh[j] = qv[j] * __expf(bb[j]); }
        v2u a; a.x = pk2(qt[0], qt[1]); a.y = pk2(qt[2], qt[3]); *(LAS v2u*)(F.lds + HL_QT + (4 * tg + i) * 272 + 8 * cg) = a;
        a.x = pk2(kt[0], kt[1]); a.y = pk2(kt[2], kt[3]); *(LAS v2u*)(F.lds + HL_KT + (4 * tg + i) * 272 + 8 * cg) = a;
        a.x = pk2(qh[0], qh[1]); a.y = pk2(qh[2], qh[3]); *(LAS v2u*)(F.lds + HL_QH + (4 * tg + i) * 272 + 8 * cg) = a; }
    LDS_WAIT(); __syncthreads();
    if (w < 4) { const int mt2 = w >> 1, nt2 = w & 1; f32x16 acc = {};
#pragma unroll
        for (int ks = 0; ks < 8; ++ks) {
            const bf16x8 A = *(const LAS bf16x8*)(F.lds + HL_QT + (32 * mt2 + r32) * 272 + (16 * ks + 8 * hi) * 2);
            const bf16x8 B = *(const LAS bf16x8*)(F.lds + HL_KT + (32 * nt2 + r32) * 272 + (16 * ks + 8 * hi) * 2);
            acc = __builtin_amdgcn_mfma_f32_32x32x16_bf16(A, B, acc, 0, 0, 0); }
#pragma unroll
        for (int r = 0; r < 16; ++r) { const int t = 32 * mt2 + att::crow(r, hi), s = 32 * nt2 + r32;
            *(LAS unsigned short*)(F.lds + HL_SC + t * 144 + s * 2) = (unsigned short)f2bf(s <= t ? acc[r] : 0.f); } }
    LDS_WAIT(); __syncthreads();
    f32x16 acc = {};
#pragma unroll
    for (int ks = 0; ks < 4; ++ks) {
        const bf16x8 A = *(const LAS bf16x8*)(F.lds + HL_SC + (32 * mt + r32) * 144 + (16 * ks + 8 * hi) * 2);
        const bf16x8 B = *(const LAS bf16x8*)(F.lds + HL_VT + (32 * nt + r32) * 144 + (16 * ks + 8 * hi) * 2);
        acc = __builtin_amdgcn_mfma_f32_32x32x16_bf16(A, B, acc, 0, 0, 0); }
#pragma unroll
    for (int ks = 0; ks < 8; ++ks) {
        const bf16x8 A = *(const LAS bf16x8*)(F.lds + HL_QH + (32 * mt + r32) * 272 + (16 * ks + 8 * hi) * 2);
        acc = __builtin_amdgcn_mfma_f32_32x32x16_bf16(A, stf[ks], acc, 0, 0, 0); }
#pragma unroll
    for (int r = 0; r < 16; ++r) { float ss = acc[r] * acc[r];
        ss += __shfl_xor(ss, 1); ss += __shfl_xor(ss, 2); ss += __shfl_xor(ss, 4); ss += __shfl_xor(ss, 8); ss += __shfl_xor(ss, 16);
        if (r32 == 0) RS[nt * 64 + 32 * mt + att::crow(r, hi)] = ss; }
    LDS_WAIT(); __syncthreads();
    const int vl = 32 * nt + r32; const float ga = P.inp(10)[(size_t)l * 4096 + cb + vl];
    bf16* mix = WSP(bf16, WS_MIX);
#pragma unroll
    for (int r = 0; r < 16; ++r) { const int t = 32 * mt + att::crow(r, hi);
        const float tot = (RS[t] + RS[64 + t]) + (RS[128 + t] + RS[192 + t]);
        const float rstd = __builtin_amdgcn_rsqf(tot * (1.f / 128.f) + EPS);
        const float g = bf2f(*(const LAS unsigned short*)(F.lds + HO_GT + t * 272 + vl * 2));
        const float o = acc[r] * rstd * ga * (g * __builtin_amdgcn_rcpf(1.0f + __expf(-g)));
        const float on = __shfl_xor(o, 1);
        if ((r32 & 1) == 0) *(GAS unsigned*)(mix + (tok0 + t) * 4096 + cb + vl) = pk2(o, on); }
    __syncthreads();
}
constexpr int ATT_ITEMS = 768;
__device__ __forceinline__ att::BlockRef mix_block(const Ptrs& P, int l, int j, int pass) {
    att::BlockRef r;
    const int x = j & 15, qb = pass ? 31 - x : x;
    if (j < 512) { const int bh = j >> 4, b = bh >> 4, h = bh & 15; const size_t q0 = (size_t)bh * SEQ + (size_t)qb * 256;
        r.Q = WSP(bf16, WS_QN) + q0 * 128; r.QX = WSP(bf16, WS_QR) + q0 * 64;
        r.K = WSP(bf16, WS_KN) + (size_t)bh * SEQ * 128; r.V = WSP(bf16, WS_VC) + (size_t)bh * SEQ * 128; r.KX = WSP(bf16, WS_KROT) + (size_t)b * SEQ * 64;
        r.O = WSP(bf16, WS_MIX) + ((size_t)b * SEQ + (size_t)qb * 256) * 4096 + 2048 + h * 128; r.G = P.inp(10) + (size_t)l * 4096 + 2048 + h * 128; }
    else { const int bh = (j - 512) >> 4, b = bh >> 3, h = bh & 7; const size_t q0 = (size_t)bh * SEQ + (size_t)qb * 256;
        r.Q = WSP(bf16, WS_FOX) + q0 * 128; r.QX = WSP(bf16, WS_QEXT) + q0 * 64;
        r.K = WSP(bf16, WS_FOX) + ((size_t)(16 + bh) * SEQ) * 128; r.V = WSP(bf16, WS_FOX) + ((size_t)(32 + bh) * SEQ) * 128; r.KX = WSP(bf16, WS_KEXT) + (size_t)bh * SEQ * 64;
        r.O = WSP(bf16, WS_MIX) + ((size_t)b * SEQ + (size_t)qb * 256) * 4096 + 1024 + h * 128; r.G = P.inp(10) + (size_t)l * 4096 + 1024 + h * 128; }
    r.P0 = qb * 256; r.jlo = 0;
    if (j >= 512) {
        const int bh = (j - 512) >> 4; const float* C = WSP(float, WS_FOXC) + (size_t)bh * SEQ;
        float km = 0.f;
        for (int sgi = 0; sgi < 16; ++sgi) km = fmaxf(km, WSP(float, WS_FOXKM)[bh * 16 + sgi]);
        const float bound = 2.0f * sqrtf(WSP(float, WS_FOXQM)[bh * 32 + qb] * km) * 1.01f + 100.0f;
        const float ct0 = C[qb * 256];
        const int nt = qb * 4;
        int lane_; asm volatile("v_mbcnt_lo_u32_b32 %0, -1, 0\n\tv_mbcnt_hi_u32_b32 %0, -1, %0" : "=v"(lane_));
        bool keep0 = true, keep1 = true;
        if (lane_ < nt) keep0 = (ct0 - C[64 * lane_ + 63]) >= -bound;
        if (lane_ + 64 < nt) keep1 = (ct0 - C[64 * (lane_ + 64) + 63]) >= -bound;
        const unsigned long long m0 = __ballot(keep0), m1 = __ballot(keep1);
        int jl = m0 ? __builtin_ctzll(m0) : (m1 ? 64 + __builtin_ctzll(m1) : nt);
        r.jlo = __builtin_amdgcn_readfirstlane(jl < nt ? jl : nt);
    }
    return r;
}
__device__ __forceinline__ void mix_attention(Frame& F, const Ptrs& P, int l) {
    const int nit = (ATT_ITEMS - F.vcu + F.G - 1) / F.G;
    if (nit <= 0) return;
    const int nblk = 2 * nit;
    att::Seam<true> S;
    att::BlockRef cur = mix_block(P, l, F.vcu, 0);
    att::attn_prime<true>(cur, 1 << 30, F.ldsg, S, fresh_tid(F.wave));
    for (int k = 0; k < nblk; ++k) {
        const int kn = (k + 1 < nblk) ? k + 1 : k;
        const att::BlockRef nxt = mix_block(P, l, F.vcu + (kn >> 1) * F.G, kn & 1);
        att::attn_block<true, true, 4096>(cur, nxt, SEQ, 1 << 30, F.ldsg, S, fresh_tid(F.wave));
        cur = nxt;
    }
}
__device__ __forceinline__ att::BlockRef mem_block(const Ptrs& P, int l, int j) {
    att::BlockRef r; const int bh = j >> 5, qb = j & 31, b = bh >> 2, h = bh & 3;
    r.Q = WSP(bf16, WS_QMEM) + ((size_t)bh * SEQ + (size_t)qb * 256) * 128; r.QX = r.Q;
    r.K = WSP(bf16, WS_KVMEM) + ((size_t)l * 2 * 8 + bh) * 256 * 128; r.V = r.K + (size_t)8 * 256 * 128; r.KX = r.K;
    r.O = WSP(bf16, WS_OMEM) + ((size_t)b * SEQ + (size_t)qb * 256) * 512 + h * 128; r.G = nullptr; r.P0 = MEMT; r.jlo = 0;
    return r;
}
__device__ __forceinline__ void mem_attention(Frame& F, const Ptrs& P, int l) {
    const int nblk = (256 - F.vcu + F.G - 1) / F.G;
    if (nblk <= 0) return;
    att::Seam<false> S;
    att::BlockRef cur = mem_block(P, l, F.vcu);
    att::attn_prime<false>(cur, 1 << 30, F.ldsg, S, fresh_tid(F.wave));
    for (int k = 0; k < nblk; ++k) {
        const int kn = (k + 1 < nblk) ? k + 1 : k;
        const att::BlockRef nxt = mem_block(P, l, F.vcu + kn * F.G);
        att::attn_block<false, false, 512>(cur, nxt, MEMT, 1 << 30, F.ldsg, S, fresh_tid(F.wave));
        cur = nxt;
    }
}

constexpr int NPH = 13;
constexpr int NPHASES = 1 + DEPTH * NPH;
__global__ void __launch_bounds__(NWAVES * 64, 2) trunk_fwd(Args args) {
    extern __shared__ __attribute__((aligned(16))) unsigned char lds[];
    const int wave_s = __builtin_amdgcn_readfirstlane(threadIdx.x >> 6);
    for (int u = threadIdx.x; u < (LDS_BYTES - LDSCTL_OFF) / 4; u += NWAVES * 64) ((LAS unsigned*)((LAS unsigned char*)lds + LDSCTL_OFF))[u] = 0u;
    __syncthreads();
    XcdBarrier bar = xcd_barrier_post((unsigned*)(args.ws + WS_CTL) + CW_BAR, (volatile LAS unsigned*)((LAS unsigned char*)lds + MISC_OFF) + 8);
#define PH_BEGIN() Frame F; { int ln_; asm volatile("v_mbcnt_lo_u32_b32 %0, -1, 0\n\tv_mbcnt_hi_u32_b32 %0, -1, %0" : "=v"(ln_)); F.tid = wave_s * 64 + ln_; } F.lds = (LAS unsigned char*)lds; F.ldsg = (char*)lds; F.MISC = (volatile LAS unsigned*)(F.lds + MISC_OFF); F.lane = F.tid & 63; F.wave = __builtin_amdgcn_readfirstlane(F.tid >> 6); \
    F.G = gridDim.x; { int bx = blockIdx.x; asm volatile("" : "+s"(bx)); F.vcu = (F.G % 8 == 0) ? (bx % 8) * (F.G / 8) + bx / 8 : bx; F.bx = bx; } \
    const CArgs* ap_ = (const CArgs*)__builtin_amdgcn_kernarg_segment_ptr(); asm volatile("" : "+s"(ap_)); const Ptrs P{ap_, ap_->out, ap_->ws}; LAS unsigned char* ring = F.lds;
    const int lo = args.ph_lo, hi = args.ph_hi;
#ifndef PH_MASK
#define PH_MASK 0xFFFFFFFFu
#endif
#define RUN(g) (lo <= (g) && (g) < hi)
#define EN(p) ((PH_MASK >> (p)) & 1u)
#ifndef DBL_MASK
#define DBL_MASK 0u
#endif
#define REPS(p) (((DBL_MASK >> (p)) & 1u) ? 2 : 1)
#ifdef PROBE_ID
    unsigned long long pr_acc = 0ull, pr_t0 = 0ull;
#define PR_BEGIN(id) do { if ((id) == PROBE_ID) pr_t0 = __builtin_amdgcn_s_memrealtime(); } while (0)
#define PR_END(id) do { if ((id) == PROBE_ID) pr_acc += __builtin_amdgcn_s_memrealtime() - pr_t0; } while (0)
#else
#define PR_BEGIN(id) do {} while (0)
#define PR_END(id) do {} while (0)
#endif
#define PHASE_END(g) do { if ((g) + 1 < hi) { PH_BEGIN(); xcd_barrier_steal(bar, F, P); } } while (0)

    if (EN(0) && RUN(0)) { PR_BEGIN(0); for (int rep_ = 0; rep_ < REPS(0); ++rep_) { PH_BEGIN(); p0_prologue(F, P); __syncthreads(); } PHASE_END(0); PR_END(0); }

    const int F0G = gridDim.x;
    for (int l = 0; l < DEPTH; ++l) {
        const int g0 = 1 + l * NPH;
        static_assert(pg8::WGM == 8 && pg8::NXCD == 8 && NIN == 8704 && M == 16384, "the cut after 8 rounds relies on StaticOrder dealing column tiles 32, 33 (all 64 row panels) in round 8 of a 256-workgroup grid");
        const int nfull = (F0G == 256) ? (64 * (NIN / 256)) / 256 : (1 << 20);
        if (EN(1) && RUN(g0 + 0)) { PR_BEGIN(1); for (int rep_ = 0; rep_ < REPS(1); ++rep_) { PH_BEGIN();
            { pg8::Gemm g{WSP(bf16, WS_HN), WLAYER(bf16, l, W_IN), M, NIN, DM}; pg8::RoundOrder S; S.s.init(M, NIN, F.G, F.bx); S.lo = 0; S.hi = nfull;
              pg8::EpiProj E{WSP(bf16, WS_PROJ), WSP(bf16, WS_FOX), WSP(float, WS_LOGF), WSP(float, WS_PROJX), WSP(bf16, WS_CQN), WSP(bf16, WS_CKVN), WSP(float, WS_CSS), WSP(float, WS_LB) + l * 1024, QSCALE_128, WSP(float, WS_HSS)};
              pg8::gemm_phase<pg8::EpiProj, pg8::RoundOrder, true, true>(ring, g, S, E, F.tid); }
            __syncthreads(); }
            PHASE_END(g0 + 0); PR_END(1);
        }
        if (EN(2) && RUN(g0 + 1)) { PR_BEGIN(2); for (int rep_ = 0; rep_ < REPS(2); ++rep_) { PH_BEGIN();
            PR_BEGIN(22); { pg8::Gemm g{WSP(bf16, WS_HN), WLAYER(bf16, l, W_IN), M, NIN, DM}; pg8::RoundOrder S; S.s.init(M, NIN, F.G, F.bx); S.lo = nfull; S.hi = 1 << 30;
              pg8::EpiProj E{WSP(bf16, WS_PROJ), WSP(bf16, WS_FOX), WSP(float, WS_LOGF), WSP(float, WS_PROJX), WSP(bf16, WS_CQN), WSP(bf16, WS_CKVN), WSP(float, WS_CSS), WSP(float, WS_LB) + l * 1024, QSCALE_128, WSP(float, WS_HSS)};
              pg8::gemm_phase<pg8::EpiProj, pg8::RoundOrder, true, true>(ring, g, S, E, F.tid); } PR_END(22);
            if (l == 0) {
                for (int ll = 0; ll < DEPTH; ++ll) {
                    pg8::Gemm g{WSP(bf16, WS_MEMN) + (size_t)ll * 512 * DM, WLAYER(bf16, ll, W_MKV), BATCH * MEMT, 1024, DM}; pg8::StaticOrder S;
                    S.init(BATCH * MEMT, 1024, F.G, (int)((F.bx + F.G - (F.G / 2 + 8 * ll) % F.G) % F.G));
                    pg8::EpiKVmem E{WSP(bf16, WS_KVMEM) + (size_t)ll * 2 * 8 * 256 * 128, WSP(bf16, WS_KVMEM) + ((size_t)ll * 2 + 1) * 8 * 256 * 128};
                    pg8::gemm_phase<pg8::EpiKVmem, pg8::StaticOrder, true, true>(ring, g, S, E, F.tid); }
            }
            __syncthreads();
            PR_BEGIN(23); { gu32* qctr = (gu32*)(P.ws + WS_CTL) + CW_Q + (l * 2 + rep_) * 64; volatile LAS unsigned* slot = F.MISC + 4;
              for (;;) {
                  if (F.tid == 0) *slot = __hip_atomic_fetch_add(qctr, 4u, RLX_AGENT);
                  LDS_WAIT(); __syncthreads();
                  const int it0 = (int)*slot;
                  __syncthreads();
                  if (it0 >= 256 + 2048) break;
                  if (it0 < 256) { for (int it = it0; it < it0 + 4; ++it) p2_rows(F, P, l, it); }
                  else { const int c0_ = it0 - 256; H1Regs R0, R1;
                      hgrn_local_load(F, P, c0_, R0); hgrn_local_load(F, P, c0_ + 1, R1); hgrn_local(F, P, c0_, R0);
                      hgrn_local_load(F, P, c0_ + 2, R0); hgrn_local(F, P, c0_ + 1, R1);
                      hgrn_local_load(F, P, c0_ + 3, R1); hgrn_local(F, P, c0_ + 2, R0); hgrn_local(F, P, c0_ + 3, R1); }
              } } PR_END(23);
            __syncthreads(); }
            PHASE_END(g0 + 1); PR_END(2);
        }
        if (EN(3) && RUN(g0 + 2)) { PR_BEGIN(3); for (int rep_ = 0; rep_ < REPS(3); ++rep_) { PH_BEGIN();
#ifndef NO_SCANS
            PR_BEGIN(30); PR_BEGIN(33); for (int it = F.vcu; it < 256; it += F.G) fox_scan(F, P, it); PR_END(33);
            PR_BEGIN(34); hgrn_scan(F, P); PR_END(34);
            __syncthreads(); PR_END(30);
#endif
#ifndef NO_QFULL
            PR_BEGIN(31); { pg8::Gemm g{WSP(bf16, WS_CQN), WLAYER(bf16, l, W_UQ), M, 3072, 768}; pg8::StaticOrder S; S.init(M, 3072, F.G, F.bx);
              pg8::EpiQfull E{WSP(bf16, WS_QN), WSP(bf16, WS_QR), WSP(float, WS_ROPE), QSCALE_MLA, WSP(float, WS_RQ)};
              pg8::gemm_phase<pg8::EpiQfull, pg8::StaticOrder, true, true>(ring, g, S, E, F.tid); } PR_END(31);
#endif
            PR_BEGIN(32); { pg8::Gemm g{WSP(bf16, WS_CKVN), WLAYER(bf16, l, W_UKV), M, 4096, 512}; pg8::StaticOrder S; S.init(M, 4096, F.G, F.bx);
              pg8::EpiKV E{WSP(bf16, WS_KN), WSP(bf16, WS_VC), WSP(float, WS_RKV)};
              pg8::gemm_phase<pg8::EpiKV, pg8::StaticOrder, true, true>(ring, g, S, E, F.tid); } PR_END(32);
            __syncthreads(); }
            PHASE_END(g0 + 2); PR_END(3);
        }
        if (EN(4) && RUN(g0 + 3)) { PR_BEGIN(4); for (int rep_ = 0; rep_ < REPS(4); ++rep_) { PH_BEGIN();
#ifndef NO_ATT
            PR_BEGIN(40); mix_attention(F, P, l);
            __syncthreads(); PR_END(40);
#endif
#ifndef NO_HOUT
            PR_BEGIN(41); { PH_BEGIN(); for (int ch = F.vcu; ch < 2048; ch += F.G) hgrn_out(F, P, ch, l); } PR_END(41);
#endif
            __syncthreads(); }
            PHASE_END(g0 + 3); PR_END(4);
        }
        if (EN(5) && RUN(g0 + 4)) { PR_BEGIN(5); for (int rep_ = 0; rep_ < REPS(5); ++rep_) { PH_BEGIN();
            pg8::Gemm g{WSP(bf16, WS_MIX), WLAYER(bf16, l, W_O), M, DM, DM}; pg8::StaticOrder S; S.init(M, DM, F.G, F.bx);
            pg8::EpiY E{WSP(bf16, WS_Y), WSP(float, WS_YSS)};
            pg8::gemm_phase<pg8::EpiY, pg8::StaticOrder, true, true>(ring, g, S, E, F.tid);
            __syncthreads(); }
            PHASE_END(g0 + 4); PR_END(5);
        }
        if (EN(6) && RUN(g0 + 5)) { PR_BEGIN(6); PH_BEGIN();
            const int gw = F.vcu * NWAVES + F.wave, NGW = F.G * NWAVES;
            if (l == 0) { for (int m = gw; m < M; m += NGW) norm_step<true, false>(F.lane, P.inp(0) + (size_t)m * DM, WSP(bf16, WS_HN) + (size_t)m * DM, WSP(bf16, WS_Y) + (size_t)m * DM, WSP(float, WS_YSS) + (size_t)m * 64, P.inp(20) + (size_t)l * DM, nullptr, WSP(float, WS_HSS) + m); }
            else { norm_rows<false, false>(F.lane, gw, NGW, M, nullptr, WSP(bf16, WS_HN), WSP(bf16, WS_Y), WSP(float, WS_YSS), P.inp(20) + (size_t)l * DM, nullptr, WSP(float, WS_HSS)); }
            PHASE_END(g0 + 5); PR_END(6);
        }
        if (EN(7) && RUN(g0 + 6)) { PR_BEGIN(7); for (int rep_ = 0; rep_ < REPS(7); ++rep_) { PH_BEGIN();
            pg8::Gemm g{WSP(bf16, WS_HN), WLAYER(bf16, l, W_MQ), M, 512, DM}; pg8::StaticOrder S; S.init(M, 512, F.G, F.bx);
            pg8::EpiQmem E{WSP(bf16, WS_QMEM), QSCALE_128, WSP(float, WS_HSS)};
            pg8::gemm_phase<pg8::EpiQmem, pg8::StaticOrder, true, true>(ring, g, S, E, F.tid);
            if (F.G == 256 && F.bx >= 128) steal_upto(F, P, Q8_TOTAL, 10);
            __syncthreads(); }
            PHASE_END(g0 + 6); PR_END(7);
        }
        if (EN(8) && RUN(g0 + 7)) { PR_BEGIN(7); for (int rep_ = 0; rep_ < REPS(8); ++rep_) { PH_BEGIN(); mem_attention(F, P, l); __syncthreads(); } PHASE_END(g0 + 7); PR_END(7); }
        if (EN(9) && RUN(g0 + 8)) { PR_BEGIN(7); for (int rep_ = 0; rep_ < REPS(9); ++rep_) { PH_BEGIN();
            pg8::Gemm g{WSP(bf16, WS_OMEM), WLAYER(bf16, l, W_MO), M, DM, 512}; pg8::StaticOrder S; S.init(M, DM, F.G, F.bx);
            pg8::EpiY E{WSP(bf16, WS_Y), WSP(float, WS_YSS)};
            pg8::gemm_phase<pg8::EpiY, pg8::StaticOrder, true, true>(ring, g, S, E, F.tid);
            __syncthreads(); }
            PHASE_END(g0 + 8); PR_END(7);
        }
        if (EN(10) && RUN(g0 + 9)) { PR_BEGIN(6); PH_BEGIN();
            const int gw = F.vcu * NWAVES + F.wave, NGW = F.G * NWAVES;
            norm_rows<false, false>(F.lane, gw, NGW, M, nullptr, WSP(bf16, WS_HN), WSP(bf16, WS_Y), WSP(float, WS_YSS), P.inp(22) + (size_t)l * DM, nullptr, WSP(float, WS_HSS));
            PHASE_END(g0 + 9); PR_END(6);
        }
        if (EN(11) && RUN(g0 + 10)) { PR_BEGIN(11); for (int rep_ = 0; rep_ < REPS(11); ++rep_) { PH_BEGIN();
            pg8::Gemm g{WSP(bf16, WS_HN), WLAYER(bf16, l, W_FF1), M, DFF, DM}; pg8::StaticOrder S; S.init(M, DFF, F.G, F.bx);
            pg8::EpiRelu2 E{WSP(bf16, WS_HID), DFF, WSP(float, WS_HSS)};
            pg8::gemm_phase<pg8::EpiRelu2, pg8::StaticOrder, true, true>(ring, g, S, E, F.tid);
            __syncthreads(); }
            PHASE_END(g0 + 10); PR_END(11);
        }
        if (EN(12) && RUN(g0 + 11)) { PR_BEGIN(12); for (int rep_ = 0; rep_ < REPS(12); ++rep_) { PH_BEGIN();
            pg8::Gemm g{WSP(bf16, WS_HID), WLAYER(bf16, l, W_FF2), M, DM, DFF}; pg8::StaticOrder S; S.init(M, DM, F.G, F.bx);
            pg8::EpiY E{WSP(bf16, WS_Y), WSP(float, WS_YSS)};
            pg8::gemm_phase<pg8::EpiY, pg8::StaticOrder, true, true>(ring, g, S, E, F.tid);
            __syncthreads(); }
            PHASE_END(g0 + 11); PR_END(12);
        }
        if (EN(13) && RUN(g0 + 12)) { PR_BEGIN(6); PH_BEGIN();
            if (l + 1 < DEPTH) steal_upto(F, P, (l + 1) * Q8_LAYER, 1 << 30);
            const int gw = F.vcu * NWAVES + F.wave, NGW = F.G * NWAVES;
            if (l + 1 < DEPTH) { norm_rows<false, false>(F.lane, gw, NGW, M, nullptr, WSP(bf16, WS_HN), WSP(bf16, WS_Y), WSP(float, WS_YSS), P.inp(24) + (size_t)l * DM, nullptr, WSP(float, WS_HSS)); }
            else { for (int m = gw; m < M; m += NGW) norm_step<false, true>(F.lane, nullptr, WSP(bf16, WS_HN) + (size_t)m * DM, WSP(bf16, WS_Y) + (size_t)m * DM, WSP(float, WS_YSS) + (size_t)m * 64, P.inp(24) + (size_t)l * DM, P.out + (size_t)m * DM, nullptr); }
            PHASE_END(g0 + 12); PR_END(6);
        }
    }
#ifdef PROBE_ID
    if (blockIdx.x == 0) { const unsigned long long t0_ = __builtin_amdgcn_s_memrealtime(), want_ = (unsigned long long)(PROBE_AMP) * pr_acc; while (__builtin_amdgcn_s_memrealtime() - t0_ < want_) __builtin_amdgcn_s_sleep(32); }
#endif
#undef RUN
#undef PHASE_END
}

#ifndef MK_PER_PHASE
#define MK_PER_PHASE 0
#endif
extern "C" void kernel_launch(void* const* d_in, const int* in_sizes, int n_in, void* d_out, int out_size, void* d_ws, size_t ws_size, hipStream_t stream) {
    static int grid = 0;
    if (grid == 0) {
        if (n_in != 25 || in_sizes[0] != M * DM || out_size != M * DM || ws_size < WS_END) { fprintf(stderr, "kernel_launch: unexpected shapes (n_in %d, in0 %d, out %d, ws %zu; need ws >= %zu); nothing launched\n", n_in, n_in > 0 ? in_sizes[0] : -1, out_size, ws_size, (size_t)WS_END); grid = -1; return; }
        int dev = 0, cus = 0, per_cu = 0;
        if (hipGetDevice(&dev) != hipSuccess || hipDeviceGetAttribute(&cus, hipDeviceAttributeMultiprocessorCount, dev) != hipSuccess) { fprintf(stderr, "kernel_launch: device query failed\n"); grid = -1; return; }
        if (hipFuncSetAttribute((const void*)trunk_fwd, hipFuncAttributeMaxDynamicSharedMemorySize, LDS_BYTES) != hipSuccess) { fprintf(stderr, "kernel_launch: hipFuncSetAttribute failed\n"); grid = -1; return; }
        if (hipOccupancyMaxActiveBlocksPerMultiprocessor(&per_cu, (const void*)trunk_fwd, NWAVES * 64, LDS_BYTES) != hipSuccess || per_cu < 1)
            fprintf(stderr, "kernel_launch: note: occupancy query reports %d workgroups per CU\n", per_cu);
        (void)hipGetLastError();
        grid = cus;
    }
    if (grid < 0) return;
    if (hipMemsetAsync((char*)d_ws + WS_CTL, 0, CTL_ZERO_BYTES, stream) != hipSuccess) { fprintf(stderr, "kernel_launch: memset failed\n"); return; }
    Args a{};
    for (int i = 0; i < 25; ++i) a.in[i] = (const float*)d_in[i];
    a.out = (float*)d_out; a.ws = (unsigned char*)d_ws;
#if MK_PER_PHASE
    for (int p = 0; p < NPHASES; ++p) { a.ph_lo = p; a.ph_hi = p + 1; hipLaunchKernelGGL(trunk_fwd, dim3(grid), dim3(NWAVES * 64), LDS_BYTES, stream, a); }
#else
    a.ph_lo = 0; a.ph_hi = NPHASES;
    hipLaunchKernelGGL(trunk_fwd, dim3(grid), dim3(NWAVES * 64), LDS_BYTES, stream, a);
#endif
    const hipError_t le = hipPeekAtLastError();
    if (le != hipSuccess) fprintf(stderr, "kernel_launch: launch failed: %s\n", hipGetErrorName(le));
}
```
